# Optimizing an MI355X kernel written in HIP

```python
import jax, jax.numpy as jnp
from jax import lax
import numpy as np

D_MODEL = 1024
BATCH = 8
SEQ = 2048
DEPTH = 4

GRID_W = 64
CTX_LEN = 256
N_MIXERS = 3
N_WIN = (DEPTH + 2) // 3
N_GLB = (DEPTH + 1) // 3
N_GDN = DEPTH // 3

HEAD_DIM = 64
N_HEADS = D_MODEL // HEAD_DIM
N_KV_HEADS = 4
GROUP = N_HEADS // N_KV_HEADS
QKV_DIM = (N_HEADS + 2 * N_KV_HEADS) * HEAD_DIM
WINDOW = 128
Q_BLOCK = 128
ROPE_THETA = 10000.0
AXIS_DIM = HEAD_DIM // 2

GDN_HEADS = D_MODEL // 128
GDN_DK = 128
GDN_DV = 128
GDN_KW = GDN_HEADS * GDN_DK
GDN_VW = GDN_HEADS * GDN_DV
GDN_IN_DIM = 2 * GDN_KW + 2 * GDN_VW + 4 * GDN_HEADS
CONV_K = 5
CHUNK = 64

N_EXPERTS = 32
TOP_K = 4
D_EXPERT = D_MODEL
SWIGLU_LIMIT = 7.0
SWIGLU_ALPHA = 1.702
EXPERT_BLOCK = 128

NORM_EPS = 1e-6
NEG_INF = -1e30

kernel_name = 'hybrid_interleaved_flow_backbone'


def rms_norm(x, g):
    xf = x.astype(jnp.float32)
    y = xf * lax.rsqrt(jnp.mean(xf * xf, axis=-1, keepdims=True) + NORM_EPS)
    return (y * g.astype(jnp.float32)).astype(x.dtype)


def l2_norm(x):
    return x * lax.rsqrt(jnp.sum(x * x, axis=-1, keepdims=True) + NORM_EPS)


def adaln(cond, w_mod, b_mod):
    m = jax.nn.silu(cond) @ w_mod + b_mod
    return jnp.split(m[:, None, :], 6, axis=-1)


def axial_tables(length, dtype):
    rows = length // GRID_W
    row = jnp.broadcast_to(jnp.arange(rows)[:, None], (rows, GRID_W)).reshape(-1)
    col = jnp.broadcast_to(jnp.arange(GRID_W)[None, :], (rows, GRID_W)).reshape(-1)
    pos = jnp.stack([row, col], axis=-1).astype(jnp.float32)
    inv = ROPE_THETA ** (-jnp.arange(0, AXIS_DIM, 2, dtype=jnp.float32) / AXIS_DIM)
    ang = pos[:, None, :, None] * inv
    return jnp.cos(ang).astype(dtype), jnp.sin(ang).astype(dtype)


def axial_rope(x, cos, sin):
    b, l, h, _ = x.shape
    xa = x.reshape(b, l, h, 2, AXIS_DIM)
    x1, x2 = xa[..., :AXIS_DIM // 2], xa[..., AXIS_DIM // 2:]
    out = jnp.concatenate([x1 * cos - x2 * sin, x2 * cos + x1 * sin], axis=-1)
    return out.reshape(b, l, h, HEAD_DIM)


def split_qkv(p):
    b, l, _ = p.shape
    nq, nk = N_HEADS * HEAD_DIM, N_KV_HEADS * HEAD_DIM
    q = p[..., :nq].reshape(b, l, N_HEADS, HEAD_DIM)
    k = p[..., nq:nq + nk].reshape(b, l, N_KV_HEADS, HEAD_DIM)
    v = p[..., nq + nk:].reshape(b, l, N_KV_HEADS, HEAD_DIM)
    return q, k, v


def attend(q, k, v, mask, sink):
    b, lq = q.shape[:2]
    qg = q.reshape(b, lq, N_KV_HEADS, GROUP, HEAD_DIM)
    s = jnp.einsum('bqkgd,bskd->bkgqs', qg, k).astype(jnp.float32) * (HEAD_DIM ** -0.5)
    if mask is not None:
        s = jnp.where(mask, s, NEG_INF)
    m = jnp.max(s, axis=-1, keepdims=True)
    if sink is not None:
        sk = sink.astype(jnp.float32).reshape(1, N_KV_HEADS, GROUP, 1, 1)
        m = jnp.maximum(m, sk)
        p = jnp.exp(s - m)
        den = jnp.sum(p, axis=-1, keepdims=True) + jnp.exp(sk - m)
    else:
        p = jnp.exp(s - m)
        den = jnp.sum(p, axis=-1, keepdims=True)
    o = jnp.einsum('bkgqs,bskd->bqkgd', (p / den).astype(v.dtype), v)
    return o.reshape(b, lq, N_HEADS * HEAD_DIM)


def window_gqa(h_lat, h_ctx, w_qkv, b_qkv, sink, w_o, b_o, cos, sin, need_ctx):
    b, l, _ = h_lat.shape
    q, k, v = split_qkv(h_lat @ w_qkv + b_qkv)
    q, k = axial_rope(q, cos, sin), axial_rope(k, cos, sin)
    qc, kc, vc = split_qkv(h_ctx @ w_qkv + b_qkv)
    pad = ((0, 0), (WINDOW, WINDOW), (0, 0), (0, 0))
    kp, vp = jnp.pad(k, pad), jnp.pad(v, pad)
    nb = l // Q_BLOCK
    span = Q_BLOCK + 2 * WINDOW
    qb = q.reshape(b, nb, Q_BLOCK, N_HEADS, HEAD_DIM).swapaxes(0, 1)
    ctx_ok = jnp.ones((Q_BLOCK, kc.shape[1]), bool)

    def block(args):
        qblk, bi = args
        start = bi * Q_BLOCK
        kblk = lax.dynamic_slice_in_dim(kp, start, span, axis=1)
        vblk = lax.dynamic_slice_in_dim(vp, start, span, axis=1)
        qpos = start + jnp.arange(Q_BLOCK)
        kpos = start - WINDOW + jnp.arange(span)
        band = (jnp.abs(qpos[:, None] - kpos[None, :]) <= WINDOW) & (kpos >= 0)[None, :] & (kpos < l)[None, :]
        mask = jnp.concatenate([band, ctx_ok], axis=1)
        return attend(qblk, jnp.concatenate([kblk, kc], axis=1), jnp.concatenate([vblk, vc], axis=1), mask, sink)

    o = lax.map(block, (qb, jnp.arange(nb)))
    y_lat = o.swapaxes(0, 1).reshape(b, l, N_HEADS * HEAD_DIM) @ w_o + b_o
    y_ctx = attend(qc, kc, vc, None, sink) @ w_o + b_o if need_ctx else None
    return y_lat, y_ctx


def global_qknorm_gqa(h_lat, h_ctx, w_qkv, g_q, g_k, w_o, cos, sin, need_ctx):
    b, l, _ = h_lat.shape
    q, k, v = split_qkv(h_lat @ w_qkv)
    q = axial_rope(rms_norm(q, g_q), cos, sin)
    k = axial_rope(rms_norm(k, g_k), cos, sin)
    qc, kc, vc = split_qkv(h_ctx @ w_qkv)
    qc, kc = rms_norm(qc, g_q), rms_norm(kc, g_k)
    k_all = jnp.concatenate([k, kc], axis=1)
    v_all = jnp.concatenate([v, vc], axis=1)
    nb = l // Q_BLOCK
    qb = q.reshape(b, nb, Q_BLOCK, N_HEADS, HEAD_DIM).swapaxes(0, 1)
    o = lax.map(lambda qblk: attend(qblk, k_all, v_all, None, None), qb)
    y_lat = o.swapaxes(0, 1).reshape(b, l, N_HEADS * HEAD_DIM) @ w_o
    y_ctx = attend(qc, kc, vc, None, None) @ w_o if need_ctx else None
    return y_lat, y_ctx


def short_conv(x, w):
    return lax.conv_general_dilated(x, w[:, None, :].astype(x.dtype), window_strides=(1,),
                                    padding=[(CONV_K // 2, CONV_K // 2)],
                                    dimension_numbers=('NWC', 'WIO', 'NWC'),
                                    feature_group_count=x.shape[-1])


def gdn_project(h, w_in, conv_w, a_log, dt_bias):
    b, l, _ = h.shape
    p = h @ w_in
    qkv = jax.nn.silu(short_conv(p[..., :2 * GDN_KW + GDN_VW], conv_w)).astype(jnp.float32)
    q = l2_norm(qkv[..., :GDN_KW].reshape(b, l, GDN_HEADS, GDN_DK)) * (GDN_DK ** -0.5)
    k = l2_norm(qkv[..., GDN_KW:2 * GDN_KW].reshape(b, l, GDN_HEADS, GDN_DK))
    v = qkv[..., 2 * GDN_KW:].reshape(b, l, GDN_HEADS, GDN_DV)
    o = 2 * GDN_KW + GDN_VW
    z = p[..., o:o + GDN_VW].reshape(b, l, GDN_HEADS, GDN_DV)
    o += GDN_VW
    beta = jax.nn.sigmoid(p[..., o:o + 2 * GDN_HEADS].astype(jnp.float32)).reshape(b, l, 2, GDN_HEADS)
    a = p[..., o + 2 * GDN_HEADS:].astype(jnp.float32).reshape(b, l, 2, GDN_HEADS)
    g = -jnp.exp(a_log.astype(jnp.float32)) * jax.nn.softplus(a + dt_bias.astype(jnp.float32))
    return q, k, v, z, beta, g


def chunk_gated_delta(q, k, v, g, beta, s0):
    b, t, h, _ = q.shape
    dv = v.shape[-1]
    n = t // CHUNK

    def chunks(a):
        a = a.reshape(b, n, CHUNK, h, *a.shape[3:])
        return jnp.moveaxis(a, 3, 2).swapaxes(0, 1)

    qc, kc, vc, gc, bc = chunks(q), chunks(k), chunks(v), chunks(g), chunks(beta)
    gcum = jnp.cumsum(gc, axis=-1)
    lower = jnp.tril(jnp.ones((CHUNK, CHUNK), bool))
    strict = jnp.tril(jnp.ones((CHUNK, CHUNK), bool), -1)
    diff = gcum[..., :, None] - gcum[..., None, :]
    decay = jnp.where(lower, jnp.exp(jnp.where(lower, diff, 0.0)), 0.0)
    kb = kc * bc[..., None]
    a_mat = jnp.where(strict, jnp.einsum('nbhid,nbhjd->nbhij', kb, kc) * decay, 0.0)
    eye = jnp.eye(CHUNK, dtype=jnp.float32)
    t_inv = lax.linalg.triangular_solve(eye + a_mat, jnp.broadcast_to(eye, a_mat.shape),
                                        left_side=True, lower=True, unit_diagonal=True)
    u = t_inv @ (vc * bc[..., None])
    w = t_inv @ (kb * jnp.exp(gcum)[..., None])
    intra = jnp.einsum('nbhid,nbhjd->nbhij', qc, kc) * decay

    def step(s, xs):
        q_i, k_i, u_i, w_i, intra_i, g_i = xs
        v_new = u_i - w_i @ s
        o = (q_i * jnp.exp(g_i)[..., None]) @ s + intra_i @ v_new
        g_last = g_i[..., -1:]
        s = s * jnp.exp(g_last)[..., None] + jnp.einsum('bhcd,bhce->bhde', k_i * jnp.exp(g_last - g_i)[..., None], v_new)
        return s, o

    s, o = lax.scan(step, s0, (qc, kc, u, w, intra, gcum))
    o = jnp.moveaxis(o.swapaxes(0, 1), 2, 3).reshape(b, t, h, dv)
    return o, s


def gated_deltanet(h_lat, h_ctx, w_in, conv_w, a_log, dt_bias, g_out, w_o, need_ctx):
    ql, kl, vl, zl, bl, gl = gdn_project(h_lat, w_in, conv_w, a_log, dt_bias)
    qc, kc, vc, zc, bc, gc = gdn_project(h_ctx, w_in, conv_w, a_log, dt_bias)
    b = h_lat.shape[0]
    s0 = jnp.zeros((b, GDN_HEADS, GDN_DK, GDN_DV), jnp.float32)
    flip = lambda a: jnp.flip(a, axis=1)
    oc_f, sc_f = chunk_gated_delta(qc, kc, vc, gc[:, :, 0], bc[:, :, 0], s0)
    ol_f, _ = chunk_gated_delta(ql, kl, vl, gl[:, :, 0], bl[:, :, 0], sc_f)
    oc_b, sc_b = chunk_gated_delta(flip(qc), flip(kc), flip(vc), flip(gc[:, :, 1]), flip(bc[:, :, 1]), s0)
    ol_b, _ = chunk_gated_delta(flip(ql), flip(kl), flip(vl), flip(gl[:, :, 1]), flip(bl[:, :, 1]), sc_b)

    def readout(o, z):
        o = (rms_norm(o, g_out) * jax.nn.silu(z.astype(jnp.float32))).astype(h_lat.dtype)
        return o.reshape(b, o.shape[1], GDN_VW) @ w_o

    y_lat = readout(ol_f + flip(ol_b), zl)
    y_ctx = readout(oc_f + flip(oc_b), zc) if need_ctx else None
    return y_lat, y_ctx


def moe_ffn(h, w_router, b_router, w_up, b_up, w_down, b_down):
    n, d = h.shape
    logits = (h @ w_router + b_router).astype(jnp.float32)
    top_val, top_idx = lax.top_k(logits, TOP_K)
    gates = jax.nn.softmax(top_val, axis=-1).astype(h.dtype)
    flat_e = top_idx.reshape(-1)
    flat_tok = jnp.repeat(jnp.arange(n, dtype=jnp.int32), TOP_K)
    order = jnp.argsort(flat_e)
    e_sorted = flat_e[order]
    counts = jnp.bincount(flat_e, length=N_EXPERTS)
    padded = (counts + EXPERT_BLOCK - 1) // EXPERT_BLOCK * EXPERT_BLOCK
    start = jnp.cumsum(counts) - counts
    pend = jnp.cumsum(padded)
    pstart = pend - padded
    dest = pstart[e_sorted] + jnp.arange(n * TOP_K) - start[e_sorted]
    n_blocks = -(-(n * TOP_K) // EXPERT_BLOCK) + N_EXPERTS
    rows = n_blocks * EXPERT_BLOCK
    tok_buf = jnp.full((rows,), n, jnp.int32).at[dest].set(flat_tok[order])
    gate_buf = jnp.zeros((rows,), h.dtype).at[dest].set(gates.reshape(-1)[order])
    blk_expert = jnp.minimum(jnp.searchsorted(pend, jnp.arange(n_blocks) * EXPERT_BLOCK, side='right'), N_EXPERTS - 1)
    xb = jnp.concatenate([h, jnp.zeros((1, d), h.dtype)], axis=0)[tok_buf].reshape(n_blocks, EXPERT_BLOCK, d)

    def expert_block(args):
        xe, e = args
        u = xe @ w_up[e] + b_up[e]
        glu = jnp.minimum(u[..., :D_EXPERT], SWIGLU_LIMIT)
        lin = jnp.clip(u[..., D_EXPERT:], -SWIGLU_LIMIT, SWIGLU_LIMIT)
        act = glu * jax.nn.sigmoid(SWIGLU_ALPHA * glu) * (lin + 1.0)
        return act @ w_down[e] + b_down[e]

    yb = lax.map(expert_block, (xb, blk_expert)).reshape(rows, d) * gate_buf[:, None]
    return jnp.zeros((n + 1, d), h.dtype).at[tok_buf].add(yb)[:n]


def setup_inputs(seed: int = 0) -> dict:
    key = jax.random.key(seed)
    ks = jax.random.split(key, 32)
    f32 = jnp.float32
    nrm = lambda k, shape, scale: jax.random.normal(k, shape, f32) * scale
    d = D_MODEL
    dt = jnp.exp(jax.random.uniform(ks[20], (N_GDN, 2, GDN_HEADS), f32, np.log(1e-3), np.log(1e-1)))
    return {
        'x': nrm(ks[0], (BATCH, SEQ, d), 1.0),
        'c': nrm(ks[1], (BATCH, d), 1.0),
        'ctx': nrm(ks[2], (BATCH, CTX_LEN, d), 1.0),
        'c_ctx': nrm(ks[3], (d,), 1.0),
        'w_mod': nrm(ks[4], (DEPTH, d, 6 * d), 0.5 * d ** -0.5),
        'b_mod': nrm(ks[5], (DEPTH, 6 * d), 0.02),
        'g_mix': 1.0 + nrm(ks[6], (DEPTH, d), 0.02),
        'g_ffn': 1.0 + nrm(ks[7], (DEPTH, d), 0.02),
        'win_w_qkv': nrm(ks[8], (N_WIN, d, QKV_DIM), d ** -0.5),
        'win_b_qkv': nrm(ks[9], (N_WIN, QKV_DIM), 0.02),
        'win_sink': nrm(ks[10], (N_WIN, N_HEADS), 1.0),
        'win_w_o': nrm(ks[11], (N_WIN, N_HEADS * HEAD_DIM, d), (N_HEADS * HEAD_DIM) ** -0.5),
        'win_b_o': nrm(ks[12], (N_WIN, d), 0.02),
        'glb_w_qkv': nrm(ks[13], (N_GLB, d, QKV_DIM), d ** -0.5),
        'glb_g_q': 1.0 + nrm(ks[14], (N_GLB, HEAD_DIM), 0.02),
        'glb_g_k': 1.0 + nrm(ks[15], (N_GLB, HEAD_DIM), 0.02),
        'glb_w_o': nrm(ks[16], (N_GLB, N_HEADS * HEAD_DIM, d), (N_HEADS * HEAD_DIM) ** -0.5),
        'gdn_w_in': nrm(ks[17], (N_GDN, d, GDN_IN_DIM), d ** -0.5),
        'gdn_conv_w': nrm(ks[18], (N_GDN, CONV_K, 2 * GDN_KW + GDN_VW), CONV_K ** -0.5),
        'gdn_a_log': jnp.log(jax.random.uniform(ks[19], (N_GDN, 2, GDN_HEADS), f32, 1.0, 16.0)),
        'gdn_dt_bias': jnp.log(jnp.expm1(dt)),
        'gdn_g_out': 1.0 + nrm(ks[21], (N_GDN, GDN_DV), 0.02),
        'gdn_w_o': nrm(ks[22], (N_GDN, GDN_VW, d), GDN_VW ** -0.5),
        'moe_w_router': nrm(ks[23], (DEPTH, d, N_EXPERTS), d ** -0.5),
        'moe_b_router': nrm(ks[24], (DEPTH, N_EXPERTS), 0.01),
        'moe_w_up': nrm(ks[25], (DEPTH, N_EXPERTS, d, 2 * D_EXPERT), d ** -0.5),
        'moe_b_up': nrm(ks[26], (DEPTH, N_EXPERTS, 2 * D_EXPERT), 0.02),
        'moe_w_down': nrm(ks[27], (DEPTH, N_EXPERTS, D_EXPERT, d), D_EXPERT ** -0.5),
        'moe_b_down': nrm(ks[28], (DEPTH, N_EXPERTS, d), 0.02),
        'g_final': 1.0 + nrm(ks[29], (d,), 0.02),
    }


def reference(x, c, ctx, c_ctx, w_mod, b_mod, g_mix, g_ffn, win_w_qkv, win_b_qkv, win_sink, win_w_o, win_b_o,
              glb_w_qkv, glb_g_q, glb_g_k, glb_w_o, gdn_w_in, gdn_conv_w, gdn_a_log, gdn_dt_bias, gdn_g_out, gdn_w_o,
              moe_w_router, moe_b_router, moe_w_up, moe_b_up, moe_w_down, moe_b_down, g_final):
    b, l, d = x.shape
    cos, sin = axial_tables(l, x.dtype)
    x_lat, x_ctx = x, ctx
    for i in range(DEPTH):
        kind, j = i % N_MIXERS, i // N_MIXERS
        need_ctx = i < DEPTH - 1
        sh1, sc1, gt1, sh2, sc2, gt2 = adaln(c, w_mod[i], b_mod[i])
        csh1, csc1, cgt1, csh2, csc2, cgt2 = adaln(c_ctx[None, :], w_mod[i], b_mod[i])
        h_lat = rms_norm(x_lat, g_mix[i]) * (1.0 + sc1) + sh1
        h_ctx = rms_norm(x_ctx, g_mix[i]) * (1.0 + csc1) + csh1
        if kind == 0:
            y_lat, y_ctx = window_gqa(h_lat, h_ctx, win_w_qkv[j], win_b_qkv[j], win_sink[j], win_w_o[j], win_b_o[j],
                                      cos, sin, need_ctx)
        elif kind == 1:
            y_lat, y_ctx = global_qknorm_gqa(h_lat, h_ctx, glb_w_qkv[j], glb_g_q[j], glb_g_k[j], glb_w_o[j],
                                             cos, sin, need_ctx)
        else:
            y_lat, y_ctx = gated_deltanet(h_lat, h_ctx, gdn_w_in[j], gdn_conv_w[j], gdn_a_log[j], gdn_dt_bias[j],
                                          gdn_g_out[j], gdn_w_o[j], need_ctx)
        x_lat = x_lat + gt1 * y_lat
        h_lat = rms_norm(x_lat, g_ffn[i]) * (1.0 + sc2) + sh2
        if need_ctx:
            x_ctx = x_ctx + cgt1 * y_ctx
            h_ctx = rms_norm(x_ctx, g_ffn[i]) * (1.0 + csc2) + csh2
            n_ctx = h_ctx.shape[0] * h_ctx.shape[1]
            tokens = jnp.concatenate([h_ctx.reshape(-1, d), h_lat.reshape(-1, d)], axis=0)
            y = moe_ffn(tokens, moe_w_router[i], moe_b_router[i], moe_w_up[i], moe_b_up[i], moe_w_down[i], moe_b_down[i])
            x_ctx = x_ctx + cgt2 * y[:n_ctx].reshape(x_ctx.shape)
            x_lat = x_lat + gt2 * y[n_ctx:].reshape(x_lat.shape)
        else:
            y = moe_ffn(h_lat.reshape(-1, d), moe_w_router[i], moe_b_router[i], moe_w_up[i], moe_b_up[i],
                        moe_w_down[i], moe_b_down[i])
            x_lat = x_lat + gt2 * y.reshape(x_lat.shape)
    return rms_norm(x_lat, g_final)
```

```cpp
#include <hip/hip_runtime.h>
#include <stdint.h>

namespace cfg {
constexpr int D = 1024, NB = 8, L = 2048, C = 256, T = L + C, NTOK = NB * T, DEPTH = 4;
constexpr int HD = 64, NH = 16, NKV = 4, QKV = 1536, WINDOW = 128;
constexpr int GH = 8, GDK = 128, GIN = 4128;
constexpr int NE = 32, TOPK = 4, CAP = NTOK;
constexpr float EPS = 1e-6f;
}
using namespace cfg;

namespace ws {
constexpr size_t al(size_t x) { return (x + 4095) & ~(size_t)4095; }
constexpr size_t CTL = 0;
constexpr size_t MODS = 65536;
constexpr size_t ROPE = al(MODS + (size_t)DEPTH * 9 * 6144 * 4);
constexpr size_t X = al(ROPE + (size_t)L * 32 * 2 * 4);
constexpr size_t H = al(X + (size_t)NTOK * D * 4);
constexpr size_t P = al(H + (size_t)NTOK * D * 4);
constexpr size_t O = al(P + (size_t)NTOK * GIN * 4);
constexpr size_t GQ = al(O + (size_t)NTOK * D * 4);
constexpr size_t GK = al(GQ + (size_t)NTOK * D * 4);
constexpr size_t GV = al(GK + (size_t)NTOK * D * 4);
constexpr size_t GBG = al(GV + (size_t)NTOK * D * 4);
constexpr size_t OF = al(GBG + (size_t)NTOK * 32 * 4);
constexpr size_t OB = al(OF + (size_t)NTOK * D * 4);
constexpr size_t LIST = al(OB + (size_t)NTOK * D * 4);
constexpr size_t GATE = al(LIST + (size_t)NE * CAP * 4);
constexpr size_t ACT = al(GATE + (size_t)NTOK * 4 * 4);
constexpr size_t YS = al(ACT + (size_t)NTOK * 4 * D * 4);
constexpr size_t END = al(YS + (size_t)NTOK * 4 * D * 4);
constexpr int CW_CNT = 1024;
constexpr int CW_OFFS = 2048;
}

__device__ __forceinline__ int cond_row(int n) { int b = n / T, p = n % T; return p < C ? 8 : b; }
__device__ __forceinline__ float silu_f(float v) { return v / (1.f + expf(-v)); }

__device__ __forceinline__ float block_sum256(float v, float* red) {
    for (int o = 32; o > 0; o >>= 1) v += __shfl_xor(v, o);
    const int w = threadIdx.x >> 6;
    __syncthreads();
    if ((threadIdx.x & 63) == 0) red[w] = v;
    __syncthreads();
    return red[0] + red[1] + red[2] + red[3];
}

__global__ void __launch_bounds__(256) k_mods(const float* c, const float* c_ctx, const float* w_mod, const float* b_mod, float* mods) {
    __shared__ float s[9][1024];
    const int gid = blockIdx.x * 256 + threadIdx.x, layer = gid / 6144, col = gid % 6144;
    for (int i = threadIdx.x; i < 9 * 1024; i += 256) { int r = i >> 10, k = i & 1023; float v = r < 8 ? c[r * 1024 + k] : c_ctx[k]; s[r][k] = silu_f(v); }
    __syncthreads();
    float acc[9];
#pragma unroll
    for (int r = 0; r < 9; ++r) acc[r] = 0.f;
    const float* w = w_mod + (size_t)layer * 1024 * 6144 + col;
    for (int k = 0; k < 1024; ++k) { const float wv = w[(size_t)k * 6144];
#pragma unroll
        for (int r = 0; r < 9; ++r) acc[r] += s[r][k] * wv; }
#pragma unroll
    for (int r = 0; r < 9; ++r) mods[((size_t)layer * 9 + r) * 6144 + col] = acc[r] + b_mod[layer * 6144 + col];
}

__global__ void __launch_bounds__(256) k_rope(float* rope) {
    const int gid = blockIdx.x * 256 + threadIdx.x; if (gid >= L * 32) return;
    const int l = gid >> 5, j = gid & 31, axis = j >> 4, f = j & 15;
    const float pos = (float)(axis == 0 ? (l / 64) : (l % 64));
    const float inv = (float)pow(10000.0, -(double)(2 * f) / 32.0);
    const float ang = pos * inv;
    rope[gid] = (float)cos((double)ang); rope[L * 32 + gid] = (float)sin((double)ang);
}

__global__ void __launch_bounds__(256) k_initx(const float* x, const float* ctx, float* X) {
    const int n = blockIdx.x, b = n / T, p = n % T;
    const float4* src = (const float4*)(p < C ? ctx + ((size_t)b * C + p) * D : x + ((size_t)b * L + (p - C)) * D);
    ((float4*)(X + (size_t)n * D))[threadIdx.x] = src[threadIdx.x];
}

__global__ void __launch_bounds__(256) k_normmod(const float* X, const float* g, const float* mods_l, int sh_chunk, int sc_chunk, float* H) {
    __shared__ float red[4];
    const int n = blockIdx.x, r = cond_row(n), t = threadIdx.x;
    const float4 v = ((const float4*)(X + (size_t)n * D))[t];
    const float ss = block_sum256(v.x * v.x + v.y * v.y + v.z * v.z + v.w * v.w, red);
    const float rs = rsqrtf(ss * (1.f / D) + EPS);
    const float4 gg = ((const float4*)g)[t];
    const float4 sh = ((const float4*)(mods_l + (size_t)r * 6144 + sh_chunk * 1024))[t];
    const float4 sc = ((const float4*)(mods_l + (size_t)r * 6144 + sc_chunk * 1024))[t];
    float4 o; o.x = v.x * rs * gg.x * (1.f + sc.x) + sh.x; o.y = v.y * rs * gg.y * (1.f + sc.y) + sh.y;
    o.z = v.z * rs * gg.z * (1.f + sc.z) + sh.z; o.w = v.w * rs * gg.w * (1.f + sc.w) + sh.w;
    ((float4*)(H + (size_t)n * D))[t] = o;
}

template <class AF>
__device__ __forceinline__ void mm_tile64(AF arow, const float* B, int ldb, int K, int col0, float (&acc)[4][4], float (*sA)[68], float (*sB)[68], int ncols = 1 << 30) {
    const int tid = threadIdx.x, tx = tid & 15, ty = tid >> 4;
    const int ar = tid >> 2, ak = (tid & 3) * 4;
    const int bk = tid >> 4, bc = (tid & 15) * 4;
    const float* ap = arow(ar);
#pragma unroll
    for (int i = 0; i < 4; ++i)
#pragma unroll
        for (int j = 0; j < 4; ++j) acc[i][j] = 0.f;
    for (int k0 = 0; k0 < K; k0 += 16) {
        float4 av = ap ? *(const float4*)(ap + k0 + ak) : make_float4(0.f, 0.f, 0.f, 0.f);
        float4 bv = (col0 + bc < ncols) ? *(const float4*)(B + (size_t)(k0 + bk) * ldb + col0 + bc) : make_float4(0.f, 0.f, 0.f, 0.f);
        __syncthreads();
        sA[ak + 0][ar] = av.x; sA[ak + 1][ar] = av.y; sA[ak + 2][ar] = av.z; sA[ak + 3][ar] = av.w;
        *(float4*)&sB[bk][bc] = bv;
        __syncthreads();
#pragma unroll
        for (int k = 0; k < 16; ++k) {
            const float4 a = *(const float4*)&sA[k][ty * 4], b = *(const float4*)&sB[k][tx * 4];
            const float aa[4] = {a.x, a.y, a.z, a.w}, bb[4] = {b.x, b.y, b.z, b.w};
#pragma unroll
            for (int i = 0; i < 4; ++i)
#pragma unroll
                for (int j = 0; j < 4; ++j) acc[i][j] += aa[i] * bb[j];
        }
    }
}

template <int MODE>
__global__ void __launch_bounds__(256) k_gemm(const float* A, int lda, const float* B, int ldb, const float* bias, float* Cm, int ldc, int M, int N, int K, const float* gate  ) {
    __shared__ float sA[16][68], sB[16][68];
    const int row0 = blockIdx.y * 64, col0 = blockIdx.x * 64;
    float acc[4][4];
    mm_tile64([&](int r) { return A + (size_t)(row0 + r) * lda; }, B, ldb, K, col0, acc, sA, sB, N);
    const int tx = threadIdx.x & 15, ty = threadIdx.x >> 4;
#pragma unroll
    for (int i = 0; i < 4; ++i) { const int row = row0 + ty * 4 + i;
#pragma unroll
        for (int j = 0; j < 4; ++j) { const int col = col0 + tx * 4 + j; if (col >= N) continue;
            const float v = acc[i][j] + (bias ? bias[col] : 0.f);
            if (MODE == 0) Cm[(size_t)row * ldc + col] = v;
            else Cm[(size_t)row * ldc + col] += gate[(size_t)cond_row(row) * 6144 + col] * v; } }
}

__global__ void __launch_bounds__(64) k_qkpost(float* P, int ldp, const float* gq, const float* gk, const float* rope) {
    const int n = blockIdx.x, hh = blockIdx.y;
    const int p = n % T, d = threadIdx.x;
    float* v = P + (size_t)n * ldp + hh * 64;
    float x = v[d];
    const float* gg = hh < 16 ? gq : gk;
    if (gg) { float ss = x * x; for (int o = 32; o > 0; o >>= 1) ss += __shfl_xor(ss, o); x = x * rsqrtf(ss * (1.f / 64) + EPS) * gg[d]; }
    if (p >= C) {
        const int l = p - C, axis = d >> 5, f = d & 15, second = (d >> 4) & 1;
        const float cs = rope[l * 32 + axis * 16 + f], sn = rope[L * 32 + l * 32 + axis * 16 + f];
        const float other = __shfl_xor(x, 16);
        x = second ? (x * cs + other * sn) : (x * cs - other * sn);
    }
    v[d] = x;
}

__global__ void __launch_bounds__(64) k_attn(const float* P, int ldp, const float* sink, int window  , float* O) {
    const int tile = blockIdx.x, h = blockIdx.y, b = blockIdx.z;
    const int p = tile * 64 + threadIdx.x, n = b * T + p, kvh = h / 4;
    float q[64], o[64];
    const float* qp = P + (size_t)n * ldp + h * 64;
#pragma unroll
    for (int d = 0; d < 64; ++d) { q[d] = qp[d] * 0.125f; o[d] = 0.f; }
    float m = sink ? sink[h] : -INFINITY, l = sink ? 1.f : 0.f;
    const bool is_ctx = tile < 4;
    int jlo = 0, jhi = -1;
    if (!is_ctx) { if (window < 0) { jlo = 0; jhi = L - 1; } else { const int i0 = tile * 64 - C; jlo = max(0, i0 - window); jhi = min(L - 1, i0 + 63 + window); } }
    const int qi = p - C;
    const int nkeys = C + (jhi - jlo + 1);
    for (int kk = 0; kk < nkeys; ++kk) {
        const int kp = kk < C ? kk : C + jlo + (kk - C);
        const float* kr = P + (size_t)(b * T + kp) * ldp + 1024 + kvh * 64;
        const float* vr = kr + 256;
        float s = 0.f;
#pragma unroll
        for (int d = 0; d < 64; ++d) s += q[d] * kr[d];
        bool ok = true;
        if (kk >= C && window >= 0) { const int j = kp - C; ok = abs(qi - j) <= window; }
        if (ok) {
            const float mn = fmaxf(m, s), sc = expf(m - mn), pe = expf(s - mn);
            l = l * sc + pe; m = mn;
#pragma unroll
            for (int d = 0; d < 64; ++d) o[d] = o[d] * sc + pe * vr[d];
        }
    }
    const float inv = 1.f / l;
    float* op = O + (size_t)n * D + h * 64;
#pragma unroll
    for (int d = 0; d < 64; ++d) op[d] = o[d] * inv;
}

__global__ void __launch_bounds__(256) k_gdn_prep(const float* P, const float* conv_w, const float* a_log, const float* dt_bias, float* GQ, float* GK, float* GV, float* GBG) {
    __shared__ float ssq[8][4];
    const int n = blockIdx.x, b = n / T, p = n % T, t = threadIdx.x;
    const int s0 = p < C ? 0 : C, s1 = p < C ? C : T;
    float val[12];
#pragma unroll
    for (int i = 0; i < 12; ++i) {
        const int c = t + 256 * i; float a = 0.f;
#pragma unroll
        for (int j = 0; j < 5; ++j) { const int pp = p + j - 2; if (pp >= s0 && pp < s1) a += P[(size_t)(b * T + pp) * GIN + c] * conv_w[j * 3072 + c]; }
        val[i] = silu_f(a);
    }
#pragma unroll
    for (int i = 0; i < 8; ++i) { float ss = val[i] * val[i]; for (int o = 32; o > 0; o >>= 1) ss += __shfl_xor(ss, o); if ((t & 63) == 0) ssq[i][t >> 6] = ss; }
    __syncthreads();
#pragma unroll
    for (int i = 0; i < 12; ++i) {
        const int c = t + 256 * i; float v = val[i];
        if (i < 8) { const int hf = t >> 7; const float ss = ssq[i][2 * hf] + ssq[i][2 * hf + 1]; v *= rsqrtf(ss + EPS); if (i < 4) v *= 0.08838834764831845f; }
        if (i < 4) GQ[(size_t)n * D + c] = v; else if (i < 8) GK[(size_t)n * D + (c - 1024)] = v; else GV[(size_t)n * D + (c - 2048)] = v;
    }
    if (t < 16) {
        const float bl = P[(size_t)n * GIN + 4096 + t]; GBG[(size_t)n * 32 + t] = 1.f / (1.f + expf(-bl));
        const float a = P[(size_t)n * GIN + 4112 + t] + dt_bias[t];
        const float sp = a > 20.f ? a : log1pf(expf(a));
        GBG[(size_t)n * 32 + 16 + t] = -expf(a_log[t]) * sp;
    }
}

__global__ void __launch_bounds__(128) k_gdn_scan(const float* GQ, const float* GK, const float* GV, const float* GBG, float* OF, float* OB) {
    __shared__ float sk[128], sq[128];
    const int b = blockIdx.x, h = blockIdx.y, dir = blockIdx.z, t = threadIdx.x;
    float S[128];
#pragma unroll
    for (int i = 0; i < 128; ++i) S[i] = 0.f;
    float* Od = dir == 0 ? OF : OB;
    for (int step = 0; step < T; ++step) {
        int p;
        if (step < C) p = dir == 0 ? step : C - 1 - step; else { const int s = step - C; p = C + (dir == 0 ? s : L - 1 - s); }
        const size_t n = (size_t)b * T + p;
        __syncthreads();
        sk[t] = GK[n * D + h * 128 + t]; sq[t] = GQ[n * D + h * 128 + t];
        const float v = GV[n * D + h * 128 + t];
        const float beta = GBG[n * 32 + dir * 8 + h], a = expf(GBG[n * 32 + 16 + dir * 8 + h]);
        __syncthreads();
        float ks = 0.f;
#pragma unroll
        for (int i = 0; i < 128; ++i) ks += sk[i] * S[i];
        const float delta = beta * (v - a * ks);
        float o = 0.f;
#pragma unroll
        for (int i = 0; i < 128; ++i) { S[i] = a * S[i] + sk[i] * delta; o += sq[i] * S[i]; }
        Od[n * D + h * 128 + t] = o;
    }
}

__global__ void __launch_bounds__(256) k_gdn_readout(const float* OF, const float* OB, const float* P, const float* g_out, float* O) {
    __shared__ float ssq[4][4];
    const int n = blockIdx.x, t = threadIdx.x;
    float o[4];
#pragma unroll
    for (int i = 0; i < 4; ++i) { const int c = t + 256 * i; o[i] = OF[(size_t)n * D + c] + OB[(size_t)n * D + c];
        float ss = o[i] * o[i]; for (int s = 32; s > 0; s >>= 1) ss += __shfl_xor(ss, s); if ((t & 63) == 0) ssq[i][t >> 6] = ss; }
    __syncthreads();
#pragma unroll
    for (int i = 0; i < 4; ++i) { const int c = t + 256 * i, hf = t >> 7; const float ss = ssq[i][2 * hf] + ssq[i][2 * hf + 1];
        const float z = P[(size_t)n * GIN + 3072 + c];
        O[(size_t)n * D + c] = o[i] * rsqrtf(ss * (1.f / 128) + EPS) * g_out[c & 127] * silu_f(z); }
}

__global__ void __launch_bounds__(256) k_router(const float* H, const float* w_router, const float* b_router, int skip_ctx, int* cnt, int* list, float* gate) {
    __shared__ float part[8][32]; __shared__ float lg[32];
    const int n = blockIdx.x, t = threadIdx.x, e = t & 31, ks = t >> 5;
    if (skip_ctx && (n % T) < C) return;
    float a = 0.f;
    for (int k = ks * 128; k < ks * 128 + 128; ++k) a += H[(size_t)n * D + k] * w_router[k * 32 + e];
    part[ks][e] = a;
    __syncthreads();
    if (t < 32) { float s = b_router[t]; for (int i = 0; i < 8; ++i) s += part[i][t]; lg[t] = s; }
    __syncthreads();
    if (t == 0) {
        int idx[4]; float val[4]; unsigned used = 0;
        for (int k = 0; k < 4; ++k) { int bi = -1; float bv = -INFINITY; for (int i = 0; i < 32; ++i) if (!((used >> i) & 1) && lg[i] > bv) { bv = lg[i]; bi = i; } used |= 1u << bi; idx[k] = bi; val[k] = bv; }
        float ex[4], sum = 0.f; for (int k = 0; k < 4; ++k) { ex[k] = expf(val[k] - val[0]); sum += ex[k]; }
        for (int k = 0; k < 4; ++k) { const int pos = atomicAdd(&cnt[idx[k]], 1); list[idx[k] * CAP + pos] = n * 4 + k; gate[n * 4 + k] = ex[k] / sum; }
    }
}
__global__ void k_offs(const int* cnt, int* offs) { if (threadIdx.x == 0) { int s = 0; for (int e = 0; e < 32; ++e) { offs[e] = s; s += cnt[e]; } offs[32] = s; } }

__global__ void __launch_bounds__(256) k_moe_up(const float* H, const float* w_up, const float* b_up, const int* cnt, const int* offs, const int* list, float* ACT) {
    __shared__ float sA[16][68], sB[16][68];
    const int e = blockIdx.z, row0 = blockIdx.y * 64, col0 = blockIdx.x * 64, M = cnt[e];
    if (row0 >= M) return;
    const float* B = w_up + (size_t)e * 1024 * 2048;
    auto arow = [&](int r) -> const float* { return (row0 + r < M) ? H + (size_t)(list[e * CAP + row0 + r] >> 2) * D : nullptr; };
    float ag[4][4], al[4][4];
    mm_tile64(arow, B, 2048, 1024, col0, ag, sA, sB);
    mm_tile64(arow, B, 2048, 1024, col0 + 1024, al, sA, sB);
    const int tx = threadIdx.x & 15, ty = threadIdx.x >> 4;
#pragma unroll
    for (int i = 0; i < 4; ++i) { const int r = row0 + ty * 4 + i; if (r >= M) continue;
#pragma unroll
        for (int j = 0; j < 4; ++j) { const int col = col0 + tx * 4 + j;
            const float glu = fminf(ag[i][j] + b_up[e * 2048 + col], 7.f);
            const float lin = fminf(fmaxf(al[i][j] + b_up[e * 2048 + 1024 + col], -7.f), 7.f);
            ACT[(size_t)(offs[e] + r) * D + col] = glu / (1.f + expf(-1.702f * glu)) * (lin + 1.f); } }
}
__global__ void __launch_bounds__(256) k_moe_down(const float* ACT, const float* w_down, const float* b_down, const int* cnt, const int* offs, const int* list, const float* gate, float* YS) {
    __shared__ float sA[16][68], sB[16][68];
    const int e = blockIdx.z, row0 = blockIdx.y * 64, col0 = blockIdx.x * 64, M = cnt[e];
    if (row0 >= M) return;
    const float* B = w_down + (size_t)e * 1024 * 1024;
    auto arow = [&](int r) -> const float* { return (row0 + r < M) ? ACT + (size_t)(offs[e] + row0 + r) * D : nullptr; };
    float acc[4][4];
    mm_tile64(arow, B, 1024, 1024, col0, acc, sA, sB);
    const int tx = threadIdx.x & 15, ty = threadIdx.x >> 4;
#pragma unroll
    for (int i = 0; i < 4; ++i) { const int r = row0 + ty * 4 + i; if (r >= M) continue; const int slot = list[e * CAP + r]; const float gt = gate[slot];
#pragma unroll
        for (int j = 0; j < 4; ++j) { const int col = col0 + tx * 4 + j; YS[(size_t)slot * D + col] = gt * (acc[i][j] + b_down[e * 1024 + col]); } }
}
__global__ void __launch_bounds__(256) k_combine(float* X, const float* YS, const float* mods_l, int skip_ctx) {
    const int n = blockIdx.x, t = threadIdx.x, r = cond_row(n);
    if (skip_ctx && (n % T) < C) return;
    float4 x = ((float4*)(X + (size_t)n * D))[t];
    const float4 g = ((const float4*)(mods_l + (size_t)r * 6144 + 5 * 1024))[t];
    float4 s = make_float4(0.f, 0.f, 0.f, 0.f);
    for (int k = 0; k < 4; ++k) { const float4 y = ((const float4*)(YS + (size_t)(n * 4 + k) * D))[t]; s.x += y.x; s.y += y.y; s.z += y.z; s.w += y.w; }
    x.x += g.x * s.x; x.y += g.y * s.y; x.z += g.z * s.z; x.w += g.w * s.w;
    ((float4*)(X + (size_t)n * D))[t] = x;
}
__global__ void __launch_bounds__(256) k_final(const float* X, const float* g, float* out) {
    __shared__ float red[4];
    const int i = blockIdx.x, b = i / L, l = i % L, t = threadIdx.x; const size_t n = (size_t)b * T + C + l;
    const float4 v = ((const float4*)(X + n * D))[t];
    const float ss = block_sum256(v.x * v.x + v.y * v.y + v.z * v.z + v.w * v.w, red);
    const float rs = rsqrtf(ss * (1.f / D) + EPS);
    const float4 gg = ((const float4*)g)[t];
    ((float4*)(out + (size_t)i * D))[t] = make_float4(v.x * rs * gg.x, v.y * rs * gg.y, v.z * rs * gg.z, v.w * rs * gg.w);
}

extern "C" void kernel_launch(void* const* d_in, const int* in_sizes, int n_in, void* d_out, int out_size, void* d_ws, size_t ws_size, hipStream_t stream) {
    const float* x = (const float*)d_in[0]; const float* c = (const float*)d_in[1]; const float* ctx = (const float*)d_in[2]; const float* c_ctx = (const float*)d_in[3];
    const float* w_mod = (const float*)d_in[4]; const float* b_mod = (const float*)d_in[5]; const float* g_mix = (const float*)d_in[6]; const float* g_ffn = (const float*)d_in[7];
    const float* win_w_qkv = (const float*)d_in[8]; const float* win_b_qkv = (const float*)d_in[9]; const float* win_sink = (const float*)d_in[10];
    const float* win_w_o = (const float*)d_in[11]; const float* win_b_o = (const float*)d_in[12];
    const float* glb_w_qkv = (const float*)d_in[13]; const float* glb_g_q = (const float*)d_in[14]; const float* glb_g_k = (const float*)d_in[15]; const float* glb_w_o = (const float*)d_in[16];
    const float* gdn_w_in = (const float*)d_in[17]; const float* gdn_conv_w = (const float*)d_in[18]; const float* gdn_a_log = (const float*)d_in[19];
    const float* gdn_dt_bias = (const float*)d_in[20]; const float* gdn_g_out = (const float*)d_in[21]; const float* gdn_w_o = (const float*)d_in[22];
    const float* moe_w_router = (const float*)d_in[23]; const float* moe_b_router = (const float*)d_in[24]; const float* moe_w_up = (const float*)d_in[25];
    const float* moe_b_up = (const float*)d_in[26]; const float* moe_w_down = (const float*)d_in[27]; const float* moe_b_down = (const float*)d_in[28]; const float* g_final = (const float*)d_in[29];
    char* w = (char*)d_ws;
    int* ctl = (int*)(w + ws::CTL);
    float* mods = (float*)(w + ws::MODS); float* rope = (float*)(w + ws::ROPE);
    float* X = (float*)(w + ws::X); float* H = (float*)(w + ws::H); float* P = (float*)(w + ws::P); float* O = (float*)(w + ws::O);
    float* GQ = (float*)(w + ws::GQ); float* GK = (float*)(w + ws::GK); float* GV = (float*)(w + ws::GV); float* GBG = (float*)(w + ws::GBG);
    float* OF = (float*)(w + ws::OF); float* OB = (float*)(w + ws::OB);
    int* list = (int*)(w + ws::LIST); float* gate = (float*)(w + ws::GATE); float* ACT = (float*)(w + ws::ACT); float* YS = (float*)(w + ws::YS);

    hipMemsetAsync(ctl, 0, 65536, stream);
    k_mods<<<DEPTH * 6144 / 256, 256, 0, stream>>>(c, c_ctx, w_mod, b_mod, mods);
    k_rope<<<L * 32 / 256, 256, 0, stream>>>(rope);
    k_initx<<<NTOK, 256, 0, stream>>>(x, ctx, X);
    for (int i = 0; i < DEPTH; ++i) {
        const int kind = i % 3, j = i / 3; const bool need_ctx = i < DEPTH - 1;
        const float* mods_l = mods + (size_t)i * 9 * 6144;
        k_normmod<<<NTOK, 256, 0, stream>>>(X, g_mix + i * D, mods_l, 0, 1, H);
        if (kind == 0) {
            k_gemm<0><<<dim3(QKV / 64, NTOK / 64), 256, 0, stream>>>(H, D, win_w_qkv + (size_t)j * D * QKV, QKV, win_b_qkv + j * QKV, P, QKV, NTOK, QKV, D, nullptr);
            k_qkpost<<<dim3(NTOK, 20), 64, 0, stream>>>(P, QKV, nullptr, nullptr, rope);
            k_attn<<<dim3(T / 64, NH, NB), 64, 0, stream>>>(P, QKV, win_sink + j * NH, WINDOW, O);
            k_gemm<1><<<dim3(D / 64, NTOK / 64), 256, 0, stream>>>(O, D, win_w_o + (size_t)j * D * D, D, win_b_o + j * D, X, D, NTOK, D, D, mods_l + 2 * 1024);
        } else if (kind == 1) {
            k_gemm<0><<<dim3(QKV / 64, NTOK / 64), 256, 0, stream>>>(H, D, glb_w_qkv + (size_t)j * D * QKV, QKV, nullptr, P, QKV, NTOK, QKV, D, nullptr);
            k_qkpost<<<dim3(NTOK, 20), 64, 0, stream>>>(P, QKV, glb_g_q + j * HD, glb_g_k + j * HD, rope);
            k_attn<<<dim3(T / 64, NH, NB), 64, 0, stream>>>(P, QKV, nullptr, -1, O);
            k_gemm<1><<<dim3(D / 64, NTOK / 64), 256, 0, stream>>>(O, D, glb_w_o + (size_t)j * D * D, D, nullptr, X, D, NTOK, D, D, mods_l + 2 * 1024);
        } else {
            k_gemm<0><<<dim3((GIN + 63) / 64, NTOK / 64), 256, 0, stream>>>(H, D, gdn_w_in + (size_t)j * D * GIN, GIN, nullptr, P, GIN, NTOK, GIN, D, nullptr);
            k_gdn_prep<<<NTOK, 256, 0, stream>>>(P, gdn_conv_w + (size_t)j * 5 * 3072, gdn_a_log + j * 16, gdn_dt_bias + j * 16, GQ, GK, GV, GBG);
            k_gdn_scan<<<dim3(NB, GH, 2), 128, 0, stream>>>(GQ, GK, GV, GBG, OF, OB);
            k_gdn_readout<<<NTOK, 256, 0, stream>>>(OF, OB, P, gdn_g_out + j * 128, O);
            k_gemm<1><<<dim3(D / 64, NTOK / 64), 256, 0, stream>>>(O, D, gdn_w_o + (size_t)j * D * D, D, nullptr, X, D, NTOK, D, D, mods_l + 2 * 1024);
        }
        int* cnt = ctl + ws::CW_CNT + i * 32; int* offs = ctl + ws::CW_OFFS + i * 64;
        k_normmod<<<NTOK, 256, 0, stream>>>(X, g_ffn + i * D, mods_l, 3, 4, H);
        k_router<<<NTOK, 256, 0, stream>>>(H, moe_w_router + (size_t)i * D * NE, moe_b_router + i * NE, need_ctx ? 0 : 1, cnt, list, gate);
        k_offs<<<1, 64, 0, stream>>>(cnt, offs);
        k_moe_up<<<dim3(D / 64, NTOK / 64, NE), 256, 0, stream>>>(H, moe_w_up + (size_t)i * NE * D * 2048, moe_b_up + (size_t)i * NE * 2048, cnt, offs, list, ACT);
        k_moe_down<<<dim3(D / 64, NTOK / 64, NE), 256, 0, stream>>>(ACT, moe_w_down + (size_t)i * NE * D * D, moe_b_down + (size_t)i * NE * D, cnt, offs, list, gate, YS);
        k_combine<<<NTOK, 256, 0, stream>>>(X, YS, mods_l, need_ctx ? 0 : 1);
    }
    k_final<<<NB * L, 256, 0, stream>>>(X, g_final, (float*)d_out);
}
```

```cpp
#include <hip/hip_runtime.h>
#include <stdint.h>
#include <cstdio>

namespace cfg {
constexpr int D = 1024, NB = 8, L = 2048, C = 256, T = L + C, NTOK = NB * T, DEPTH = 4;
constexpr int HD = 64, NH = 16, NKV = 4, QKV = 1536, WINDOW = 128;
constexpr int GH = 8, GDK = 128, GIN = 4128;
constexpr int NE = 32, TOPK = 4, CAP = NTOK;
constexpr float EPS = 1e-6f;
}
using namespace cfg;

namespace ws {
constexpr size_t al(size_t x) { return (x + 4095) & ~(size_t)4095; }
constexpr size_t CTL = 0;
constexpr size_t MODS = 65536;
constexpr size_t ROPE = al(MODS + (size_t)DEPTH * 9 * 6144 * 4);
constexpr size_t X = al(ROPE + (size_t)L * 32 * 2 * 4);
constexpr size_t H = al(X + (size_t)NTOK * D * 4);
constexpr size_t P = al(H + (size_t)NTOK * D * 4);
constexpr size_t O = al(P + (size_t)NTOK * GIN * 4);
constexpr size_t GQ = al(O + (size_t)NTOK * D * 4);
constexpr size_t GK = al(GQ + (size_t)NTOK * D * 4);
constexpr size_t GV = al(GK + (size_t)NTOK * D * 4);
constexpr size_t GBG = al(GV + (size_t)NTOK * D * 4);
constexpr size_t OF = al(GBG + (size_t)NTOK * 32 * 4);
constexpr size_t OB = al(OF + (size_t)NTOK * D * 4);
constexpr size_t LIST = al(OB + (size_t)NTOK * D * 4);
constexpr size_t GATE = al(LIST + (size_t)NE * CAP * 4);
constexpr size_t WT_UP = al(GATE + (size_t)NTOK * 4 * 4);
constexpr size_t WT_DN = al(WT_UP + (size_t)4 * 32 * 2048 * 1024 * 2);
constexpr size_t ASORT = al(WT_DN + (size_t)4 * 32 * 1024 * 1024 * 2);
constexpr size_t GDNS = ASORT;
constexpr size_t ACTB = al(ASORT + (size_t)NE * CAP * 1024 * 2);
constexpr size_t YSB = al(ACTB + (size_t)81920 * 1024 * 2);
constexpr size_t HB = al(YSB + (size_t)NTOK * 4 * 1024 * 2);
constexpr size_t QB = al(HB + (size_t)NTOK * 1024 * 2);
constexpr size_t KB = al(QB + (size_t)NTOK * 1024 * 2);
constexpr size_t VB = al(KB + (size_t)NTOK * 256 * 2);
constexpr size_t PB = al(VB + (size_t)NTOK * 256 * 2);
constexpr size_t OBF = al(PB + (size_t)NTOK * 4096 * 2);
constexpr size_t SP = al(OBF + (size_t)NTOK * 1024 * 2);
constexpr size_t WT_QKV = al(SP + (size_t)NTOK * 32 * 4);
constexpr size_t WT_O = al(WT_QKV + (size_t)3 * 1536 * 1024 * 2);
constexpr size_t WT_GIN = al(WT_O + (size_t)4 * 1024 * 1024 * 2);
constexpr size_t END = al(WT_GIN + (size_t)4096 * 1024 * 2);
constexpr int CW_CNT = 1024;
constexpr int CW_OFFS = 2048;
}

__device__ __forceinline__ int cond_row(int n) { int b = n / T, p = n % T; return p < C ? 8 : b; }
__device__ __forceinline__ float silu_f(float v) { return v / (1.f + expf(-v)); }

__device__ __forceinline__ int otid() { int t = threadIdx.x; asm volatile("" : "+v"(t)); return t; }

namespace pg8 {
#define PG8_LAS __attribute__((address_space(3)))
typedef unsigned short bf16_t;
typedef short bf16x8 __attribute__((ext_vector_type(8)));
typedef float f32x4 __attribute__((ext_vector_type(4)));
typedef unsigned u32x4 __attribute__((ext_vector_type(4)));
constexpr int BM = 256, BK = 64, HALF = 128, HTB = HALF * BK * 2  , STAGE_BYTES = 8 * HTB;
__host__ __device__ __forceinline__ int lds_byte(int r, int c) { const int st = (r >> 4) * 2 + (c >> 5), rr = r & 15, cc = c & 31, ob = rr * 64 + cc * 2; return st * 1024 + (ob ^ (((ob >> 9) & 1) << 5)); }
__host__ __device__ __forceinline__ void stage_rc(int b, int& R, int& C) { const int st = b / 1024, sb = b % 1024, swz = sb ^ (((sb >> 9) & 1) << 5); R = (st >> 1) * 16 + swz / 64; C = (st & 1) * 32 + (swz % 64) / 2; }
__host__ __device__ __forceinline__ int perm32(int rho) { const int n = rho >> 4, i = rho & 15; return 8 * (i >> 2) + 4 * n + (i & 3); }
struct Unit { const char* a; const char* b; int pm, pn, e, mt; };
__device__ __forceinline__ unsigned cvt_pk_bf16(float lo, float hi) { unsigned r; asm volatile("v_cvt_pk_bf16_f32 %0, %1, %2" : "=v"(r) : "v"(lo), "v"(hi)); return r; }
template <class Epi, class Sched, bool ALIGN_EPI = false, bool SP2 = false>
__device__ __forceinline__ void gemm_phase(PG8_LAS unsigned char* lds, const int Kdim, const Sched& S, const Epi& E) {
    const int tid = otid(), wid = __builtin_amdgcn_readfirstlane(tid >> 6), lane = tid & 63, wr = wid >> 2, wc = wid & 3, fr = lane & 15, fq = lane >> 4;
    const int K = Kdim, nt = K / BK;
    unsigned voffA[2], voffB[2];
#pragma unroll
    for (int i = 0; i < 2; ++i) { int R, C; stage_rc(tid * 16 + i * 8192, R, C); const int Rb = Epi::PERM ? ((R & ~31) + perm32(R & 31)) : R;
        voffA[i] = (unsigned)(R * K + C) * 2u; voffB[i] = (unsigned)(Rb * K + C) * 2u; }
    const size_t kstep = (size_t)(BK * 2);
    const size_t hstep = (size_t)HALF * K * 2;
    const unsigned ldsw = (unsigned)wid * 1024u;
    const int aoff = lds_byte(wr * 64 + fr, fq * 8), boff = lds_byte(wc * 32 + fr, fq * 8);
#define PG8_SA(b, h) (((b) * 2 + (h)) * HTB)
#define PG8_SB(b, h) ((4 + (b) * 2 + (h)) * HTB)
#define PG8_STAGE(bufoff, gbase, voff) do { _Pragma("unroll") for (int _i = 0; _i < 2; ++_i) \
        __builtin_amdgcn_global_load_lds((const unsigned*)((const char*)(gbase) + (voff)[_i]), (PG8_LAS unsigned*)(lds + (bufoff) + ldsw + _i * 8192), 16, 0, 0); } while (0)
#define PG8_LDA(dst, b, h) do { _Pragma("unroll") for (int m = 0; m < 4; ++m) _Pragma("unroll") for (int k = 0; k < 2; ++k) dst[m][k] = *(const PG8_LAS bf16x8*)(lds + PG8_SA(b, h) + aoff + m * 2048 + k * 1024); } while (0)
#define PG8_LDB(dst, b, h) do { _Pragma("unroll") for (int n = 0; n < 2; ++n) _Pragma("unroll") for (int k = 0; k < 2; ++k) dst[n][k] = *(const PG8_LAS bf16x8*)(lds + PG8_SB(b, h) + boff + n * 2048 + k * 1024); } while (0)
#define PG8_MMA(ai, bj, At, Bt) do { __builtin_amdgcn_s_setprio(1); _Pragma("unroll") for (int m = 0; m < 4; ++m) _Pragma("unroll") for (int n = 0; n < 2; ++n) _Pragma("unroll") for (int k = 0; k < 2; ++k) \
        acc[ai][bj][m][n] = __builtin_amdgcn_mfma_f32_16x16x32_bf16(Bt[n][k], At[m][k], acc[ai][bj][m][n], 0, 0, 0); __builtin_amdgcn_s_setprio(0); } while (0)
#define PG8_WAIT_V(n) asm volatile("s_waitcnt vmcnt(" #n ")" ::: "memory")
#define PG8_WAIT_L(n) asm volatile("s_waitcnt lgkmcnt(" #n ")" ::: "memory")
#define PG8_BAR __builtin_amdgcn_s_barrier()
#define PG8_SCHED __builtin_amdgcn_sched_barrier(0)
    Unit cur, nxt; int ui = 0;
    if (!S.next(0, cur)) return;
    f32x4 acc[2][2][4][2];
#pragma unroll
    for (int a = 0; a < 2; ++a)
#pragma unroll
        for (int b = 0; b < 2; ++b)
#pragma unroll
            for (int m = 0; m < 4; ++m)
#pragma unroll
                for (int n = 0; n < 2; ++n) acc[a][b][m][n] = (f32x4){0.f, 0.f, 0.f, 0.f};
    bf16x8 At[4][2], B0[2][2], B1[2][2];
    const char* cA = cur.a; const char* cB = cur.b;
    S.a_ready(cur);
    if constexpr (SP2) {
        PG8_STAGE(PG8_SB(0, 0), cB, voffB); PG8_STAGE(PG8_SB(0, 1), cB + hstep, voffB); PG8_STAGE(PG8_SA(0, 0), cA, voffA); PG8_STAGE(PG8_SA(0, 1), cA + hstep, voffA);
        if (wr == 1) PG8_BAR;
        PG8_WAIT_V(2); PG8_BAR;
        PG8_STAGE(PG8_SB(1, 0), cB + kstep, voffB); PG8_STAGE(PG8_SA(1, 0), cA + kstep, voffA); PG8_STAGE(PG8_SB(1, 1), cB + hstep + kstep, voffB);
        PG8_WAIT_V(6); PG8_BAR;
    } else {
        PG8_STAGE(PG8_SB(0, 0), cB, voffB); PG8_STAGE(PG8_SA(0, 0), cA, voffA); PG8_STAGE(PG8_SB(0, 1), cB + hstep, voffB); PG8_STAGE(PG8_SA(0, 1), cA + hstep, voffA);
        if (wr == 1) PG8_BAR;
        PG8_WAIT_V(4); PG8_BAR;
        PG8_STAGE(PG8_SB(1, 0), cB + kstep, voffB); PG8_STAGE(PG8_SA(1, 0), cA + kstep, voffA); PG8_STAGE(PG8_SB(1, 1), cB + hstep + kstep, voffB);
        PG8_WAIT_V(6); PG8_BAR;
    }
    for (;;) {
        const bool has_next = S.next(ui + 1, nxt);
        const char* nA = has_next ? nxt.a : cA; const char* nB = has_next ? nxt.b : cB;
        for (int t = 0; t < nt; t += 2) {
            const bool last = (t == nt - 2);
            const char* a1 = cA + (size_t)(t + 1) * kstep;
            const char* a2 = last ? nA : cA + (size_t)(t + 2) * kstep; const char* b2 = last ? nB : cB + (size_t)(t + 2) * kstep;
            const char* a3 = a2 + kstep; const char* b3 = b2 + kstep;
            if (last && has_next) S.a_ready(nxt);
            if constexpr (SP2) {
            PG8_LDB(B0, 0, 0); PG8_LDB(B1, 0, 1); PG8_SCHED; PG8_LDA(At, 0, 0); PG8_STAGE(PG8_SA(1, 1), a1 + hstep, voffA);
            PG8_WAIT_V(8); PG8_WAIT_L(0); PG8_BAR; PG8_MMA(0, 0, At, B0); PG8_MMA(0, 1, At, B1); PG8_BAR; PG8_SCHED;
            PG8_LDA(At, 0, 1); PG8_STAGE(PG8_SB(0, 0), b2, voffB); PG8_STAGE(PG8_SB(0, 1), b2 + hstep, voffB); PG8_STAGE(PG8_SA(0, 0), a2, voffA);
            PG8_WAIT_V(8); PG8_WAIT_L(0); PG8_BAR; PG8_MMA(1, 0, At, B0); PG8_MMA(1, 1, At, B1); PG8_BAR; PG8_SCHED;
            PG8_LDB(B0, 1, 0); PG8_LDB(B1, 1, 1); PG8_SCHED; PG8_LDA(At, 1, 0); PG8_STAGE(PG8_SA(0, 1), a2 + hstep, voffA);
            PG8_WAIT_V(8); PG8_WAIT_L(0); PG8_BAR; PG8_MMA(0, 0, At, B0); PG8_MMA(0, 1, At, B1); PG8_BAR; PG8_SCHED;
            PG8_LDA(At, 1, 1); PG8_STAGE(PG8_SB(1, 0), b3, voffB); PG8_STAGE(PG8_SB(1, 1), b3 + hstep, voffB); PG8_STAGE(PG8_SA(1, 0), a3, voffA);
            PG8_WAIT_V(8); PG8_WAIT_L(0); PG8_BAR; PG8_MMA(1, 0, At, B0); PG8_MMA(1, 1, At, B1); PG8_BAR; PG8_SCHED;
            } else {
            PG8_LDB(B0, 0, 0); PG8_SCHED; PG8_LDA(At, 0, 0); PG8_STAGE(PG8_SA(1, 1), a1 + hstep, voffA);
            PG8_WAIT_L(8); PG8_BAR; PG8_WAIT_L(0); PG8_MMA(0, 0, At, B0); PG8_BAR; PG8_SCHED;
            PG8_LDB(B1, 0, 1); PG8_STAGE(PG8_SB(0, 0), b2, voffB);
            PG8_BAR; PG8_WAIT_L(0); PG8_MMA(0, 1, At, B1); PG8_BAR;
            PG8_LDA(At, 0, 1); PG8_STAGE(PG8_SA(0, 0), a2, voffA);
            PG8_BAR; PG8_WAIT_L(0); PG8_MMA(1, 0, At, B0); PG8_BAR; PG8_SCHED;
            PG8_STAGE(PG8_SB(0, 1), b2 + hstep, voffB);
            PG8_WAIT_V(6); PG8_BAR; PG8_MMA(1, 1, At, B1); PG8_BAR;
            PG8_LDB(B0, 1, 0); PG8_SCHED; PG8_LDA(At, 1, 0); PG8_STAGE(PG8_SA(0, 1), a2 + hstep, voffA);
            PG8_WAIT_L(8); PG8_BAR; PG8_WAIT_L(0); PG8_MMA(0, 0, At, B0); PG8_BAR; PG8_SCHED;
            PG8_LDB(B1, 1, 1); PG8_STAGE(PG8_SB(1, 0), b3, voffB);
            PG8_BAR; PG8_WAIT_L(0); PG8_MMA(0, 1, At, B1); PG8_BAR;
            PG8_LDA(At, 1, 1); PG8_STAGE(PG8_SA(1, 0), a3, voffA);
            PG8_BAR; PG8_WAIT_L(0); PG8_MMA(1, 0, At, B0); PG8_BAR; PG8_SCHED;
            PG8_STAGE(PG8_SB(1, 1), b3 + hstep, voffB);
            PG8_WAIT_V(6); PG8_BAR; PG8_MMA(1, 1, At, B1); PG8_BAR;
            }
        }
        if constexpr (ALIGN_EPI) { if (wr == 0) PG8_BAR; }
        if constexpr (!Epi::AFTER_DRAIN) { E(acc, cur, wr, wc, fr, fq); S.done(cur); }
        if (!has_next) break;
#pragma unroll
        for (int a = 0; a < 2; ++a)
#pragma unroll
            for (int b = 0; b < 2; ++b)
#pragma unroll
                for (int m = 0; m < 4; ++m)
#pragma unroll
                    for (int n = 0; n < 2; ++n) acc[a][b][m][n] = (f32x4){0.f, 0.f, 0.f, 0.f};
        cur = nxt; cA = nA; cB = nB; ++ui;
        if constexpr (ALIGN_EPI) { if (wr == 1) PG8_BAR; }
    }
    PG8_WAIT_V(0);
    if constexpr (!ALIGN_EPI) { if (wr == 0) PG8_BAR; }
    PG8_BAR;
    if constexpr (Epi::AFTER_DRAIN) { E.fused(acc, cur, wr, wc, fr, fq, lds, wid, lane); S.done(cur); }
#undef PG8_SA
#undef PG8_SB
#undef PG8_STAGE
#undef PG8_LDA
#undef PG8_LDB
#undef PG8_MMA
#undef PG8_WAIT_V
#undef PG8_WAIT_L
#undef PG8_BAR
#undef PG8_SCHED
}
}

constexpr int NTHR = 512, LDS_BYTES = 147456, LDS_MISC = 131072;
#define LAS __attribute__((address_space(3)))
typedef unsigned short bf16_t;
typedef unsigned v4u __attribute__((ext_vector_type(4)));
typedef float f32x4 __attribute__((ext_vector_type(4)));
__device__ __forceinline__ unsigned f2bf(float f) { unsigned u = __builtin_bit_cast(unsigned, f); return (u + 0x7fffu + ((u >> 16) & 1u)) >> 16; }
__device__ __forceinline__ unsigned pk2(float lo, float hi) { return f2bf(lo) | (f2bf(hi) << 16); }
__device__ __forceinline__ float bf2f(unsigned b) { return __builtin_bit_cast(float, b << 16); }
#define LDS_WAIT() asm volatile("s_waitcnt lgkmcnt(0)" ::: "memory")

struct Params {
    const float* in[30];
    float* out;
    unsigned char* ws;
    int ph_lo; int ph_hi;
};

__device__ __forceinline__ void transpose_item(const float* W, int N, bf16_t* WT  , int k0, int nlog0, LAS float* scr, int lane) {
#pragma unroll 8
    for (int i = 0; i < 32; ++i) { const int kk = 2 * i + (lane >> 5); scr[kk * 33 + (lane & 31)] = W[(size_t)(k0 + kk) * N + nlog0 + (lane & 31)]; }
    LDS_WAIT(); asm volatile("" ::: "memory");
    const int c = lane & 7;
#pragma unroll
    for (int j = 0; j < 4; ++j) { const int n = (lane >> 3) + 8 * j; const LAS float* s = scr + (8 * c) * 33 + n;
        v4u o; o.x = pk2(s[0 * 33], s[1 * 33]); o.y = pk2(s[2 * 33], s[3 * 33]); o.z = pk2(s[4 * 33], s[5 * 33]); o.w = pk2(s[6 * 33], s[7 * 33]);
        *(v4u*)(WT + (size_t)n * 1024 + k0 + 8 * c) = o; }
    LDS_WAIT(); asm volatile("" ::: "memory");
}
__device__ __forceinline__ int upmap(int n0) { return ((n0 & 255) >> 7) * 1024 + (n0 >> 8) * 128 + (n0 & 127); }

__device__ __forceinline__ void prologue_moe_weights(const Params& p, LAS unsigned char* lds, int bid, int nb) {
    const int lane = otid() & 63, wave = otid() >> 6;
    LAS float* scr = (LAS float*)(lds + wave * 16384);
    const int gw = bid * 8 + wave, NGW = nb * 8;
    const float* w_up = p.in[25]; const float* w_dn = p.in[27];
    bf16_t* WTU = (bf16_t*)(p.ws + ws::WT_UP); bf16_t* WTD = (bf16_t*)(p.ws + ws::WT_DN);
    constexpr int IU = 128 * 1024, ID = 128 * 512;
    for (int it = gw; it < IU + ID; it += NGW) {
        if (it < IU) { const int mi = it >> 10, r = it & 1023, kb = r >> 6, nbk = r & 63, n0 = nbk * 32;
            transpose_item(w_up + (size_t)mi * 1024 * 2048, 2048, WTU + ((size_t)mi * 2048 + n0) * 1024, kb * 64, upmap(n0), scr, lane); }
        else { const int j = it - IU, mi = j >> 9, r = j & 511, kb = r >> 5, nbk = r & 31, n0 = nbk * 32;
            transpose_item(w_dn + (size_t)mi * 1024 * 1024, 1024, WTD + ((size_t)mi * 1024 + n0) * 1024, kb * 64, n0, scr, lane); }
    }
}

constexpr int TAB_TPRE = 0, TAB_OFFP = 64;
__device__ __forceinline__ void moe_tables(const int* cnt, LAS int* tab) {
    __syncthreads();
    if (otid() == 0) { int t = 0; for (int e = 0; e < 32; ++e) { tab[TAB_TPRE + e] = t; tab[TAB_OFFP + e] = t * 256; t += (cnt[e] + 255) >> 8; } tab[TAB_TPRE + 32] = t; tab[TAB_OFFP + 32] = t * 256; }
    __syncthreads();
}
template <bool UP> struct MoeOrder {
    const LAS int* tab; const char* A; const char* Bt; int c, G, total;
    static constexpr int NTN = UP ? 8 : 4;
    __device__ __forceinline__ void init(const LAS int* tab_, const void* A_, const void* Bt_, int c_, int G_) { tab = tab_; A = (const char*)A_; Bt = (const char*)Bt_; c = c_; G = G_; total = __builtin_amdgcn_readfirstlane(tab_[TAB_TPRE + 32]) * NTN; }
    __device__ __forceinline__ bool next(int i, pg8::Unit& u) const {
        const int Lx = i * G + c; if (Lx >= total) return false;
        const int tile = Lx / NTN; u.pn = Lx % NTN;
        int e = 0;
#pragma unroll
        for (int k = 1; k < 32; ++k) e += (__builtin_amdgcn_readfirstlane(tab[TAB_TPRE + k]) <= tile) ? 1 : 0;
        const int mt = tile - __builtin_amdgcn_readfirstlane(tab[TAB_TPRE + e]);
        const int offp = __builtin_amdgcn_readfirstlane(tab[TAB_OFFP + e]);
        u.e = e; u.mt = mt; u.pm = offp + mt * 256;
        const size_t arow = UP ? (size_t)e * CAP + (size_t)mt * 256 : (size_t)(offp + mt * 256);
        u.a = A + arow * 2048;
        u.b = Bt + ((size_t)e * (NTN * 256) + (size_t)u.pn * 256) * 2048;
        return true;
    }
    __device__ __forceinline__ void a_ready(const pg8::Unit&) const {}
    __device__ __forceinline__ void done(const pg8::Unit&) const {}
};
struct EpiMoeUp {
    static constexpr bool PERM = true, AFTER_DRAIN = false;
    bf16_t* ACT; const float* b_up;
    __device__ __forceinline__ void operator()(const pg8::f32x4 (&acc)[2][2][4][2], const pg8::Unit& u, int wr, int wc, int fr, int fq) const {
        const int colj = u.pn * 128 + wc * 32 + 8 * fq;
        const float* bg = b_up + u.e * 2048 + colj;
        f32x4 bgv[2], blv[2];
#pragma unroll
        for (int n = 0; n < 2; ++n) { bgv[n] = *(const f32x4*)(bg + 4 * n); blv[n] = *(const f32x4*)(bg + 1024 + 4 * n); }
#pragma unroll
        for (int ai = 0; ai < 2; ++ai)
#pragma unroll
            for (int m = 0; m < 4; ++m) {
                const int row = u.pm + ai * 128 + wr * 64 + m * 16 + fr;
                float a[8];
#pragma unroll
                for (int n = 0; n < 2; ++n)
#pragma unroll
                    for (int j = 0; j < 4; ++j) {
                        const float g = fminf(acc[ai][0][m][n][j] + bgv[n][j], 7.f);
                        const float l = fminf(fmaxf(acc[ai][1][m][n][j] + blv[n][j], -7.f), 7.f);
                        const float sg = __builtin_amdgcn_rcpf(1.f + __builtin_amdgcn_exp2f(-1.702f * 1.4426950408889634f * g));
                        a[n * 4 + j] = g * sg * (l + 1.f);
                    }
                pg8::u32x4 w; w.x = pg8::cvt_pk_bf16(a[0], a[1]); w.y = pg8::cvt_pk_bf16(a[2], a[3]); w.z = pg8::cvt_pk_bf16(a[4], a[5]); w.w = pg8::cvt_pk_bf16(a[6], a[7]);
                *(pg8::u32x4*)(ACT + (size_t)row * 1024 + colj) = w;
            }
    }
};
struct EpiMoeDown {
    static constexpr bool PERM = true, AFTER_DRAIN = false;
    bf16_t* YS; const float* b_down; const int* list; const float* gate; const int* cnt;
    __device__ __forceinline__ void operator()(const pg8::f32x4 (&acc)[2][2][4][2], const pg8::Unit& u, int wr, int wc, int fr, int fq) const {
        const int col0 = u.pn * 256 + wc * 32 + 8 * fq;
        const int M = cnt[u.e];
        f32x4 bv[2][2];
#pragma unroll
        for (int bj = 0; bj < 2; ++bj)
#pragma unroll
            for (int n = 0; n < 2; ++n) bv[bj][n] = *(const f32x4*)(b_down + u.e * 1024 + col0 + bj * 128 + 4 * n);
#pragma unroll
        for (int ai = 0; ai < 2; ++ai)
#pragma unroll
            for (int m = 0; m < 4; ++m) {
                const int r = u.mt * 256 + ai * 128 + wr * 64 + m * 16 + fr;
                if (r < M) {
                    const int slot = list[u.e * CAP + r]; const float g = gate[slot];
                    bf16_t* rowp = YS + (size_t)slot * 1024 + col0;
#pragma unroll
                    for (int bj = 0; bj < 2; ++bj) {
                        const f32x4 v0 = (acc[ai][bj][m][0] + bv[bj][0]) * g, v1 = (acc[ai][bj][m][1] + bv[bj][1]) * g;
                        pg8::u32x4 w; w.x = pg8::cvt_pk_bf16(v0[0], v0[1]); w.y = pg8::cvt_pk_bf16(v0[2], v0[3]); w.z = pg8::cvt_pk_bf16(v1[0], v1[1]); w.w = pg8::cvt_pk_bf16(v1[2], v1[3]);
                        *(pg8::u32x4*)(rowp + bj * 128) = w;
                    }
                }
            }
    }
};
__device__ __forceinline__ void moe_up_phase(const Params& p, int layer, LAS unsigned char* lds, int bid, int nb) {
    const int* cnt = (const int*)(p.ws + ws::CTL) + ws::CW_CNT + layer * 32;
    LAS int* tab = (LAS int*)(lds + LDS_MISC);
    moe_tables(cnt, tab);
    MoeOrder<true> S; S.init(tab, p.ws + ws::ASORT, (const bf16_t*)(p.ws + ws::WT_UP) + (size_t)layer * 32 * 2048 * 1024, bid, nb);
    EpiMoeUp E; E.ACT = (bf16_t*)(p.ws + ws::ACTB); E.b_up = p.in[26] + (size_t)layer * 32 * 2048;
    pg8::gemm_phase<EpiMoeUp, MoeOrder<true>, true, true>(lds, 1024, S, E);
}
__device__ __forceinline__ void moe_down_phase(const Params& p, int layer, LAS unsigned char* lds, int bid, int nb) {
    const int* cnt = (const int*)(p.ws + ws::CTL) + ws::CW_CNT + layer * 32;
    LAS int* tab = (LAS int*)(lds + LDS_MISC);
    moe_tables(cnt, tab);
    MoeOrder<false> S; S.init(tab, p.ws + ws::ACTB, (const bf16_t*)(p.ws + ws::WT_DN) + (size_t)layer * 32 * 1024 * 1024, bid, nb);
    EpiMoeDown E; E.YS = (bf16_t*)(p.ws + ws::YSB); E.b_down = p.in[28] + (size_t)layer * 32 * 1024; E.list = (const int*)(p.ws + ws::LIST); E.gate = (const float*)(p.ws + ws::GATE); E.cnt = cnt;
    pg8::gemm_phase<EpiMoeDown, MoeOrder<false>, true, true>(lds, 1024, S, E);
}

extern __shared__ __attribute__((aligned(16))) unsigned char dyn_lds[];
__global__ void __launch_bounds__(256) k_combine_b(float* X, const bf16_t* YS, const float* mods_l, int skip_ctx) {
    const int n = blockIdx.x, t = otid(), r = cond_row(n);
    if (skip_ctx && (n % T) < C) return;
    float4 x = ((float4*)(X + (size_t)n * D))[t];
    const float4 g = ((const float4*)(mods_l + (size_t)r * 6144 + 5 * 1024))[t];
    float4 s = make_float4(0.f, 0.f, 0.f, 0.f);
    for (int k = 0; k < 4; ++k) { const uint2 y = ((const uint2*)(YS + (size_t)(n * 4 + k) * D))[t];
        s.x += bf2f(y.x & 0xffffu); s.y += bf2f(y.x >> 16); s.z += bf2f(y.y & 0xffffu); s.w += bf2f(y.y >> 16); }
    x.x += g.x * s.x; x.y += g.y * s.y; x.z += g.z * s.z; x.w += g.w * s.w;
    ((float4*)(X + (size_t)n * D))[t] = x;
}

constexpr float QSCALE = 0.125f * 1.4426950408889634f;
__device__ __forceinline__ int qkvmap(int n0) { const int p = n0 & 255; return (n0 >> 8) * 256 + ((p & 127) >> 5) * 64 + (p >> 7) * 32; }

__device__ __forceinline__ void prologue_dense_weights(const Params& p, LAS unsigned char* lds, int bid, int nb) {
    const int lane = otid() & 63, wave = otid() >> 6;
    LAS float* scr = (LAS float*)(lds + wave * 16384);
    const int gw = bid * 8 + wave, NGW = nb * 8;
    bf16_t* WQ = (bf16_t*)(p.ws + ws::WT_QKV); bf16_t* WO = (bf16_t*)(p.ws + ws::WT_O); bf16_t* WG = (bf16_t*)(p.ws + ws::WT_GIN);
    constexpr int IQ = 16 * 48, IO = 16 * 32, IG = 16 * 128;
    for (int it = gw; it < 3 * IQ + 4 * IO + IG; it += NGW) {
        int r = it;
        if (r < 3 * IQ) { const int mi = r / IQ, q = r % IQ, kb = q / 48, n0 = (q % 48) * 32;
            const float* W = mi == 1 ? p.in[13] : p.in[8] + (size_t)(mi == 2 ? 1 : 0) * 1024 * 1536;
            transpose_item(W, 1536, WQ + ((size_t)mi * 1536 + n0) * 1024, kb * 64, qkvmap(n0), scr, lane); continue; }
        r -= 3 * IQ;
        if (r < 4 * IO) { const int mi = r / IO, q = r % IO, kb = q / 32, n0 = (q % 32) * 32;
            const float* W = mi == 0 ? p.in[11] : mi == 1 ? p.in[16] : mi == 2 ? p.in[22] : p.in[11] + (size_t)1024 * 1024;
            transpose_item(W, 1024, WO + ((size_t)mi * 1024 + n0) * 1024, kb * 64, n0, scr, lane); continue; }
        r -= 4 * IO;
        { const int kb = r / 128, n0 = (r % 128) * 32; transpose_item(p.in[17], 4128, WG + (size_t)n0 * 1024, kb * 64, n0, scr, lane); }
    }
}

struct DenseOrder {
    const char* A; const char* Bt; int nN, c, G, total;
    __device__ __forceinline__ void init(const void* A_, const void* Bt_, int nM, int nN_, int c_, int G_) { A = (const char*)A_; Bt = (const char*)Bt_; nN = nN_; c = c_; G = G_; total = nM * nN_; }
    __device__ __forceinline__ bool next(int i, pg8::Unit& u) const {
        const int Lx = i * G + c; if (Lx >= total) return false;
        const int grp = Lx / (8 * nN), r = Lx % (8 * nN);
        u.pm = grp * 8 + (r & 7); u.pn = r >> 3; u.e = 0; u.mt = 0;
        u.a = A + (size_t)u.pm * 256 * 2048; u.b = Bt + (size_t)u.pn * 256 * 2048;
        return true;
    }
    __device__ __forceinline__ void a_ready(const pg8::Unit&) const {}
    __device__ __forceinline__ void done(const pg8::Unit&) const {}
};

struct EpiQKV {
    static constexpr bool PERM = true, AFTER_DRAIN = false;
    bf16_t* Q; bf16_t* Kb; bf16_t* Vb; const float* bias; const float* gq; const float* gk; const float* rope;
    __device__ __forceinline__ void operator()(const pg8::f32x4 (&acc)[2][2][4][2], const pg8::Unit& u, int wr, int wc, int fr, int fq) const {
        const int kind = u.pn < 4 ? 0 : (u.pn == 4 ? 1 : 2);
        const bool latent = (u.pm % 9) != 0;
        const int lcol = u.pn * 256 + wc * 64 + 8 * fq;
        f32x4 bv[2][2], gv[2][2];
#pragma unroll
        for (int bj = 0; bj < 2; ++bj)
#pragma unroll
            for (int n = 0; n < 2; ++n) {
                bv[bj][n] = bias ? *(const f32x4*)(bias + lcol + bj * 32 + 4 * n) : (f32x4){0.f, 0.f, 0.f, 0.f};
                const float* g = kind == 0 ? gq : gk;
                gv[bj][n] = (g && kind < 2) ? *(const f32x4*)(g + 8 * fq + bj * 32 + 4 * n) : (f32x4){1.f, 1.f, 1.f, 1.f};
            }
        const bool donorm = (gq != nullptr) && kind < 2;
        const bool dorope = latent && kind < 2;
        const int second = fq >> 1, fbase = 8 * (fq & 1);
        bf16_t* base = kind == 0 ? Q : (kind == 1 ? Kb : Vb);
        const int opitch = kind == 0 ? 1024 : 256;
        const int ocol = (kind == 0 ? u.pn * 256 : 0) + wc * 64 + 8 * fq;
#pragma unroll
        for (int ai = 0; ai < 2; ++ai)
#pragma unroll
            for (int m = 0; m < 4; ++m) {
                const int row = u.pm * 256 + ai * 128 + wr * 64 + m * 16 + fr;
                f32x4 x[2][2];
#pragma unroll
                for (int bj = 0; bj < 2; ++bj)
#pragma unroll
                    for (int n = 0; n < 2; ++n) x[bj][n] = acc[ai][bj][m][n] + bv[bj][n];
                if (donorm) {
                    float ss = 0.f;
#pragma unroll
                    for (int bj = 0; bj < 2; ++bj)
#pragma unroll
                        for (int n = 0; n < 2; ++n) ss += (x[bj][n][0] * x[bj][n][0] + x[bj][n][1] * x[bj][n][1]) + (x[bj][n][2] * x[bj][n][2] + x[bj][n][3] * x[bj][n][3]);
                    ss += __shfl_xor(ss, 16); ss += __shfl_xor(ss, 32);
                    const float rs = rsqrtf(ss * (1.f / 64.f) + EPS);
#pragma unroll
                    for (int bj = 0; bj < 2; ++bj)
#pragma unroll
                        for (int n = 0; n < 2; ++n) x[bj][n] = x[bj][n] * rs * gv[bj][n];
                }
                if (dorope) {
                    const int l = row % T - C;
                    const float* cp = rope + (size_t)l * 32 + fbase; const float* sp = cp + L * 32;
#pragma unroll
                    for (int bj = 0; bj < 2; ++bj)
#pragma unroll
                        for (int n = 0; n < 2; ++n) {
                            const f32x4 cs = *(const f32x4*)(cp + bj * 16 + 4 * n), sn = *(const f32x4*)(sp + bj * 16 + 4 * n);
                            f32x4 o;
#pragma unroll
                            for (int j = 0; j < 4; ++j) { const float other = __shfl_xor(x[bj][n][j], 32); o[j] = second ? (x[bj][n][j] * cs[j] + other * sn[j]) : (x[bj][n][j] * cs[j] - other * sn[j]); }
                            x[bj][n] = o;
                        }
                }
                const float sc = kind == 0 ? QSCALE : 1.f;
                bf16_t* rowp = base + (size_t)row * opitch + ocol;
#pragma unroll
                for (int bj = 0; bj < 2; ++bj) {
                    const f32x4 v0 = x[bj][0] * sc, v1 = x[bj][1] * sc;
                    pg8::u32x4 w; w.x = pg8::cvt_pk_bf16(v0[0], v0[1]); w.y = pg8::cvt_pk_bf16(v0[2], v0[3]); w.z = pg8::cvt_pk_bf16(v1[0], v1[1]); w.w = pg8::cvt_pk_bf16(v1[2], v1[3]);
                    *(pg8::u32x4*)(rowp + bj * 32) = w;
                }
            }
    }
};
struct EpiPlainBf16 {
    static constexpr bool PERM = true, AFTER_DRAIN = false;
    bf16_t* O; int ldc;
    __device__ __forceinline__ void operator()(const pg8::f32x4 (&acc)[2][2][4][2], const pg8::Unit& u, int wr, int wc, int fr, int fq) const {
        const int col0 = u.pn * 256 + wc * 32 + 8 * fq;
#pragma unroll
        for (int ai = 0; ai < 2; ++ai)
#pragma unroll
            for (int m = 0; m < 4; ++m) { bf16_t* rowp = O + (size_t)(u.pm * 256 + ai * 128 + wr * 64 + m * 16 + fr) * ldc + col0;
#pragma unroll
                for (int bj = 0; bj < 2; ++bj) { const f32x4 v0 = acc[ai][bj][m][0], v1 = acc[ai][bj][m][1];
                    pg8::u32x4 w; w.x = pg8::cvt_pk_bf16(v0[0], v0[1]); w.y = pg8::cvt_pk_bf16(v0[2], v0[3]); w.z = pg8::cvt_pk_bf16(v1[0], v1[1]); w.w = pg8::cvt_pk_bf16(v1[2], v1[3]);
                    *(pg8::u32x4*)(rowp + bj * 128) = w; } }
    }
};
struct EpiResid {
    static constexpr bool PERM = false, AFTER_DRAIN = false;
    float* X; const float* bias; const float* gate;
    __device__ __forceinline__ void operator()(const pg8::f32x4 (&acc)[2][2][4][2], const pg8::Unit& u, int wr, int wc, int fr, int fq) const {
        const int col0 = u.pn * 256 + wc * 32 + 4 * fq;
        const int cr = (u.pm % 9) == 0 ? 8 : u.pm / 9;
        f32x4 bv[2][2], gv[2][2];
#pragma unroll
        for (int bj = 0; bj < 2; ++bj)
#pragma unroll
            for (int n = 0; n < 2; ++n) { const int c = col0 + bj * 128 + 16 * n;
                bv[bj][n] = bias ? *(const f32x4*)(bias + c) : (f32x4){0.f, 0.f, 0.f, 0.f}; gv[bj][n] = *(const f32x4*)(gate + (size_t)cr * 6144 + c); }
#pragma unroll
        for (int ai = 0; ai < 2; ++ai)
#pragma unroll
            for (int m = 0; m < 4; ++m) { float* rowp = X + (size_t)(u.pm * 256 + ai * 128 + wr * 64 + m * 16 + fr) * 1024 + col0;
#pragma unroll
                for (int bj = 0; bj < 2; ++bj)
#pragma unroll
                    for (int n = 0; n < 2; ++n) { f32x4* ptr = (f32x4*)(rowp + bj * 128 + 16 * n); *ptr = *ptr + gv[bj][n] * (acc[ai][bj][m][n] + bv[bj][n]); } }
    }
};
__device__ __forceinline__ int qkv_slot(int layer) { return layer == 0 ? 0 : (layer == 1 ? 1 : 2); }
__device__ __forceinline__ void qkv_phase(const Params& p, int layer, LAS unsigned char* lds, int bid, int nb) {
    DenseOrder S; S.init(p.ws + ws::HB, (const bf16_t*)(p.ws + ws::WT_QKV) + (size_t)qkv_slot(layer) * 1536 * 1024, 72, 6, bid, nb);
    EpiQKV E; E.Q = (bf16_t*)(p.ws + ws::QB); E.Kb = (bf16_t*)(p.ws + ws::KB); E.Vb = (bf16_t*)(p.ws + ws::VB); E.rope = (const float*)(p.ws + ws::ROPE);
    if (layer == 1) { E.bias = nullptr; E.gq = p.in[14]; E.gk = p.in[15]; } else { E.bias = p.in[9] + (layer == 3 ? 1536 : 0); E.gq = nullptr; E.gk = nullptr; }
    pg8::gemm_phase<EpiQKV, DenseOrder, true, true>(lds, 1024, S, E);
}
__device__ __forceinline__ void gin_phase(const Params& p, LAS unsigned char* lds, int bid, int nb) {
    DenseOrder S; S.init(p.ws + ws::HB, p.ws + ws::WT_GIN, 72, 16, bid, nb);
    EpiPlainBf16 E; E.O = (bf16_t*)(p.ws + ws::PB); E.ldc = 4096;
    pg8::gemm_phase<EpiPlainBf16, DenseOrder, true, true>(lds, 1024, S, E);
}
__device__ __forceinline__ void oproj_phase(const Params& p, int layer, LAS unsigned char* lds, int bid, int nb) {
    DenseOrder S; S.init(p.ws + ws::OBF, (const bf16_t*)(p.ws + ws::WT_O) + (size_t)layer * 1024 * 1024, 72, 4, bid, nb);
    EpiResid E; E.X = (float*)(p.ws + ws::X); E.bias = layer == 0 ? p.in[12] : (layer == 3 ? p.in[12] + 1024 : nullptr);
    E.gate = (const float*)(p.ws + ws::MODS) + (size_t)layer * 9 * 6144 + 2 * 1024;
    pg8::gemm_phase<EpiResid, DenseOrder, true, true>(lds, 1024, S, E);
}

#include <hip/hip_bf16.h>
#include <cmath>
namespace attn_body {
using bf16=__hip_bfloat16;
using bf16x8=__attribute__((ext_vector_type(8)))short;
using s16x4=__attribute__((ext_vector_type(4)))short;
using f32x16=__attribute__((ext_vector_type(16)))float;
using u32x4=__attribute__((ext_vector_type(4)))unsigned;
constexpr int D=64,DM=1024,KVP=256;
constexpr int NW=8,QBLK=32,KVBLK=64;
__device__ __forceinline__ int crow(int r,int hi){return (r&3)+8*(r>>2)+4*hi;}
#define SBAR() __builtin_amdgcn_sched_barrier(0)
__device__ __forceinline__ void wmask(f32x16&p0,f32x16&p1,int kv0,int qi,int hi){
  const float NEG=-INFINITY; const int dlt=kv0+4*hi-qi;
  #pragma unroll
  for(int r=0;r<16;++r){const int d0=dlt+(r&3)+8*(r>>2); if(d0>128||d0<-128)p0[r]=NEG; if(d0+32>128||d0+32<-128)p1[r]=NEG;}
}

constexpr int NSLOT=3, SLOTB=8192;
constexpr int LDS_K=0, LDS_V=NSLOT*SLOTB, LDS_WS=2*NSLOT*SLOTB, LDS_OST=LDS_WS+NW*64*4, LDS_BYTES=LDS_OST+NW*4096;
constexpr float C2=0.125f*1.4426950408889634f;
__device__ __forceinline__ void glds16(const void*gsrc,unsigned lds_dst){unsigned keep;
  asm volatile("s_mov_b32 %0, m0\n\ts_mov_b32 m0, %2\n\ts_nop 0\n\tglobal_load_lds_dwordx4 %1, off\n\ts_mov_b32 m0, %0":"=&s"(keep):"v"(gsrc),"s"(lds_dst):"memory");}
__device__ __forceinline__ float max3f(float a,float b,float c){float r;asm("v_max3_f32 %0, %1, %2, %3":"=v"(r):"v"(a),"v"(b),"v"(c));return r;}
__device__ __forceinline__ float max2f(float a,float b){float r;asm("v_max_f32_e32 %0, %1, %2":"=v"(r):"v"(a),"v"(b));return r;}
__device__ __forceinline__ float fadd_s(float a,float b){float r;asm("v_add_f32_e32 %0, %1, %2":"=v"(r):"v"(a),"v"(b));return r;}
__device__ __forceinline__ float fsub_s(float a,float b){float r;asm("v_sub_f32_e32 %0, %1, %2":"=v"(r):"v"(a),"v"(b));return r;}
typedef float f32x2_t __attribute__((ext_vector_type(2))); typedef __bf16 bf16x2_t __attribute__((ext_vector_type(2)));
__device__ __forceinline__ unsigned cvtpk_s(float lo,float hi){f32x2_t v={lo,hi};bf16x2_t b=__builtin_convertvector(v,bf16x2_t);return __builtin_bit_cast(unsigned,b);}
#define WAIT_BAR(N) asm volatile("s_waitcnt vmcnt(" #N ") lgkmcnt(0)\n\ts_barrier":::"memory")

__device__ __forceinline__ void qkt(f32x16&p0,f32x16&p1,const char*Kslot,const bf16x8*qr,const f32x16&negm,int r32,int hi){
  const char*kb=Kslot+hi*1024+r32*16;
  #pragma unroll
  for(int d0=0;d0<4;++d0){
    const bf16x8 b0=*reinterpret_cast<const bf16x8*>(kb+d0*2048);
    const bf16x8 b1=*reinterpret_cast<const bf16x8*>(kb+d0*2048+512);
    if(d0==0){p0=__builtin_amdgcn_mfma_f32_32x32x16_bf16(b0,qr[0],negm,0,0,0);p1=__builtin_amdgcn_mfma_f32_32x32x16_bf16(b1,qr[0],negm,0,0,0);}
    else{p0=__builtin_amdgcn_mfma_f32_32x32x16_bf16(b0,qr[d0],p0,0,0,0);p1=__builtin_amdgcn_mfma_f32_32x32x16_bf16(b1,qr[d0],p1,0,0,0);}}
}
typedef __attribute__((address_space(3))) const char* lds_cptr;
typedef short v4i16_t __attribute__((ext_vector_type(4)));
__device__ __forceinline__ void kload8(bf16x8*kf,lds_cptr kp){
  kf[0]=*(const __attribute__((address_space(3))) bf16x8*)(kp);      kf[1]=*(const __attribute__((address_space(3))) bf16x8*)(kp+512);
  kf[2]=*(const __attribute__((address_space(3))) bf16x8*)(kp+2048); kf[3]=*(const __attribute__((address_space(3))) bf16x8*)(kp+2560);
  kf[4]=*(const __attribute__((address_space(3))) bf16x8*)(kp+4096); kf[5]=*(const __attribute__((address_space(3))) bf16x8*)(kp+4608);
  kf[6]=*(const __attribute__((address_space(3))) bf16x8*)(kp+6144); kf[7]=*(const __attribute__((address_space(3))) bf16x8*)(kp+6656);
}
__device__ __forceinline__ void kload2(bf16x8*kf,lds_cptr kp,int j){ kf[2*j]=*(const __attribute__((address_space(3))) bf16x8*)(kp+j*2048); kf[2*j+1]=*(const __attribute__((address_space(3))) bf16x8*)(kp+j*2048+512); }
__device__ __forceinline__ s16x4 vtr(lds_cptr p){ return __builtin_bit_cast(s16x4,__builtin_amdgcn_ds_read_tr16_b64_v4i16((__attribute__((address_space(3))) v4i16_t*)p)); }
__device__ __forceinline__ float rowmax(const f32x16&p0,const f32x16&p1){
  float a=max3f(p0[0],p0[1],p1[0]),b=max3f(p0[2],p0[3],p1[1]);a=max3f(a,p1[2],p1[3]);
  #pragma unroll
  for(int r=4;r<16;r+=4){a=max3f(a,p0[r],p0[r+1]);b=max3f(b,p0[r+2],p0[r+3]);a=max3f(a,p1[r],p1[r+1]);b=max3f(b,p1[r+2],p1[r+3]);}
  const float m=max2f(a,b);
  auto rr=__builtin_amdgcn_permlane32_swap(__float_as_uint(m),__float_as_uint(m),false,false);
  return max2f(__uint_as_float(rr[0]),__uint_as_float(rr[1]));
}
__device__ __forceinline__ void pv(f32x16*o,int vb,bf16x8 pa0,bf16x8 pa1,bf16x8 pa2,bf16x8 pa3){
  #pragma unroll
  for(int d0=0;d0<2;++d0){s16x4 lo[4],hi[4];
    #pragma unroll
    for(int ks=0;ks<4;++ks){
      asm volatile("ds_read_b64_tr_b16 %0,%1 offset:%c2":"=&v"(lo[ks]):"v"(vb),"i"(d0*4096+ks*1024):"memory");
      asm volatile("ds_read_b64_tr_b16 %0,%1 offset:%c2":"=&v"(hi[ks]):"v"(vb),"i"(d0*4096+ks*1024+512):"memory");}
    asm volatile("s_waitcnt lgkmcnt(0)":::"memory");SBAR();
    #define PK(k) (bf16x8){lo[k][0],lo[k][1],lo[k][2],lo[k][3],hi[k][0],hi[k][1],hi[k][2],hi[k][3]}
    o[d0]=__builtin_amdgcn_mfma_f32_32x32x16_bf16(pa0,PK(0),o[d0],0,0,0);
    o[d0]=__builtin_amdgcn_mfma_f32_32x32x16_bf16(pa1,PK(1),o[d0],0,0,0);
    o[d0]=__builtin_amdgcn_mfma_f32_32x32x16_bf16(pa2,PK(2),o[d0],0,0,0);
    o[d0]=__builtin_amdgcn_mfma_f32_32x32x16_bf16(pa3,PK(3),o[d0],0,0,0);
    #undef PK
  }
}

#ifndef ATTN_STORE16
#define ATTN_STORE16(p,v) (*(u32x4*)(p)=(v))
#endif
template<int THRL> __device__ __forceinline__ void attn_unit(long qrow,int h0,int kvh,long krow,int j0,int NT,bool win,int i0,const float*sink,const bf16*Q,const bf16*__restrict__ K,const bf16*__restrict__ V,bf16*O,char*shm){
  int tid=otid();
  const int lane=tid&63,r32=lane&31,hi=lane>>5; const int wid=__builtin_amdgcn_readfirstlane(tid>>6);
  const int hh=h0+(wid>>2);
  const bf16*Qw=Q+(qrow+(wid&3)*QBLK)*DM+hh*D;
  const bf16*Kh=K+krow*KVP+kvh*D,*Vh=V+krow*KVP+kvh*D;
  const unsigned lds0=(unsigned)(uintptr_t)shm;
  float*wsf=(float*)(shm+LDS_WS)+wid*64;
  const bf16*ksrc=Kh+(long)lane*KVP+wid*8;
  const bf16*vsrc=Vh+(long)(16*(wid&3)+(lane>>2))*KVP+(wid>>2)*32+(lane&3)*8;
  const unsigned kdst=lds0+LDS_K+wid*1024, vdst=lds0+LDS_V+wid*1024;
  #define TROW(t) ((t)<4?64*(t):256+64*(j0+(t)-4))
  #define DMA_K(t,slot) glds16(ksrc+(long)TROW(t)*KVP,(unsigned)__builtin_amdgcn_readfirstlane(kdst+(slot)))
  #define DMA_V(t,slot) glds16(vsrc+(long)TROW(t)*KVP,(unsigned)__builtin_amdgcn_readfirstlane(vdst+(slot)))
  const int vb0=(int)(lds0+LDS_V)+((lane>>4)&1)*32+(lane&3)*8+(4*hi+((lane&15)>>2))*64;
  const char*Kbase=shm+LDS_K; bf16x8 kf[8];
  const lds_cptr shm3=(lds_cptr)shm; const lds_cptr kp0=shm3+LDS_K+hi*1024+r32*16; const lds_cptr vp0=shm3+LDS_V+((lane>>4)&1)*32+(lane&3)*8+(4*hi+((lane&15)>>2))*64;
  DMA_K(0,0);DMA_V(0,0);DMA_K(1,SLOTB);
  bf16x8 qr[4];
  #pragma unroll
  for(int d0=0;d0<4;++d0)qr[d0]=*reinterpret_cast<const bf16x8*>(&Qw[(long)r32*DM+d0*16+hi*8]);
  float mhat=0.f,l_reg=0.f;f32x16 o[2];o[0]=f32x16{};o[1]=f32x16{};f32x16 negm=f32x16{};asm volatile("":"+v"(negm));
  const int qi=i0+(wid&3)*QBLK+r32;
  #define CMASK(P0,P1,t) do{ if(win&&(t)>=4)wmask(P0,P1,64*(j0+(t)-4),qi,hi); }while(0)
  bool resc=false;
  #define START(P0,P1) do{ const float rm=rowmax(P0,P1); resc=false; \
    { const float dl=rm; mhat=fadd_s(mhat,dl); \
      _Pragma("unroll") for(int r=0;r<16;++r){P0[r]=fsub_s(P0[r],dl);P1[r]=fsub_s(P1[r],dl);} \
      _Pragma("unroll") for(int r=0;r<16;++r)negm[r]=-mhat; asm volatile("":"+v"(negm)); } \
    _Pragma("unroll") for(int r=0;r<16;++r)P0[r]=__builtin_amdgcn_exp2f(P0[r]); }while(0)
  #define RESC() do{ if(resc){ asm volatile("s_waitcnt lgkmcnt(0)":::"memory"); \
      _Pragma("unroll") for(int d_=0;d_<2;++d_) _Pragma("unroll") for(int r=0;r<16;++r)o[d_][r]*=wsf[crow(r,hi)]; } }while(0)
  f32x16 pA0,pA1,pB0,pB1;
  int sl_prev=0,sl_cur=0,sl_next=SLOTB;
  #define ROT() do{sl_prev=sl_cur;sl_cur=sl_next;sl_next=(sl_next==(NSLOT-1)*SLOTB)?0:sl_next+SLOTB;}while(0)
  DMA_K(2,2*SLOTB);
  WAIT_BAR(3);
  qkt(pA0,pA1,Kbase,qr,negm,r32,hi);asm volatile("s_nop 15\n\ts_nop 7":"+v"(pA0),"+v"(pA1));CMASK(pA0,pA1,0);
  START(pA0,pA1);
  _Pragma("unroll") for(int r=0;r<16;++r)pA1[r]=__builtin_amdgcn_exp2f(pA1[r]);
  WAIT_BAR(0);
  DMA_K(3,0);DMA_V(1,SLOTB);
  ROT();
  kload8(kf,kp0+sl_cur);
  WAIT_BAR(2);
  s16x4 vlo[8],vhi[8]; u32x4 pw0,pw1,pw2,pw3;
  #define PKW(P,B) cvtpk_s(P[B],P[B+1])
  #define PAF(k) __builtin_bit_cast(bf16x8,pw##k)
  #define VFR(i) (bf16x8){vlo[i][0],vlo[i][1],vlo[i][2],vlo[i][3],vhi[i][0],vhi[i][1],vhi[i][2],vhi[i][3]}
  #define PIN(x) asm volatile("":"+v"(x))
  #define MX3(a,b,c) __builtin_fmaxf(__builtin_fmaxf((a),(b)),(c))
  #define GAPA(MF,A0,A1,A2,A3,W0,W1,PW) do{ MF; sacc+=A0; sacc+=A1; sacc+=A2; sacc+=A3; PIN(sacc); W0; W1; PIN(PW); SBAR(); }while(0)
  #define EX(v) __builtin_amdgcn_exp2f(v)
  #define GAPB(MF,X,B) do{ MF; X[B]=EX(X[B]); X[B+1]=EX(X[B+1]); X[B+2]=EX(X[B+2]); X[B+3]=EX(X[B+3]); PIN(X); SBAR(); }while(0)
  #define VRD(i) do{ vlo[i]=vtr(vp_+(((i)>>2)*4096+((i)&3)*1024)); vhi[i]=vtr(vp_+(((i)>>2)*4096+((i)&3)*1024+512)); }while(0)
  #define KRD(G,j) do{ if(G){ kload2(kf,kp0+sl_next,j); SBAR(); } }while(0)
  #define STEP(C0,C1,P0,P1,t,GK,GV,GL) do{ SBAR(); \
    const lds_cptr vp_=vp0+sl_prev; \
    VRD(0); SBAR(); float sacc=(P0[0]+P0[1]); \
    GAPA(C0=__builtin_amdgcn_mfma_f32_32x32x16_bf16(kf[0],qr[0],negm,0,0,0), P0[2],P0[3],P0[4],P0[5],     pw0[0]=PKW(P0,0), pw0[1]=PKW(P0,2), pw0); \
    VRD(4); SBAR(); GAPA(C1=__builtin_amdgcn_mfma_f32_32x32x16_bf16(kf[1],qr[0],negm,0,0,0), P0[6],P0[7],P0[8],P0[9],     pw0[2]=PKW(P0,4), pw0[3]=PKW(P0,6), pw0); \
    VRD(1); SBAR(); GAPA(C0=__builtin_amdgcn_mfma_f32_32x32x16_bf16(kf[2],qr[1],C0,0,0,0),   P0[10],P0[11],P0[12],P0[13], pw1[0]=PKW(P0,8), pw1[1]=PKW(P0,10), pw1); \
    VRD(5); SBAR(); GAPA(C1=__builtin_amdgcn_mfma_f32_32x32x16_bf16(kf[3],qr[1],C1,0,0,0),   P0[14],P0[15],P1[0],P1[1],   pw1[2]=PKW(P0,12),pw1[3]=PKW(P0,14), pw1); \
    VRD(2); SBAR(); GAPA(C0=__builtin_amdgcn_mfma_f32_32x32x16_bf16(kf[4],qr[2],C0,0,0,0),   P1[2],P1[3],P1[4],P1[5],     pw2[0]=PKW(P1,0), pw2[1]=PKW(P1,2), pw2); \
    VRD(6); SBAR(); GAPA(C1=__builtin_amdgcn_mfma_f32_32x32x16_bf16(kf[5],qr[2],C1,0,0,0),   P1[6],P1[7],P1[8],P1[9],     pw2[2]=PKW(P1,4), pw2[3]=PKW(P1,6), pw2); \
    VRD(3); SBAR(); GAPA(C0=__builtin_amdgcn_mfma_f32_32x32x16_bf16(kf[6],qr[3],C0,0,0,0),   P1[10],P1[11],P1[12],P1[13], pw3[0]=PKW(P1,8), pw3[1]=PKW(P1,10), pw3); \
    VRD(7); SBAR(); GAPA(C1=__builtin_amdgcn_mfma_f32_32x32x16_bf16(kf[7],qr[3],C1,0,0,0),   P1[14],P1[15],0.f,0.f,       pw3[2]=PKW(P1,12),pw3[3]=PKW(P1,14), pw3); \
    l_reg+=sacc; \
    if(GK){DMA_K((t)+3,sl_cur);} if(GV){DMA_V((t)+1,sl_next);} \
    CMASK(C0,C1,t); \
    { float a=MX3(C0[0],C0[1],C1[0]),b=MX3(C0[2],C0[3],C1[1]); a=MX3(a,C1[2],C1[3]); \
      _Pragma("unroll") for(int r=4;r<16;r+=4){a=MX3(a,C0[r],C0[r+1]);b=MX3(b,C0[r+2],C0[r+3]);a=MX3(a,C1[r],C1[r+1]);b=MX3(b,C1[r+2],C1[r+3]);} \
      float rm=__builtin_fmaxf(a,b); { auto rr=__builtin_amdgcn_permlane32_swap(__float_as_uint(rm),__float_as_uint(rm),false,false); rm=__builtin_fmaxf(__uint_as_float(rr[0]),__uint_as_float(rr[1])); } \
      resc=false; \
      if(__builtin_expect(__any(rm>(float)THRL),0)){ const float dl=__builtin_fmaxf(rm,0.f); mhat+=dl; \
        _Pragma("unroll") for(int r=0;r<16;++r){C0[r]-=dl;C1[r]-=dl;} \
        _Pragma("unroll") for(int r=0;r<16;++r)negm[r]=-mhat; asm volatile("":"+v"(negm)); \
        const float f=__builtin_amdgcn_exp2f(-dl); l_reg*=f; if(hi==0)wsf[r32]=f; resc=true; } } \
    SBAR(); \
    GAPB(o[0]=__builtin_amdgcn_mfma_f32_32x32x16_bf16(PAF(0),VFR(0),o[0],0,0,0), C0,0); \
    GAPB(o[1]=__builtin_amdgcn_mfma_f32_32x32x16_bf16(PAF(0),VFR(4),o[1],0,0,0), C0,4); \
    KRD(GL,0); GAPB(o[0]=__builtin_amdgcn_mfma_f32_32x32x16_bf16(PAF(1),VFR(1),o[0],0,0,0), C0,8); \
    KRD(GL,1); GAPB(o[1]=__builtin_amdgcn_mfma_f32_32x32x16_bf16(PAF(1),VFR(5),o[1],0,0,0), C0,12); \
    KRD(GL,2); GAPB(o[0]=__builtin_amdgcn_mfma_f32_32x32x16_bf16(PAF(2),VFR(2),o[0],0,0,0), C1,0); \
    KRD(GL,3); GAPB(o[1]=__builtin_amdgcn_mfma_f32_32x32x16_bf16(PAF(2),VFR(6),o[1],0,0,0), C1,4); \
    GAPB(o[0]=__builtin_amdgcn_mfma_f32_32x32x16_bf16(PAF(3),VFR(3),o[0],0,0,0), C1,8); \
    GAPB(o[1]=__builtin_amdgcn_mfma_f32_32x32x16_bf16(PAF(3),VFR(7),o[1],0,0,0), C1,12); \
    }while(0)
  int t=1;
  for(;t+5<NT;t+=2){
    STEP(pB0,pB1,pA0,pA1,t,true,true,true);     WAIT_BAR(2); RESC(); ROT();
    STEP(pA0,pA1,pB0,pB1,t+1,true,true,true);   WAIT_BAR(2); RESC(); ROT();
  }
  #define ENDW(tt) do{ if((tt)+3<NT){WAIT_BAR(2);} else if((tt)+2<NT){WAIT_BAR(1);} else {WAIT_BAR(0);} }while(0)
  for(;t+1<NT;t+=2){
    STEP(pB0,pB1,pA0,pA1,t,(t+3<NT),(t+1<NT),(t+1<NT));       ENDW(t);   RESC(); ROT();
    STEP(pA0,pA1,pB0,pB1,t+1,(t+4<NT),(t+2<NT),(t+2<NT));     ENDW(t+1); RESC(); ROT();
  }
  STEP(pB0,pB1,pA0,pA1,NT-1,false,false,false); RESC();
  { float sacc=pB0[0]+pB0[1]; _Pragma("unroll") for(int r=2;r<16;++r)sacc+=pB0[r]; _Pragma("unroll") for(int r=0;r<16;++r)sacc+=pB1[r]; l_reg+=sacc;
    pw0=(u32x4){PKW(pB0,0),PKW(pB0,2),PKW(pB0,4),PKW(pB0,6)};pw1=(u32x4){PKW(pB0,8),PKW(pB0,10),PKW(pB0,12),PKW(pB0,14)};pw2=(u32x4){PKW(pB1,0),PKW(pB1,2),PKW(pB1,4),PKW(pB1,6)};pw3=(u32x4){PKW(pB1,8),PKW(pB1,10),PKW(pB1,12),PKW(pB1,14)};
    SBAR(); pv(o,vb0+sl_cur,PAF(0),PAF(1),PAF(2),PAF(3)); }
  #undef PKW
  #undef PAF
  #undef VFR
  #undef PIN
  #undef MX3
  #undef GAPA
  #undef GAPB
  #undef EX
  #undef VRD
  #undef KRD
  #undef STEP
  #undef ENDW
  {auto rr=__builtin_amdgcn_permlane32_swap(__float_as_uint(l_reg),__float_as_uint(l_reg),false,false);l_reg=__uint_as_float(rr[0])+__uint_as_float(rr[1]);}
  if(sink)l_reg+=__builtin_amdgcn_exp2f(sink[hh]*1.4426950408889634f-mhat);
  if(hi==0)wsf[32+r32]=l_reg;asm volatile("s_waitcnt lgkmcnt(0)":::"memory");
  float rli[16];
  #pragma unroll
  for(int r=0;r<16;++r)rli[r]=__builtin_amdgcn_rcpf(wsf[32+crow(r,hi)]);
  bf16*Ow=O+(qrow+(wid&3)*QBLK)*DM+hh*D;
  { bf16*stg=(bf16*)(shm+LDS_OST)+wid*2048;
    #pragma unroll
    for(int r=0;r<16;++r){const int orow=crow(r,hi);
      #pragma unroll
      for(int d0=0;d0<2;++d0)stg[orow*64+d0*32+r32]=__float2bfloat16(o[d0][r]*rli[r]);}
    asm volatile("s_waitcnt lgkmcnt(0)":::"memory");
    #pragma unroll
    for(int i=0;i<4;++i){const int row=i*8+(lane>>3),ch=lane&7; const u32x4 v=*(const u32x4*)(stg+row*64+ch*8); ATTN_STORE16(Ow+(long)row*DM+ch*8,v);} }
  asm volatile("s_waitcnt lgkmcnt(0)\n\ts_barrier":::"memory");
  #undef DMA_K
  #undef TROW
  #undef DMA_V
  #undef CMASK
  #undef START
  #undef RESC
  #undef ROT
}
constexpr int ATTN_LDS_BYTES=LDS_BYTES;
#undef SBAR
#undef WAIT_BAR
}
__device__ __forceinline__ void attn_phase_fn(const Params& p, int layer, LAS unsigned char* lds, int bid, int nb) {
    using attn_body::bf16;
    const bf16* Q = (const bf16*)(p.ws + ws::QB); const bf16* K = (const bf16*)(p.ws + ws::KB); const bf16* V = (const bf16*)(p.ws + ws::VB); bf16* O = (bf16*)(p.ws + ws::OBF);
    const bool win = layer != 1; const bool need_ctx = layer < 3;
    const float* sink = win ? p.in[10] + (layer == 3 ? 16 : 0) : nullptr;
    char* shm = (char*)lds;
    for (int u = bid; u < 1024; u += nb) {
        const int b = u & 7, idx = u >> 3, hp = idx >> 4, qblk = idx & 15;
        const int i0 = qblk * 128;
        int j0 = 0, NT = 36;
        if (win) { const int jlo = max(0, i0 / 64 - 2), jhi = min(31, i0 / 64 + 3); j0 = jlo; NT = 4 + jhi - jlo + 1; }
        attn_body::attn_unit<8>((long)b * T + C + i0, hp * 2, hp >> 1, (long)b * T, j0, NT, win, i0, sink, Q, K, V, O, shm);
    }
    if (need_ctx) for (int u = bid; u < 128; u += nb) {
        const int b = u & 7, idx = u >> 3, hp = idx >> 1, qblk = idx & 1;
        attn_body::attn_unit<8>((long)b * T + qblk * 128, hp * 2, hp >> 1, (long)b * T, 0, 4, false, 0, sink, Q, K, V, O, shm);
    }
}

namespace gdn {
typedef short bf16x8 __attribute__((ext_vector_type(8)));
typedef short bf16x4 __attribute__((ext_vector_type(4)));
typedef float f32x4 __attribute__((ext_vector_type(4)));
typedef float f32x2_t __attribute__((ext_vector_type(2))); typedef __bf16 bf16x2_t __attribute__((ext_vector_type(2)));
__device__ __forceinline__ unsigned cvtpk(float lo, float hi) { f32x2_t v = {lo, hi}; bf16x2_t b = __builtin_convertvector(v, bf16x2_t); return __builtin_bit_cast(unsigned, b); }
__device__ __forceinline__ float bfl(unsigned u) { return __builtin_bit_cast(float, u << 16); }
__device__ __forceinline__ float bfh(unsigned u) { return __builtin_bit_cast(float, u & 0xffff0000u); }
#define MFMA16(a, b, c) __builtin_amdgcn_mfma_f32_16x16x32_bf16((a), (b), (c), 0, 0, 0)
constexpr size_t SZ_M = 32768, SZ_N = 32768, SZ_W = 16384, SZ_Q = 16384, SZ_U = 16384, SZ_I = 8192, SZ_S = 32768;
constexpr size_t NSLOT = (size_t)NB * 36 * 8 * 2;
constexpr size_t OFF_M = 0, OFF_N = OFF_M + NSLOT * SZ_M, OFF_W = OFF_N + NSLOT * SZ_N, OFF_Q = OFF_W + NSLOT * SZ_W, OFF_U = OFF_Q + NSLOT * SZ_Q, OFF_I = OFF_U + NSLOT * SZ_U, OFF_S = OFF_I + NSLOT * SZ_I, OFF_END = OFF_S + NSLOT * SZ_S;
constexpr int QLS = 136, KTST = 72, FS = 65;
constexpr int O_QL = 0, O_KL = 17408, O_AT = 0, O_TT = 16640, O_KT = 34816, O_VT = 53248, O_KTS = 71680, O_KK = 90112, O_QKB = 106752, O_TB = 106752, O_TG = 115968, O_GV = 125184;
constexpr int GV_BETA = 0, GV_GC = 128, GV_GL = 256;

__device__ __forceinline__ bf16x8 pack8(const f32x4& a, const f32x4& b) { typedef unsigned u4 __attribute__((ext_vector_type(4))); u4 p; p.x = cvtpk(a[0], a[1]); p.y = cvtpk(a[2], a[3]); p.z = cvtpk(b[0], b[1]); p.w = cvtpk(b[2], b[3]); return __builtin_bit_cast(bf16x8, p); }
__device__ __forceinline__ unsigned long long pack4(const f32x4& a) { return (unsigned long long)cvtpk(a[0], a[1]) | ((unsigned long long)cvtpk(a[2], a[3]) << 32); }
__device__ __forceinline__ bf16x8 ldperm_lds(const LAS bf16_t* p) { const bf16x4 a = *(const LAS bf16x4*)p, b = *(const LAS bf16x4*)(p + 16); return (bf16x8){a[0], a[1], a[2], a[3], b[0], b[1], b[2], b[3]}; }
__device__ __forceinline__ bf16x8 ldperm_g(const bf16_t* p) { const bf16x4 a = *(const bf16x4*)p, b = *(const bf16x4*)(p + 16); return (bf16x8){a[0], a[1], a[2], a[3], b[0], b[1], b[2], b[3]}; }

__device__ __forceinline__ void mm16f(f32x4& acc, const LAS float* pa, const LAS float* pb, int lane) {
    const int m = lane & 15, q = lane >> 4;
#pragma unroll
    for (int s = 0; s < 4; ++s) acc = __builtin_amdgcn_mfma_f32_16x16x4f32(pa[m * FS + 4 * s + q], pb[(4 * s + q) * FS + m], acc, 0, 0, 0);
}
__device__ __forceinline__ void st16f(LAS float* pd, const f32x4& v, int lane, float sgn) { const int m = lane & 15, q = lane >> 4;
#pragma unroll
    for (int r = 0; r < 4; ++r) pd[(4 * q + r) * FS + m] = sgn * v[r]; }

__device__ __forceinline__ void g3_item(const Params& p, int b, int c, int h, LAS unsigned char* lds) {
    const int tid = otid(), lane = tid & 63, wave = __builtin_amdgcn_readfirstlane(tid >> 6);
    const bf16_t* PBp = (const bf16_t*)(p.ws + ws::PB); const float* SPp = (const float*)(p.ws + ws::SP);
    unsigned char* G = p.ws + ws::GDNS;
    const float* conv_w = p.in[18]; const float* a_log = p.in[19]; const float* dt_bias = p.in[20];
    LAS bf16_t* QL = (LAS bf16_t*)(lds + O_QL); LAS bf16_t* KL = (LAS bf16_t*)(lds + O_KL); LAS bf16_t* KT = (LAS bf16_t*)(lds + O_KT); LAS bf16_t* VT = (LAS bf16_t*)(lds + O_VT);
    LAS bf16_t* KTS = (LAS bf16_t*)(lds + O_KTS); LAS float* KK = (LAS float*)(lds + O_KK); LAS bf16_t* QKB = (LAS bf16_t*)(lds + O_QKB);
    LAS float* AT = (LAS float*)(lds + O_AT); LAS float* TT = (LAS float*)(lds + O_TT); LAS bf16_t* TB = (LAS bf16_t*)(lds + O_TB); LAS bf16_t* TG = (LAS bf16_t*)(lds + O_TG);
    LAS float* GV = (LAS float*)(lds + O_GV);
    const size_t n0 = (size_t)b * T + 64 * c;
    const int seg_lo = c < 4 ? 0 : C, seg_hi = c < 4 ? C : T;
    const size_t sl0 = (((size_t)b * 36 + c) * 8 + h) * 2;
    __syncthreads();
    if (tid < 384) {
        const int rg = tid / 48, kind = (tid % 48) >> 4, cg = tid & 15;
        const int ch = kind * 1024 + h * 128 + 8 * cg;
        float wv[5][8];
#pragma unroll
        for (int j = 0; j < 5; ++j) { const float4 w0 = *(const float4*)(conv_w + j * 3072 + ch), w1 = *(const float4*)(conv_w + j * 3072 + ch + 4);
            wv[j][0] = w0.x; wv[j][1] = w0.y; wv[j][2] = w0.z; wv[j][3] = w0.w; wv[j][4] = w1.x; wv[j][5] = w1.y; wv[j][6] = w1.z; wv[j][7] = w1.w; }
#pragma unroll 1
        for (int half = 0; half < 2; ++half) {
            v4u raw[8];
#pragma unroll
            for (int rr = 0; rr < 8; ++rr) { const int pp = 64 * c + 8 * rg + 4 * half + rr - 2;
                raw[rr] = (pp >= seg_lo && pp < seg_hi) ? *(const v4u*)(PBp + ((size_t)b * T + pp) * 4096 + ch) : (v4u){0u, 0u, 0u, 0u}; }
            float o[4][8];
#pragma unroll
            for (int r = 0; r < 4; ++r) {
#pragma unroll
                for (int e = 0; e < 8; ++e) o[r][e] = 0.f;
#pragma unroll
                for (int j = 0; j < 5; ++j) { const v4u x = raw[r + j]; const unsigned xs[4] = {x.x, x.y, x.z, x.w};
#pragma unroll
                    for (int e2 = 0; e2 < 4; ++e2) { o[r][2 * e2] += bfl(xs[e2]) * wv[j][2 * e2]; o[r][2 * e2 + 1] += bfh(xs[e2]) * wv[j][2 * e2 + 1]; } }
                float ss = 0.f;
#pragma unroll
                for (int e = 0; e < 8; ++e) { const float v = o[r][e]; o[r][e] = v * __builtin_amdgcn_rcpf(1.f + __expf(-v)); ss += o[r][e] * o[r][e]; }
                ss += __shfl_xor(ss, 1); ss += __shfl_xor(ss, 2); ss += __shfl_xor(ss, 4); ss += __shfl_xor(ss, 8);
                if (kind < 2) { const float rs = rsqrtf(ss + EPS) * (kind == 0 ? 0.08838834764831845f : 1.f);
#pragma unroll
                    for (int e = 0; e < 8; ++e) o[r][e] *= rs; }
            }
            if (kind < 2) { LAS bf16_t* dst = kind == 0 ? QL : KL;
#pragma unroll
                for (int r = 0; r < 4; ++r) { v4u w; w.x = cvtpk(o[r][0], o[r][1]); w.y = cvtpk(o[r][2], o[r][3]); w.z = cvtpk(o[r][4], o[r][5]); w.w = cvtpk(o[r][6], o[r][7]);
                    *(LAS v4u*)(dst + (8 * rg + 4 * half + r) * QLS + 8 * cg) = w; } }
            if (kind >= 1) { LAS bf16_t* dst = kind == 1 ? KT : VT;
#pragma unroll
                for (int e = 0; e < 8; ++e) { const unsigned long long w = (unsigned long long)cvtpk(o[0][e], o[1][e]) | ((unsigned long long)cvtpk(o[2][e], o[3][e]) << 32);
                    *(LAS unsigned long long*)(dst + (8 * cg + e) * KTST + 8 * rg + 4 * half) = w; } }
        }
    } else if (tid >= 448) {
        const int i = lane;
#pragma unroll
        for (int d = 0; d < 2; ++d) {
            const float bl = SPp[(n0 + i) * 32 + d * 8 + h];
            const float a = SPp[(n0 + i) * 32 + 16 + d * 8 + h] + dt_bias[d * 8 + h];
            const float sp = a > 15.f ? a : __logf(1.f + __expf(a));
            float g = -__expf(a_log[d * 8 + h]) * sp;
#pragma unroll
            for (int o = 1; o < 64; o <<= 1) { const float t = d == 0 ? __shfl_up(g, o) : __shfl_down(g, o); if (d == 0 ? (i >= o) : (i + o < 64)) g += t; }
            GV[GV_BETA + d * 64 + i] = 1.f / (1.f + __expf(-bl)); GV[GV_GC + d * 64 + i] = g;
            if (d == 0 ? (i == 63) : (i == 0)) GV[GV_GL + d] = g;
        }
    }
    __syncthreads();
    {
        const int which = wave >> 2, rb = wave & 3, m = lane & 15, q = lane >> 4;
        const LAS bf16_t* Ab = (which ? QL : KL) + (16 * rb + m) * QLS + 8 * q;
        bf16x8 af[4];
#pragma unroll
        for (int s = 0; s < 4; ++s) af[s] = *(const LAS bf16x8*)(Ab + 32 * s);
#pragma unroll
        for (int cb = 0; cb < 4; ++cb) {
            f32x4 acc = {0.f, 0.f, 0.f, 0.f};
#pragma unroll
            for (int s = 0; s < 4; ++s) acc = MFMA16(af[s], *(const LAS bf16x8*)(KL + (16 * cb + m) * QLS + 8 * q + 32 * s), acc);
#pragma unroll
            for (int r = 0; r < 4; ++r) { const int i = 16 * rb + 4 * q + r, j = 16 * cb + m;
                if (which == 0) KK[i * FS + j] = acc[r]; else QKB[i * KTST + j] = (bf16_t)(cvtpk(acc[r], 0.f) & 0xffffu); }
        }
    }
    __syncthreads();
#pragma unroll
    for (int it = 0; it < 4; ++it) { const int idx = tid + 512 * it, d = idx >> 10, i = (idx >> 4) & 63, ck = idx & 15;
        const float sc = __expf(GV[GV_GC + d * 64 + i]);
        const v4u x = *(const LAS v4u*)(QL + i * QLS + 8 * ck); v4u w;
        w.x = cvtpk(bfl(x.x) * sc, bfh(x.x) * sc); w.y = cvtpk(bfl(x.y) * sc, bfh(x.y) * sc); w.z = cvtpk(bfl(x.z) * sc, bfh(x.z) * sc); w.w = cvtpk(bfl(x.w) * sc, bfh(x.w) * sc);
        *(v4u*)(G + OFF_Q + (sl0 + d) * SZ_Q + ((size_t)i * 128 + 8 * ck) * 2) = w; }
#pragma unroll
    for (int it = 0; it < 2; ++it) { const int idx = tid + 512 * it, d = idx >> 9, i = (idx >> 3) & 63, ck = idx & 7;
        const float gi = GV[GV_GC + d * 64 + i];
        const v4u x = *(const LAS v4u*)(QKB + i * KTST + 8 * ck); const unsigned xs[4] = {x.x, x.y, x.z, x.w}; unsigned ws_[4];
#pragma unroll
        for (int e2 = 0; e2 < 4; ++e2) { const int j0 = 8 * ck + 2 * e2, j1 = j0 + 1;
            const bool k0 = d == 0 ? (j0 <= i) : (j0 >= i), k1 = d == 0 ? (j1 <= i) : (j1 >= i);
            const float v0 = k0 ? bfl(xs[e2]) * __expf(gi - GV[GV_GC + d * 64 + j0]) : 0.f, v1 = k1 ? bfh(xs[e2]) * __expf(gi - GV[GV_GC + d * 64 + j1]) : 0.f;
            ws_[e2] = cvtpk(v0, v1); }
        *(v4u*)(G + OFF_I + (sl0 + d) * SZ_I + ((size_t)i * 64 + 8 * ck) * 2) = (v4u){ws_[0], ws_[1], ws_[2], ws_[3]}; }
    __syncthreads();
    for (int d = 0; d < 2; ++d) {
        const float gl = GV[GV_GL + d];
#pragma unroll
        for (int e = 0; e < 8; ++e) { const int idx = tid * 8 + e, it = idx >> 6, jt = idx & 63, ip = d ? 63 - it : it, jp = d ? 63 - jt : jt;
            float v = 0.f;
            if (jt < it) v = GV[GV_BETA + d * 64 + ip] * KK[ip * FS + jp] * __expf(GV[GV_GC + d * 64 + ip] - GV[GV_GC + d * 64 + jp]);
            AT[it * FS + jt] = v; TT[it * FS + jt] = 0.f; }
        __syncthreads();
        if (wave == 0) { const int g = lane >> 4, cc = lane & 15; const LAS float* ab = AT + (16 * g) * FS + 16 * g;
            float t[16];
#pragma unroll
            for (int r = 0; r < 16; ++r) { float acc = (r == cc) ? 1.f : 0.f;
#pragma unroll
                for (int j = 0; j < 16; ++j) if (j < r) acc -= ab[r * FS + j] * t[j];
                t[r] = acc; }
#pragma unroll
            for (int r = 0; r < 16; ++r) TT[(16 * g + r) * FS + 16 * g + cc] = t[r]; }
        __syncthreads();
        if (wave < 3) { const int bi = wave + 1, bj = wave; f32x4 x = {0.f, 0.f, 0.f, 0.f};
            mm16f(x, AT + (16 * bi) * FS + 16 * bj, TT + (16 * bj) * FS + 16 * bj, lane);
            st16f(TT + (16 * bi) * FS + 16 * bj, x, lane, 1.f); LDS_WAIT();
            f32x4 y = {0.f, 0.f, 0.f, 0.f}; mm16f(y, TT + (16 * bi) * FS + 16 * bi, TT + (16 * bi) * FS + 16 * bj, lane);
            st16f(TT + (16 * bi) * FS + 16 * bj, y, lane, -1.f); }
        __syncthreads();
        if (wave < 2) { const int bi = wave + 2, bj = wave; f32x4 x = {0.f, 0.f, 0.f, 0.f};
            mm16f(x, AT + (16 * bi) * FS + 16 * bj, TT + (16 * bj) * FS + 16 * bj, lane);
            mm16f(x, AT + (16 * bi) * FS + 16 * (bj + 1), TT + (16 * (bj + 1)) * FS + 16 * bj, lane);
            st16f(TT + (16 * bi) * FS + 16 * bj, x, lane, 1.f); LDS_WAIT();
            f32x4 y = {0.f, 0.f, 0.f, 0.f}; mm16f(y, TT + (16 * bi) * FS + 16 * bi, TT + (16 * bi) * FS + 16 * bj, lane);
            st16f(TT + (16 * bi) * FS + 16 * bj, y, lane, -1.f); }
        __syncthreads();
        if (wave == 0) { f32x4 x = {0.f, 0.f, 0.f, 0.f};
            mm16f(x, AT + 48 * FS + 0, TT + 0, lane); mm16f(x, AT + 48 * FS + 16, TT + 16 * FS, lane); mm16f(x, AT + 48 * FS + 32, TT + 32 * FS, lane);
            st16f(TT + 48 * FS, x, lane, 1.f); LDS_WAIT();
            f32x4 y = {0.f, 0.f, 0.f, 0.f}; mm16f(y, TT + 48 * FS + 48, TT + 48 * FS, lane);
            st16f(TT + 48 * FS, y, lane, -1.f); }
        __syncthreads();
#pragma unroll
        for (int e = 0; e < 8; e += 2) { const int idx = tid * 8 + e, i = idx >> 6, j = idx & 63;
            const float t0 = TT[(d ? 63 - i : i) * FS + (d ? 63 - j : j)], t1 = TT[(d ? 63 - i : i) * FS + (d ? 62 - j : j + 1)];
            const float b0 = GV[GV_BETA + d * 64 + j], b1 = GV[GV_BETA + d * 64 + j + 1];
            const float e0 = __expf(GV[GV_GC + d * 64 + j]), e1 = __expf(GV[GV_GC + d * 64 + j + 1]);
            *(LAS unsigned*)(TB + i * KTST + j) = cvtpk(t0 * b0, t1 * b1); *(LAS unsigned*)(TG + i * KTST + j) = cvtpk(t0 * b0 * e0, t1 * b1 * e1); }
#pragma unroll
        for (int it = 0; it < 2; ++it) { const int idx = tid + 512 * it, a = idx >> 3, ck = idx & 7;
            const v4u x = *(const LAS v4u*)(KT + a * KTST + 8 * ck); const unsigned xs[4] = {x.x, x.y, x.z, x.w}; unsigned w4[4];
#pragma unroll
            for (int e2 = 0; e2 < 4; ++e2) { const int i0 = 8 * ck + 2 * e2; w4[e2] = cvtpk(bfl(xs[e2]) * __expf(gl - GV[GV_GC + d * 64 + i0]), bfh(xs[e2]) * __expf(gl - GV[GV_GC + d * 64 + i0 + 1])); }
            *(LAS v4u*)(KTS + a * KTST + 8 * ck) = (v4u){w4[0], w4[1], w4[2], w4[3]}; }
        __syncthreads();
        {
            const int w = wave, m = lane & 15, q = lane >> 4;
            const size_t sl = sl0 + d;
            f32x4 U[4], W[4];
            bf16x8 bv[2], bk[2];
#pragma unroll
            for (int s = 0; s < 2; ++s) { bv[s] = *(const LAS bf16x8*)(VT + (16 * w + m) * KTST + 32 * s + 8 * q); bk[s] = *(const LAS bf16x8*)(KT + (16 * w + m) * KTST + 32 * s + 8 * q); }
#pragma unroll
            for (int rb = 0; rb < 4; ++rb) { U[rb] = (f32x4){0.f, 0.f, 0.f, 0.f}; W[rb] = (f32x4){0.f, 0.f, 0.f, 0.f};
#pragma unroll
                for (int s = 0; s < 2; ++s) { U[rb] = MFMA16(*(const LAS bf16x8*)(TB + (16 * rb + m) * KTST + 32 * s + 8 * q), bv[s], U[rb]);
                    W[rb] = MFMA16(*(const LAS bf16x8*)(TG + (16 * rb + m) * KTST + 32 * s + 8 * q), bk[s], W[rb]); }
                *(unsigned long long*)(G + OFF_U + sl * SZ_U + ((size_t)(16 * w + m) * 64 + 16 * rb + 4 * q) * 2) = pack4(U[rb]);
                f32x4 wt = {0.f, 0.f, 0.f, 0.f};
#pragma unroll
                for (int s = 0; s < 2; ++s) wt = MFMA16(bk[s], *(const LAS bf16x8*)(TG + (16 * rb + m) * KTST + 32 * s + 8 * q), wt);
                *(unsigned long long*)(G + OFF_W + sl * SZ_W + ((size_t)(16 * rb + m) * 128 + 16 * w + 4 * q) * 2) = pack4(wt);
            }
            bf16x8 PU[2], PW[2];
#pragma unroll
            for (int s = 0; s < 2; ++s) { PU[s] = pack8(U[2 * s], U[2 * s + 1]); PW[s] = pack8(W[2 * s], W[2 * s + 1]); }
            const float egl = __expf(gl);
#pragma unroll
            for (int ab = 0; ab < 8; ++ab) {
                f32x4 nn = {0.f, 0.f, 0.f, 0.f}, mm = {0.f, 0.f, 0.f, 0.f};
#pragma unroll
                for (int s = 0; s < 2; ++s) { const bf16x8 kf = ldperm_lds(KTS + (16 * ab + m) * KTST + 32 * s + 4 * q);
                    nn = MFMA16(kf, PU[s], nn);
                    mm = MFMA16(PW[s], kf, mm); }
                *(unsigned long long*)(G + OFF_N + sl * SZ_N + ((size_t)(16 * w + m) * 128 + 16 * ab + 4 * q) * 2) = pack4(nn);
                f32x4 mo;
#pragma unroll
                for (int r = 0; r < 4; ++r) mo[r] = ((16 * ab + m) == (16 * w + 4 * q + r) ? egl : 0.f) - mm[r];
                *(unsigned long long*)(G + OFF_M + sl * SZ_M + ((size_t)(16 * ab + m) * 128 + 16 * w + 4 * q) * 2) = pack4(mo);
            }
        }
        __syncthreads();
    }
}

__device__ __forceinline__ void g4_chain(const Params& p, int id, int lane) {
    unsigned char* G = p.ws + ws::GDNS;
    const int ch = id >> 3, cb = id & 7, b = ch >> 4, h = (ch >> 1) & 7, d = ch & 1, m = lane & 15, q = lane >> 4;
    f32x4 acc[8];
#pragma unroll
    for (int ab = 0; ab < 8; ++ab) acc[ab] = (f32x4){0.f, 0.f, 0.f, 0.f};
    for (int step = 0; step < 36; ++step) {
        const int c = d == 0 ? step : (step < 4 ? 3 - step : 39 - step);
        const size_t sl = (((size_t)b * 36 + c) * 8 + h) * 2 + d;
        unsigned char* St = G + OFF_S + sl * SZ_S + ((size_t)(16 * cb + m) * 128 + 4 * q) * 2;
        const unsigned char* Nt = G + OFF_N + sl * SZ_N + ((size_t)(16 * cb + m) * 128 + 4 * q) * 2;
        const bf16_t* Mp = (const bf16_t*)(G + OFF_M + sl * SZ_M) + (size_t)m * 128 + 4 * q;
        bf16x8 PS[4];
#pragma unroll
        for (int s = 0; s < 4; ++s) PS[s] = pack8(acc[2 * s], acc[2 * s + 1]);
#pragma unroll
        for (int ab = 0; ab < 8; ++ab) { *(unsigned long long*)(St + 32 * ab) = pack4(acc[ab]);
            const uint2 nv = *(const uint2*)(Nt + 32 * ab); acc[ab] = (f32x4){bfl(nv.x), bfh(nv.x), bfl(nv.y), bfh(nv.y)}; }
#pragma unroll
        for (int ab = 0; ab < 8; ++ab)
#pragma unroll
            for (int s = 0; s < 4; ++s) acc[ab] = MFMA16(ldperm_g(Mp + (size_t)(16 * ab) * 128 + 32 * s), PS[s], acc[ab]);
    }
}

__device__ __forceinline__ void g5_item(const Params& p, int b, int c, int h, LAS unsigned char* lds) {
    const int tid = otid(), lane = tid & 63, w = __builtin_amdgcn_readfirstlane(tid >> 6), m = lane & 15, q = lane >> 4;
    unsigned char* G = p.ws + ws::GDNS;
    const bf16_t* PBp = (const bf16_t*)(p.ws + ws::PB); bf16_t* Op = (bf16_t*)(p.ws + ws::OBF);
    const float* g_out = p.in[21];
    LAS float* red = (LAS float*)lds;
    const size_t n0 = (size_t)b * T + 64 * c;
    const size_t sl0 = (((size_t)b * 36 + c) * 8 + h) * 2;
    f32x4 o[4];
#pragma unroll
    for (int rb = 0; rb < 4; ++rb) o[rb] = (f32x4){0.f, 0.f, 0.f, 0.f};
#pragma unroll
    for (int d = 0; d < 2; ++d) {
        const size_t sl = sl0 + d;
        const bf16_t* St = (const bf16_t*)(G + OFF_S + sl * SZ_S) + (size_t)(16 * w + m) * 128 + 8 * q;
        const bf16_t* Wp = (const bf16_t*)(G + OFF_W + sl * SZ_W) + (size_t)m * 128 + 8 * q;
        const bf16_t* Qp = (const bf16_t*)(G + OFF_Q + sl * SZ_Q) + (size_t)m * 128 + 8 * q;
        const bf16_t* Up = (const bf16_t*)(G + OFF_U + sl * SZ_U) + (size_t)(16 * w + m) * 64 + 4 * q;
        const bf16_t* Ip = (const bf16_t*)(G + OFF_I + sl * SZ_I) + (size_t)m * 64 + 4 * q;
        bf16x8 SB[4];
#pragma unroll
        for (int s = 0; s < 4; ++s) SB[s] = *(const bf16x8*)(St + 32 * s);
        f32x4 vn[4];
#pragma unroll
        for (int rb = 0; rb < 4; ++rb) { f32x4 t1 = {0.f, 0.f, 0.f, 0.f};
#pragma unroll
            for (int s = 0; s < 4; ++s) { t1 = MFMA16(*(const bf16x8*)(Wp + (size_t)(16 * rb) * 128 + 32 * s), SB[s], t1); o[rb] = MFMA16(*(const bf16x8*)(Qp + (size_t)(16 * rb) * 128 + 32 * s), SB[s], o[rb]); }
            const uint2 uv = *(const uint2*)(Up + 16 * rb);
            vn[rb] = (f32x4){bfl(uv.x) - t1[0], bfh(uv.x) - t1[1], bfl(uv.y) - t1[2], bfh(uv.y) - t1[3]}; }
        bf16x8 PV[2];
#pragma unroll
        for (int s = 0; s < 2; ++s) PV[s] = pack8(vn[2 * s], vn[2 * s + 1]);
#pragma unroll
        for (int rb = 0; rb < 4; ++rb)
#pragma unroll
            for (int s = 0; s < 2; ++s) o[rb] = MFMA16(ldperm_g(Ip + (size_t)(16 * rb) * 64 + 32 * s), PV[s], o[rb]);
    }
    __syncthreads();
#pragma unroll
    for (int rb = 0; rb < 4; ++rb)
#pragma unroll
        for (int r = 0; r < 4; ++r) { float ss = o[rb][r] * o[rb][r]; ss += __shfl_xor(ss, 1); ss += __shfl_xor(ss, 2); ss += __shfl_xor(ss, 4); ss += __shfl_xor(ss, 8);
            if (m == 0) red[w * 64 + 16 * rb + 4 * q + r] = ss; }
    __syncthreads();
    const int dv = 16 * w + m; const float go = g_out[dv];
#pragma unroll
    for (int rb = 0; rb < 4; ++rb)
#pragma unroll
        for (int r = 0; r < 4; ++r) { const int i = 16 * rb + 4 * q + r; float ss = 0.f;
#pragma unroll
            for (int ww = 0; ww < 8; ++ww) ss += red[ww * 64 + i];
            const float z = bfl((unsigned)PBp[(n0 + i) * 4096 + 3072 + h * 128 + dv]);
            const float val = o[rb][r] * rsqrtf(ss * (1.f / 128.f) + EPS) * go * (z * __builtin_amdgcn_rcpf(1.f + __expf(-z)));
            Op[(n0 + i) * 1024 + h * 128 + dv] = (bf16_t)(cvtpk(val, 0.f) & 0xffffu); }
}
}

__device__ __forceinline__ void gdn_g3_phase(const Params& p, LAS unsigned char* lds, int bid, int nb) {
    for (int it = bid; it < NB * 36 * 8; it += nb) { const int h = it & 7, bc = it >> 3; gdn::g3_item(p, bc / 36, bc % 36, h, lds); }
}
__device__ __forceinline__ void gdn_g4_phase(const Params& p, int bid, int nb) {
    const int wave = otid() >> 6; if (wave >= 4) return;
    for (int id = bid * 4 + wave; id < 1024; id += nb * 4) gdn::g4_chain(p, id, otid() & 63);
}
__device__ __forceinline__ void gdn_g5_phase(const Params& p, LAS unsigned char* lds, int bid, int nb) {
    for (int it = bid; it < NB * 36 * 8; it += nb) { const int h = it & 7, bc = it >> 3; gdn::g5_item(p, bc / 36, bc % 36, h, lds); }
}

__device__ __forceinline__ float wave_sum(float v) {
#pragma unroll
    for (int o = 1; o < 64; o <<= 1) v += __shfl_xor(v, o);
    return v;
}
__device__ __forceinline__ void stage_w32(const float* W, int ldw, LAS float* sw) {
    for (int i = otid(); i < 1024 * 8; i += NTHR) { const int k = i >> 3, c = i & 7; const f32x4 v = *(const f32x4*)(W + (size_t)k * ldw + 4 * c); *(LAS f32x4*)(sw + k * 32 + ((c ^ (k & 7)) << 2)) = v; }
}
__device__ __forceinline__ void dot32x2(const float (&h0)[16], const float (&h1)[16], const LAS float* sw, int lane, float (&p0)[32], float (&p1)[32]) {
#pragma unroll
    for (int e = 0; e < 32; ++e) { p0[e] = 0.f; p1[e] = 0.f; }
#pragma unroll
    for (int j = 0; j < 16; ++j) { const int k = lane + 64 * j;
#pragma unroll
        for (int c = 0; c < 8; ++c) { const f32x4 w = *(const LAS f32x4*)(sw + k * 32 + ((c ^ (k & 7)) << 2));
#pragma unroll
            for (int e = 0; e < 4; ++e) { p0[4 * c + e] += h0[j] * w[e]; p1[4 * c + e] += h1[j] * w[e]; } } }
}
__device__ __forceinline__ float reduce32(float (&p)[32], int lane) {
#pragma unroll
    for (int e = 0; e < 16; ++e) { const bool up = (lane & 32) != 0; const float send = up ? p[e] : p[e + 16]; const float keep = up ? p[e + 16] : p[e]; p[e] = keep + __shfl_xor(send, 32); }
#pragma unroll
    for (int e = 0; e < 8; ++e) { const bool up = (lane & 16) != 0; const float send = up ? p[e] : p[e + 8]; const float keep = up ? p[e + 8] : p[e]; p[e] = keep + __shfl_xor(send, 16); }
#pragma unroll
    for (int e = 0; e < 4; ++e) { const bool up = (lane & 8) != 0; const float send = up ? p[e] : p[e + 4]; const float keep = up ? p[e + 4] : p[e]; p[e] = keep + __shfl_xor(send, 8); }
#pragma unroll
    for (int e = 0; e < 2; ++e) { const bool up = (lane & 4) != 0; const float send = up ? p[e] : p[e + 2]; const float keep = up ? p[e + 2] : p[e]; p[e] = keep + __shfl_xor(send, 4); }
    { const bool up = (lane & 2) != 0; const float send = up ? p[0] : p[1]; const float keep = up ? p[1] : p[0]; p[0] = keep + __shfl_xor(send, 2); }
    return p[0] + __shfl_xor(p[0], 1);
}
__device__ __forceinline__ void load_row(const Params& p, int layer, int n, int lane, bool combine, float (&x)[16]) {
    const int b = n / T, pp = n % T;
    const float* src;
    if (layer == 0) src = pp < C ? p.in[2] + ((size_t)b * C + pp) * D : p.in[0] + ((size_t)b * L + (pp - C)) * D;
    else src = (const float*)(p.ws + ws::X) + (size_t)n * D;
#pragma unroll
    for (int j = 0; j < 16; ++j) x[j] = src[lane + 64 * j];
    if (combine) {
        const bf16_t* ys = (const bf16_t*)(p.ws + ws::YSB) + (size_t)n * 4 * D;
        const float* gt2 = (const float*)(p.ws + ws::MODS) + ((size_t)(layer - 1) * 9 + (pp < C ? 8 : b)) * 6144 + 5 * 1024;
#pragma unroll
        for (int j = 0; j < 16; ++j) { float s = 0.f;
#pragma unroll
            for (int k = 0; k < 4; ++k) s += bf2f(ys[(size_t)k * D + lane + 64 * j]);
            x[j] += gt2[lane + 64 * j] * s; }
    }
}
__device__ __forceinline__ void normmod_row(const Params& p, int layer, int n, int lane, const float* g, int sh_chunk, const float (&x)[16], float (&h)[16]) {
    float ss = 0.f;
#pragma unroll
    for (int j = 0; j < 16; ++j) ss += x[j] * x[j];
    const float rs = rsqrtf(wave_sum(ss) * (1.f / D) + EPS);
    const int b = n / T, pp = n % T;
    const float* md = (const float*)(p.ws + ws::MODS) + ((size_t)layer * 9 + (pp < C ? 8 : b)) * 6144 + sh_chunk * 1024;
#pragma unroll
    for (int j = 0; j < 16; ++j) { const int k = lane + 64 * j; h[j] = x[j] * rs * g[k] * (1.f + md[1024 + k]) + md[k]; }
}
__device__ __forceinline__ void phaseA(const Params& p, int layer, LAS unsigned char* lds, int bid, int nb) {
    const int lane = otid() & 63, wave = otid() >> 6;
    LAS float* sw = (LAS float*)lds;
    const bool gdnl = layer == 2;
    __syncthreads();
    if (gdnl) { stage_w32(p.in[17] + 4096, GIN, sw); __syncthreads(); }
    float* X = (float*)(p.ws + ws::X); bf16_t* HB = (bf16_t*)(p.ws + ws::HB); float* SPp = (float*)(p.ws + ws::SP);
    const float* g = p.in[6] + layer * D;
    const bool prev_skip_ctx = false;
    for (int pr = bid * 8 + wave; pr < NTOK / 2; pr += nb * 8) {
        const int n0 = 2 * pr, n1 = n0 + 1;
        float x0[16], x1[16], h0[16], h1[16];
        load_row(p, layer, n0, lane, layer > 0, x0); load_row(p, layer, n1, lane, layer > 0, x1);
        if (layer == 0 || layer > 0) {
#pragma unroll
            for (int j = 0; j < 16; ++j) { X[(size_t)n0 * D + lane + 64 * j] = x0[j]; X[(size_t)n1 * D + lane + 64 * j] = x1[j]; } }
        normmod_row(p, layer, n0, lane, g, 0, x0, h0); normmod_row(p, layer, n1, lane, g, 0, x1, h1);
#pragma unroll
        for (int j = 0; j < 16; ++j) { HB[(size_t)n0 * D + lane + 64 * j] = (bf16_t)f2bf(h0[j]); HB[(size_t)n1 * D + lane + 64 * j] = (bf16_t)f2bf(h1[j]); }
        if (gdnl) { float p0[32], p1[32]; dot32x2(h0, h1, sw, lane, p0, p1); const float r0 = reduce32(p0, lane), r1 = reduce32(p1, lane);
            if ((lane & 1) == 0) { SPp[(size_t)n0 * 32 + (lane >> 1)] = r0; SPp[(size_t)n1 * 32 + (lane >> 1)] = r1; } }
    }
    (void)prev_skip_ctx;
}
__device__ __forceinline__ void top4(float v, int lane, int (&idx)[4], float (&val)[4]) {
    const int e = lane >> 1;
#pragma unroll
    for (int k = 0; k < 4; ++k) {
        float bv = v; int bi = e;
#pragma unroll
        for (int o = 2; o < 64; o <<= 1) { const float ov = __shfl_xor(bv, o); const int oi = __shfl_xor(bi, o); if (ov > bv || (ov == bv && oi < bi)) { bv = ov; bi = oi; } }
        idx[k] = bi; val[k] = bv;
        if (e == bi) v = -INFINITY;
    }
}
__device__ __forceinline__ void phaseE(const Params& p, int layer, LAS unsigned char* lds, int bid, int nb) {
    const int lane = otid() & 63, wave = otid() >> 6;
    LAS float* sw = (LAS float*)lds;
    __syncthreads();
    stage_w32(p.in[23] + (size_t)layer * D * NE, NE, sw); __syncthreads();
    const float* g = p.in[7] + layer * D; const float* br = p.in[24] + layer * NE;
    int* cnt = (int*)(p.ws + ws::CTL) + ws::CW_CNT + layer * 32; int* list = (int*)(p.ws + ws::LIST); float* gate = (float*)(p.ws + ws::GATE);
    bf16_t* AS = (bf16_t*)(p.ws + ws::ASORT);
    const bool skip_ctx = layer == 3;
    const float bias = br[lane >> 1];
    for (int pr = bid * 8 + wave; pr < NTOK / 2; pr += nb * 8) {
        const int n0 = 2 * pr, n1 = n0 + 1;
        if (skip_ctx && (n0 % T) < C) continue;
        float x0[16], x1[16], h0[16], h1[16];
        load_row(p, 1, n0, lane, false, x0); load_row(p, 1, n1, lane, false, x1);
        normmod_row(p, layer, n0, lane, g, 3, x0, h0); normmod_row(p, layer, n1, lane, g, 3, x1, h1);
        float p0[32], p1[32]; dot32x2(h0, h1, sw, lane, p0, p1);
        const float l0 = reduce32(p0, lane) + bias, l1 = reduce32(p1, lane) + bias;
#pragma unroll
        for (int t = 0; t < 2; ++t) {
            const int n = t ? n1 : n0; int idx[4]; float val[4]; top4(t ? l1 : l0, lane, idx, val);
            float ex[4], sum = 0.f;
#pragma unroll
            for (int k = 0; k < 4; ++k) { ex[k] = __expf(val[k] - val[0]); sum += ex[k]; }
            const float inv = 1.f / sum;
            int dst[4];
#pragma unroll
            for (int k = 0; k < 4; ++k) { int pos = 0; if (lane == 0) pos = atomicAdd(&cnt[idx[k]], 1); pos = __builtin_amdgcn_readfirstlane(pos); dst[k] = idx[k] * CAP + pos;
                if (lane == 0) { list[dst[k]] = n * 4 + k; gate[n * 4 + k] = ex[k] * inv; } }
#pragma unroll
            for (int j = 0; j < 16; ++j) { const bf16_t hv = (bf16_t)f2bf(t ? h1[j] : h0[j]);
#pragma unroll
                for (int k = 0; k < 4; ++k) AS[(size_t)dst[k] * 1024 + lane + 64 * j] = hv; }
        }
    }
}
__device__ __forceinline__ void phaseFinal(const Params& p, int bid, int nb) {
    const int lane = otid() & 63, wave = otid() >> 6;
    const float* g = p.in[29];
    for (int i = bid * 8 + wave; i < NB * L; i += nb * 8) {
        const int b = i / L, l = i % L, n = b * T + C + l;
        float x[16]; load_row(p, 4, n, lane, true, x);
        float ss = 0.f;
#pragma unroll
        for (int j = 0; j < 16; ++j) ss += x[j] * x[j];
        const float rs = rsqrtf(wave_sum(ss) * (1.f / D) + EPS);
#pragma unroll
        for (int j = 0; j < 16; ++j) p.out[(size_t)i * D + lane + 64 * j] = x[j] * rs * g[lane + 64 * j];
    }
}
__device__ __forceinline__ void prologue_mods(const Params& p, LAS unsigned char* lds, int bid, int nb) {
    const int lane = otid() & 63, wave = otid() >> 6;
    LAS float* sc = (LAS float*)lds;
    LAS float* part = (LAS float*)(lds + 36864);
    float* mods = (float*)(p.ws + ws::MODS);
    __syncthreads();
    for (int i = otid(); i < 9 * 1024; i += NTHR) { const int r = i >> 10, k = i & 1023; const float v = r < 8 ? p.in[1][r * 1024 + k] : p.in[3][k]; sc[i] = v / (1.f + expf(-v)); }
    __syncthreads();
    for (int task = bid; task < DEPTH * 96; task += nb) {
        const int layer = task / 96, col = (task % 96) * 64 + lane;
        const float* w = p.in[4] + (size_t)layer * 1024 * 6144 + col;
        float acc[9];
#pragma unroll
        for (int r = 0; r < 9; ++r) acc[r] = 0.f;
#pragma unroll 8
        for (int kk = 0; kk < 128; ++kk) { const int k = wave * 128 + kk; const float wv = w[(size_t)k * 6144];
#pragma unroll
            for (int r = 0; r < 9; ++r) acc[r] += sc[r * 1024 + k] * wv; }
#pragma unroll
        for (int r = 0; r < 9; ++r) part[(wave * 9 + r) * 64 + lane] = acc[r];
        __syncthreads();
        for (int i = otid(); i < 9 * 64; i += NTHR) { const int r = i >> 6, cc = i & 63; float s = 0.f;
#pragma unroll
            for (int ww = 0; ww < 8; ++ww) s += part[(ww * 9 + r) * 64 + cc];
            const int c2 = (task % 96) * 64 + cc; mods[((size_t)layer * 9 + r) * 6144 + c2] = s + p.in[5][layer * 6144 + c2]; }
        __syncthreads();
    }
    float* rope = (float*)(p.ws + ws::ROPE);
    for (int gid = bid * NTHR + otid(); gid < L * 32; gid += nb * NTHR) {
        const int l = gid >> 5, j = gid & 31, axis = j >> 4, f = j & 15;
        const float pos = (float)(axis == 0 ? (l / 64) : (l % 64));
        const float inv = (float)pow(10000.0, -(double)(2 * f) / 32.0);
        const float ang = pos * inv;
        rope[gid] = (float)cos((double)ang); rope[L * 32 + gid] = (float)sin((double)ang);
    }
}

#define XB_TMO      128
#define XB_XCNT(j)  (256  + 64 * (j))
#define XB_XSUB(j)  (1280 + 64 * (j))
#define XB_XGEN(j)  (2304 + 64 * (j))
#define XB_TOP      3328
#define XB_TOPGEN   3392
#define XCD_BAR_WORDS 3456
#define XB_SPIN_CAP (1u << 18)

__device__ __forceinline__ unsigned xb_ld(unsigned* p)              { return __hip_atomic_load(p, __ATOMIC_RELAXED, __HIP_MEMORY_SCOPE_AGENT); }
__device__ __forceinline__ unsigned xb_add(unsigned* p, unsigned v) { return __hip_atomic_fetch_add(p, v, __ATOMIC_RELAXED, __HIP_MEMORY_SCOPE_AGENT); }
__device__ __forceinline__ unsigned xb_xcc_id() { return (unsigned)__builtin_amdgcn_s_getreg((3 << 11) | 20) & 0xFu; }
#define XB_SPIN(cond, bar) do { unsigned _sp = 0; while (cond) { __builtin_amdgcn_s_sleep(1); \
    if ((++_sp & 255u) == 0u) { if (xb_ld(&(bar)[XB_TMO])) break; if (_sp > XB_SPIN_CAP) { atomicAdd(&(bar)[XB_TMO], 1u); break; } } } } while (0)

struct XcdBarrier {
    unsigned* bar; unsigned x;
    volatile LAS unsigned* st;
};

__device__ __forceinline__ XcdBarrier xcd_barrier_post(unsigned* bar, volatile LAS unsigned* st) {
    XcdBarrier b; b.bar = bar; b.x = xb_xcc_id(); b.st = st;
    if (threadIdx.x == 0) (void)xb_add(&bar[XB_XCNT(b.x)], 1u);
    return b;
}
__device__ __forceinline__ void xcd_barrier_complete(unsigned* bar, unsigned x, unsigned& nloc, unsigned& nx) {
    const unsigned G = gridDim.x * gridDim.y * gridDim.z;
    unsigned sum, cnt, mine, sp = 0u;
    for (;;) {
        sum = 0u; cnt = 0u; mine = 0u;
#pragma unroll
        for (unsigned j = 0; j < 16; ++j) { const unsigned c = xb_ld(&bar[XB_XCNT(j)]); sum += c; cnt += (c > 0u) ? 1u : 0u; mine = (j == x) ? c : mine; }
        if (sum == G) break;
        __builtin_amdgcn_s_sleep(1);
        if ((++sp & 255u) == 0u) { if (xb_ld(&bar[XB_TMO])) break; if (sp > XB_SPIN_CAP) { atomicAdd(&bar[XB_TMO], 1u); break; } }
    }
    nloc = mine > 0u ? mine : 1u; nx = cnt > 0u ? cnt : 1u;
}

__device__ __forceinline__ void xcd_barrier(const XcdBarrier& b) {
    asm volatile("s_waitcnt vmcnt(0)" ::: "memory");
    __syncthreads();
    if (threadIdx.x == 0) {
        unsigned* bar = b.bar;
        __builtin_amdgcn_s_waitcnt(0);
        unsigned nloc = b.st[0], nx = b.st[1];
        if (nloc == 0u) { xcd_barrier_complete(bar, b.x, nloc, nx); b.st[0] = nloc; b.st[1] = nx; }
        const unsigned old = xb_add(&bar[XB_XSUB(b.x)], 1u);
        const unsigned gen = old / nloc;
        if (old + 1u == (gen + 1u) * nloc) {
            __builtin_amdgcn_fence(__ATOMIC_RELEASE, "agent");
            asm volatile("s_waitcnt vmcnt(0)" ::: "memory");
            const unsigned og = xb_add(&bar[XB_TOP], 1u);
            const unsigned tg = og / nx;
            if (og + 1u == (tg + 1u) * nx) xb_add(&bar[XB_TOPGEN], 1u);
            else XB_SPIN(xb_ld(&bar[XB_TOPGEN]) == tg, bar);
            __builtin_amdgcn_fence(__ATOMIC_ACQUIRE, "agent");
            xb_add(&bar[XB_XGEN(b.x)], 1u);
            asm volatile("s_waitcnt vmcnt(0)" ::: "memory");
        } else {
            XB_SPIN(xb_ld(&bar[XB_XGEN(b.x)]) == gen, bar);
            __builtin_amdgcn_fence(__ATOMIC_ACQUIRE, "agent");
            asm volatile("s_waitcnt vmcnt(0)" ::: "memory");
        }
    }
    __syncthreads();
}


#ifndef MK_MULTI
#define MK_MULTI 0
#endif
constexpr int CW_BAR = 4096;
constexpr int N_PHASES = 38;
__global__ void __launch_bounds__(NTHR, 2) mega(Params p) {
    LAS unsigned char* lds = (LAS unsigned char*)dyn_lds;
    volatile LAS unsigned* st = (volatile LAS unsigned*)(lds + LDS_MISC + 1024);
    if (threadIdx.x == 0) { st[0] = 0u; st[1] = 0u; st[2] = 0u; st[3] = 0u; }
    __syncthreads();
    const int bid = blockIdx.x, nb = gridDim.x;
    const int lo = p.ph_lo, hi = p.ph_hi;
    const bool one = (hi - lo) == N_PHASES;
    XcdBarrier xb; xb.bar = (unsigned*)(p.ws + ws::CTL) + CW_BAR; xb.x = 0; xb.st = st;
    if (one) xb = xcd_barrier_post((unsigned*)(p.ws + ws::CTL) + CW_BAR, st);
#define PH(idx) ((idx) >= lo && (idx) < hi)
#define SEAM() do { if (one) xcd_barrier(xb); } while (0)
    if (PH(0)) { prologue_mods(p, lds, bid, nb); prologue_dense_weights(p, lds, bid, nb); prologue_moe_weights(p, lds, bid, nb); }
    SEAM();
    for (int layer = 0; layer < DEPTH; ++layer) {
        const int pb = 1 + 9 * layer;
        if (PH(pb + 0)) phaseA(p, layer, lds, bid, nb);
        SEAM();
        if (layer == 2) {
            if (PH(pb + 1)) gin_phase(p, lds, bid, nb);
            SEAM();
            if (PH(pb + 2)) gdn_g3_phase(p, lds, bid, nb);
            SEAM();
            if (PH(pb + 3)) gdn_g4_phase(p, bid, nb);
            SEAM();
            if (PH(pb + 4)) gdn_g5_phase(p, lds, bid, nb);
        } else {
            if (PH(pb + 1)) qkv_phase(p, layer, lds, bid, nb);
            SEAM();
            if (PH(pb + 2)) attn_phase_fn(p, layer, lds, bid, nb);
        }
        SEAM();
        if (PH(pb + 5)) oproj_phase(p, layer, lds, bid, nb);
        SEAM();
        if (PH(pb + 6)) phaseE(p, layer, lds, bid, nb);
        SEAM();
        if (PH(pb + 7)) moe_up_phase(p, layer, lds, bid, nb);
        SEAM();
        if (PH(pb + 8)) moe_down_phase(p, layer, lds, bid, nb);
        SEAM();
    }
    if (PH(37)) phaseFinal(p, bid, nb);
#undef PH
#undef SEAM
}

extern "C" void kernel_launch(void* const* d_in, const int* in_sizes, int n_in, void* d_out, int out_size, void* d_ws, size_t ws_size, hipStream_t stream) {
    static int grid = 0;
    if (grid == 0) {
        int dev = 0, cus = 0, per_cu = 0;
        if (ws_size < ws::END) { fprintf(stderr, "kernel_launch: workspace too small: %zu < %zu\n", ws_size, (size_t)ws::END); grid = -1; return; }
        if (hipGetDevice(&dev) != hipSuccess || hipDeviceGetAttribute(&cus, hipDeviceAttributeMultiprocessorCount, dev) != hipSuccess) { grid = -1; return; }
        if (hipFuncSetAttribute((const void*)mega, hipFuncAttributeMaxDynamicSharedMemorySize, LDS_BYTES) != hipSuccess) { fprintf(stderr, "kernel_launch: hipFuncSetAttribute failed\n"); grid = -1; return; }
        if (hipOccupancyMaxActiveBlocksPerMultiprocessor(&per_cu, (const void*)mega, NTHR, LDS_BYTES) != hipSuccess || per_cu < 1) { fprintf(stderr, "kernel_launch: occupancy query says %d\n", per_cu); per_cu = 1; }
        (void)hipGetLastError();
        grid = cus;
    }
    if (grid < 0) return;
    (void)hipMemsetAsync((char*)d_ws + ws::CTL, 0, 65536, stream);
    Params prm{};
    for (int q = 0; q < 30; ++q) prm.in[q] = (const float*)d_in[q];
    prm.out = (float*)d_out; prm.ws = (unsigned char*)d_ws;
#if MK_MULTI
    for (int ph = 0; ph < N_PHASES; ++ph) { prm.ph_lo = ph; prm.ph_hi = ph + 1; hipLaunchKernelGGL(mega, dim3(grid), dim3(NTHR), LDS_BYTES, stream, prm); }
#else
    prm.ph_lo = 0; prm.ph_hi = N_PHASES;
    hipLaunchKernelGGL(mega, dim3(grid), dim3(NTHR), LDS_BYTES, stream, prm);
#endif
}
```

```cpp
#include <hip/hip_runtime.h>
#include <stdint.h>
#include <cstdio>

namespace cfg {
constexpr int D = 1024, NB = 8, L = 2048, C = 256, T = L + C, NTOK = NB * T, DEPTH = 4;
constexpr int HD = 64, NH = 16, NKV = 4, QKV = 1536, WINDOW = 128;
constexpr int GH = 8, GDK = 128, GIN = 4128;
constexpr int NE = 32, TOPK = 4, CAP = NTOK;
constexpr float EPS = 1e-6f;
}
using namespace cfg;

namespace ws {
constexpr size_t al(size_t x) { return (x + 4095) & ~(size_t)4095; }
constexpr size_t CTL = 0;
constexpr size_t MODS = 65536;
constexpr size_t ROPE = al(MODS + (size_t)DEPTH * 9 * 6144 * 4);
constexpr size_t X = al(ROPE + (size_t)L * 32 * 2 * 4);
constexpr size_t SP = al(X + (size_t)NTOK * D * 4);
constexpr size_t LIST = al(SP + (size_t)NTOK * 32 * 4);
constexpr size_t GATE = al(LIST + (size_t)NE * CAP * 4);
constexpr size_t POSI = al(GATE + (size_t)NTOK * 4 * 4);
constexpr size_t HB = al(POSI + (size_t)NTOK * 4 * 4);
constexpr size_t QB = al(HB + (size_t)NTOK * 1024 * 2);
constexpr size_t KB = al(QB + (size_t)NTOK * 1024 * 2);
constexpr size_t VB = al(KB + (size_t)NTOK * 256 * 2);
constexpr size_t PB = al(VB + (size_t)NTOK * 256 * 2);
constexpr size_t OBF = al(PB + (size_t)NTOK * 4096 * 2);
constexpr size_t ACTB = al(OBF + (size_t)NTOK * 1024 * 2);
constexpr size_t YSB = al(ACTB + (size_t)81920 * 1024 * 2);
constexpr size_t GDNS = al(YSB + (size_t)81920 * 1024 * 2);
constexpr size_t WT_UP = al(GDNS + (size_t)NB * 36 * 8 * 2 * 90120);
constexpr size_t WT_DN = al(WT_UP + (size_t)4 * 32 * 2048 * 1024 * 2);
constexpr size_t WT_QKV = al(WT_DN + (size_t)4 * 32 * 1024 * 1024 * 2);
constexpr size_t WT_O = al(WT_QKV + (size_t)3 * 1536 * 1024 * 2);
constexpr size_t WT_GIN = al(WT_O + (size_t)4 * 1024 * 1024 * 2);
constexpr size_t WT_RT = al(WT_GIN + (size_t)4096 * 1024 * 2);
constexpr size_t MODAB = al(WT_RT + (size_t)4 * 2 * 32 * 1024 * 2);
constexpr size_t END = al(MODAB + (size_t)4 * 9 * 2 * 1024 * 4);
constexpr int CW_CNT = 1024;
constexpr int CW_OFFS = 2048;
}

__device__ __forceinline__ int cond_row(int n) { int b = n / T, p = n % T; return p < C ? 8 : b; }
__device__ __forceinline__ float silu_f(float v) { return v / (1.f + expf(-v)); }

__device__ __forceinline__ int otid() { int t = threadIdx.x; asm volatile("" : "+v"(t)); return t; }
#if defined(PROBE_SECTION)
#define PSEC_ACC(lds_) ((__attribute__((address_space(3))) unsigned long long*)((lds_) + 131072 + 1536))
#define PSEC_BEGIN() const unsigned long long psec_t0_ = __builtin_amdgcn_s_memrealtime()
#define PSEC_END(id, lds_, tid_) do { if ((id) == PROBE_SECTION && (tid_) == 0) *PSEC_ACC(lds_) += __builtin_amdgcn_s_memrealtime() - psec_t0_; } while (0)
#else
#define PSEC_BEGIN() do { } while (0)
#define PSEC_END(id, lds_, tid_) do { } while (0)
#endif
#define LDS_BARRIER() do { asm volatile("s_waitcnt lgkmcnt(0)" ::: "memory"); __builtin_amdgcn_s_barrier(); asm volatile("" ::: "memory"); } while (0)

namespace pg8 {
#define PG8_LAS __attribute__((address_space(3)))
typedef unsigned short bf16_t;
typedef short bf16x8 __attribute__((ext_vector_type(8)));
typedef float f32x4 __attribute__((ext_vector_type(4)));
typedef unsigned u32x4 __attribute__((ext_vector_type(4)));
constexpr int BM = 256, BK = 64, HALF = 128, HTB = HALF * BK * 2  , STAGE_BYTES = 8 * HTB;
__host__ __device__ __forceinline__ int lds_byte(int r, int c) { const int st = (r >> 4) * 2 + (c >> 5), rr = r & 15, cc = c & 31, ob = rr * 64 + cc * 2; return st * 1024 + (ob ^ (((ob >> 9) & 1) << 5)); }
__host__ __device__ __forceinline__ void stage_rc(int b, int& R, int& C) { const int st = b / 1024, sb = b % 1024, swz = sb ^ (((sb >> 9) & 1) << 5); R = (st >> 1) * 16 + swz / 64; C = (st & 1) * 32 + (swz % 64) / 2; }
__host__ __device__ __forceinline__ int perm32(int rho) { const int n = rho >> 4, i = rho & 15; return 8 * (i >> 2) + 4 * n + (i & 3); }
struct Unit { const char* a; const char* b; int pm, pn, e, mt, cnt, lx; };
__device__ __forceinline__ unsigned cvt_pk_bf16(float lo, float hi) { unsigned r; asm volatile("v_cvt_pk_bf16_f32 %0, %1, %2" : "=v"(r) : "v"(lo), "v"(hi)); return r; }
template <class Epi, class Sched, bool ALIGN_EPI = false, bool SP2 = false, bool GATHER = false, bool HALFM = false>
__device__ __forceinline__ void gemm_phase(PG8_LAS unsigned char* lds, const int Kdim, const Sched& S, const Epi& E) {
    const int tid = otid(), wid = __builtin_amdgcn_readfirstlane(tid >> 6), lane = tid & 63, wr = wid >> 2, wc = wid & 3, fr = lane & 15, fq = lane >> 4;
    const int K = Kdim, nt = K / BK;
    unsigned voffA[2], voffB[2];
#pragma unroll
    for (int i = 0; i < 2; ++i) { int R, C; stage_rc(tid * 16 + i * 8192, R, C); const int Rb = Epi::PERM ? ((R & ~31) + perm32(R & 31)) : R;
        voffA[i] = (unsigned)(R * K + C) * 2u; voffB[i] = (unsigned)(Rb * K + C) * 2u; }
    int RA[2]; unsigned CA2[2];
#pragma unroll
    for (int i = 0; i < 2; ++i) { int R, C; stage_rc(tid * 16 + i * 8192, R, C); RA[i] = R; CA2[i] = (unsigned)C * 2u; }
    const size_t kstep = (size_t)(BK * 2);
    const size_t hstep = (size_t)HALF * K * 2;
    const unsigned ldsw = (unsigned)wid * 1024u;
    const int aoff = lds_byte(wr * 64 + fr, fq * 8), boff = lds_byte(wc * 32 + fr, fq * 8);
#define PG8_SA(b, h) (((b) * 2 + (h)) * HTB)
#define PG8_SB(b, h) ((4 + (b) * 2 + (h)) * HTB)
#define PG8_STAGE(bufoff, gbase, voff) do { _Pragma("unroll") for (int _i = 0; _i < 2; ++_i) \
        __builtin_amdgcn_global_load_lds((const unsigned*)((const char*)(gbase) + (voff)[_i]), (PG8_LAS unsigned*)(lds + (bufoff) + ldsw + _i * 8192), 16, 0, 0); } while (0)
#define PG8_STAGE_G(bufoff, kb, g) do { _Pragma("unroll") for (int _i = 0; _i < 2; ++_i) \
        __builtin_amdgcn_global_load_lds((const unsigned*)(gA + (size_t)(kb) + (g)[_i]), (PG8_LAS unsigned*)(lds + (bufoff) + ldsw + _i * 8192), 16, 0, 0); } while (0)
#define PG8_LDA(dst, b, h) do { _Pragma("unroll") for (int m = 0; m < 4; ++m) _Pragma("unroll") for (int k = 0; k < 2; ++k) dst[m][k] = *(const PG8_LAS bf16x8*)(lds + PG8_SA(b, h) + aoff + m * 2048 + k * 1024); } while (0)
#define PG8_LDB(dst, b, h) do { _Pragma("unroll") for (int n = 0; n < 2; ++n) _Pragma("unroll") for (int k = 0; k < 2; ++k) dst[n][k] = *(const PG8_LAS bf16x8*)(lds + PG8_SB(b, h) + boff + n * 2048 + k * 1024); } while (0)
#define PG8_MMA(ai, bj, At, Bt) do { __builtin_amdgcn_s_setprio(1); _Pragma("unroll") for (int m = 0; m < 4; ++m) _Pragma("unroll") for (int n = 0; n < 2; ++n) _Pragma("unroll") for (int k = 0; k < 2; ++k) \
        acc[ai][bj][m][n] = __builtin_amdgcn_mfma_f32_16x16x32_bf16(Bt[n][k], At[m][k], acc[ai][bj][m][n], 0, 0, 0); __builtin_amdgcn_s_setprio(0); } while (0)
#define PG8_WAIT_V(n) asm volatile("s_waitcnt vmcnt(" #n ")" ::: "memory")
#define PG8_WAIT_L(n) asm volatile("s_waitcnt lgkmcnt(" #n ")" ::: "memory")
#define PG8_BAR __builtin_amdgcn_s_barrier()
#define PG8_SCHED __builtin_amdgcn_sched_barrier(0)
    Unit cur, nxt; int ui = 0;
    if (!S.next(0, cur)) return;
    f32x4 acc[2][2][4][2];
#pragma unroll
    for (int a = 0; a < 2; ++a)
#pragma unroll
        for (int b = 0; b < 2; ++b)
#pragma unroll
            for (int m = 0; m < 4; ++m)
#pragma unroll
                for (int n = 0; n < 2; ++n) acc[a][b][m][n] = (f32x4){0.f, 0.f, 0.f, 0.f};
    bf16x8 At[4][2], B0[2][2], B1[2][2];
    const char* cA = cur.a; const char* cB = cur.b;
    S.a_ready(cur);
    const char* gA = nullptr; unsigned gc[2][2] = {{0u, 0u}, {0u, 0u}}, gn[2][2] = {{0u, 0u}, {0u, 0u}};
    if constexpr (GATHER) { static_assert(SP2, "GATHER needs the SP2 loop"); gA = S.abase();
        Unit u1; const bool h1 = S.next(1, u1);
#pragma unroll
        for (int h = 0; h < 2; ++h)
#pragma unroll
            for (int i = 0; i < 2; ++i) { gc[h][i] = (unsigned)S.row_index(cur, h * HALF + RA[i]) * (unsigned)(K * 2) + CA2[i]; gn[h][i] = h1 ? (unsigned)S.row_index(u1, h * HALF + RA[i]) * (unsigned)(K * 2) + CA2[i] : gc[h][i]; } }
    if constexpr (SP2) {
        PG8_STAGE(PG8_SB(0, 0), cB, voffB); PG8_STAGE(PG8_SB(0, 1), cB + hstep, voffB);
        if constexpr (GATHER) { PG8_STAGE_G(PG8_SA(0, 0), 0, gc[0]); PG8_STAGE_G(PG8_SA(0, 1), 0, gc[1]); } else { PG8_STAGE(PG8_SA(0, 0), cA, voffA); PG8_STAGE(PG8_SA(0, 1), cA + hstep, voffA); }
        if (wr == 1) PG8_BAR;
        PG8_WAIT_V(2); PG8_BAR;
        PG8_STAGE(PG8_SB(1, 0), cB + kstep, voffB); if constexpr (GATHER) PG8_STAGE_G(PG8_SA(1, 0), kstep, gc[0]); else PG8_STAGE(PG8_SA(1, 0), cA + kstep, voffA); PG8_STAGE(PG8_SB(1, 1), cB + hstep + kstep, voffB);
        PG8_WAIT_V(6); PG8_BAR;
    } else {
        PG8_STAGE(PG8_SB(0, 0), cB, voffB); PG8_STAGE(PG8_SA(0, 0), cA, voffA); PG8_STAGE(PG8_SB(0, 1), cB + hstep, voffB); PG8_STAGE(PG8_SA(0, 1), cA + hstep, voffA);
        if (wr == 1) PG8_BAR;
        PG8_WAIT_V(4); PG8_BAR;
        PG8_STAGE(PG8_SB(1, 0), cB + kstep, voffB); PG8_STAGE(PG8_SA(1, 0), cA + kstep, voffA); PG8_STAGE(PG8_SB(1, 1), cB + hstep + kstep, voffB);
        PG8_WAIT_V(6); PG8_BAR;
    }
    for (;;) {
        const bool has_next = S.next(ui + 1, nxt);
        int ix[2][2] = {{0, 0}, {0, 0}}; bool has_nn = false;
        if constexpr (GATHER) { Unit nn; has_nn = has_next && S.next(ui + 2, nn);
            if (has_nn) {
#pragma unroll
                for (int h = 0; h < 2; ++h)
#pragma unroll
                    for (int i = 0; i < 2; ++i) ix[h][i] = S.row_index(nn, h * HALF + RA[i]); } }
        const char* nA = has_next ? nxt.a : cA; const char* nB = has_next ? nxt.b : cB;
        for (int t = 0; t < nt; t += 2) {
            const bool last = (t == nt - 2);
            const char* a1 = cA + (size_t)(t + 1) * kstep;
            const char* a2 = last ? nA : cA + (size_t)(t + 2) * kstep; const char* b2 = last ? nB : cB + (size_t)(t + 2) * kstep;
            const char* a3 = a2 + kstep; const char* b3 = b2 + kstep;
            if (last && has_next) S.a_ready(nxt);
            unsigned s0[2] = {0u, 0u}, s1[2] = {0u, 0u}; size_t kb2 = 0;
            if constexpr (GATHER) { kb2 = last ? (size_t)0 : (size_t)(t + 2) * kstep;
#pragma unroll
                for (int i = 0; i < 2; ++i) { s0[i] = last ? gn[0][i] : gc[0][i]; s1[i] = last ? gn[1][i] : gc[1][i]; } }
            if constexpr (SP2) {
            PG8_LDB(B0, 0, 0); PG8_LDB(B1, 0, 1); PG8_SCHED; PG8_LDA(At, 0, 0); if constexpr (GATHER) PG8_STAGE_G(PG8_SA(1, 1), (size_t)(t + 1) * kstep, gc[1]); else PG8_STAGE(PG8_SA(1, 1), a1 + hstep, voffA);
            PG8_WAIT_V(8); PG8_WAIT_L(0); PG8_BAR; PG8_MMA(0, 0, At, B0); PG8_MMA(0, 1, At, B1); PG8_BAR; PG8_SCHED;
            if constexpr (!HALFM) PG8_LDA(At, 0, 1); PG8_STAGE(PG8_SB(0, 0), b2, voffB); PG8_STAGE(PG8_SB(0, 1), b2 + hstep, voffB); if constexpr (GATHER) PG8_STAGE_G(PG8_SA(0, 0), kb2, s0); else PG8_STAGE(PG8_SA(0, 0), a2, voffA);
            PG8_WAIT_V(8); PG8_WAIT_L(0); PG8_BAR; if constexpr (!HALFM) { PG8_MMA(1, 0, At, B0); PG8_MMA(1, 1, At, B1); } PG8_BAR; PG8_SCHED;
            PG8_LDB(B0, 1, 0); PG8_LDB(B1, 1, 1); PG8_SCHED; PG8_LDA(At, 1, 0); if constexpr (GATHER) PG8_STAGE_G(PG8_SA(0, 1), kb2, s1); else PG8_STAGE(PG8_SA(0, 1), a2 + hstep, voffA);
            PG8_WAIT_V(8); PG8_WAIT_L(0); PG8_BAR; PG8_MMA(0, 0, At, B0); PG8_MMA(0, 1, At, B1); PG8_BAR; PG8_SCHED;
            if constexpr (!HALFM) PG8_LDA(At, 1, 1); PG8_STAGE(PG8_SB(1, 0), b3, voffB); PG8_STAGE(PG8_SB(1, 1), b3 + hstep, voffB); if constexpr (GATHER) PG8_STAGE_G(PG8_SA(1, 0), kb2 + kstep, s0); else PG8_STAGE(PG8_SA(1, 0), a3, voffA);
            PG8_WAIT_V(8); PG8_WAIT_L(0); PG8_BAR; if constexpr (!HALFM) { PG8_MMA(1, 0, At, B0); PG8_MMA(1, 1, At, B1); } PG8_BAR; PG8_SCHED;
            } else {
            PG8_LDB(B0, 0, 0); PG8_SCHED; PG8_LDA(At, 0, 0); PG8_STAGE(PG8_SA(1, 1), a1 + hstep, voffA);
            PG8_WAIT_L(8); PG8_BAR; PG8_WAIT_L(0); PG8_MMA(0, 0, At, B0); PG8_BAR; PG8_SCHED;
            PG8_LDB(B1, 0, 1); PG8_STAGE(PG8_SB(0, 0), b2, voffB);
            PG8_BAR; PG8_WAIT_L(0); PG8_MMA(0, 1, At, B1); PG8_BAR;
            PG8_LDA(At, 0, 1); PG8_STAGE(PG8_SA(0, 0), a2, voffA);
            PG8_BAR; PG8_WAIT_L(0); PG8_MMA(1, 0, At, B0); PG8_BAR; PG8_SCHED;
            PG8_STAGE(PG8_SB(0, 1), b2 + hstep, voffB);
            PG8_WAIT_V(6); PG8_BAR; PG8_MMA(1, 1, At, B1); PG8_BAR;
            PG8_LDB(B0, 1, 0); PG8_SCHED; PG8_LDA(At, 1, 0); PG8_STAGE(PG8_SA(0, 1), a2 + hstep, voffA);
            PG8_WAIT_L(8); PG8_BAR; PG8_WAIT_L(0); PG8_MMA(0, 0, At, B0); PG8_BAR; PG8_SCHED;
            PG8_LDB(B1, 1, 1); PG8_STAGE(PG8_SB(1, 0), b3, voffB);
            PG8_BAR; PG8_WAIT_L(0); PG8_MMA(0, 1, At, B1); PG8_BAR;
            PG8_LDA(At, 1, 1); PG8_STAGE(PG8_SA(1, 0), a3, voffA);
            PG8_BAR; PG8_WAIT_L(0); PG8_MMA(1, 0, At, B0); PG8_BAR; PG8_SCHED;
            PG8_STAGE(PG8_SB(1, 1), b3 + hstep, voffB);
            PG8_WAIT_V(6); PG8_BAR; PG8_MMA(1, 1, At, B1); PG8_BAR;
            }
        }
        if constexpr (ALIGN_EPI) { if (wr == 0) PG8_BAR; }
        if constexpr (!Epi::AFTER_DRAIN) { E(acc, cur, wr, wc, fr, fq); S.done(cur); }
        if (!has_next) break;
#pragma unroll
        for (int a = 0; a < 2; ++a)
#pragma unroll
            for (int b = 0; b < 2; ++b)
#pragma unroll
                for (int m = 0; m < 4; ++m)
#pragma unroll
                    for (int n = 0; n < 2; ++n) acc[a][b][m][n] = (f32x4){0.f, 0.f, 0.f, 0.f};
        cur = nxt; cA = nA; cB = nB; ++ui;
        if constexpr (GATHER) {
#pragma unroll
            for (int h = 0; h < 2; ++h)
#pragma unroll
                for (int i = 0; i < 2; ++i) { gc[h][i] = gn[h][i]; if (has_nn) gn[h][i] = (unsigned)ix[h][i] * (unsigned)(K * 2) + CA2[i]; } }
        if constexpr (ALIGN_EPI) { if (wr == 1) PG8_BAR; }
    }
    PG8_WAIT_V(0);
    if constexpr (!ALIGN_EPI) { if (wr == 0) PG8_BAR; }
    PG8_BAR;
    if constexpr (Epi::AFTER_DRAIN) { E.fused(acc, cur, wr, wc, fr, fq, lds, wid, lane); S.done(cur); }
#undef PG8_SA
#undef PG8_SB
#undef PG8_STAGE
#undef PG8_STAGE_G
#undef PG8_LDA
#undef PG8_LDB
#undef PG8_MMA
#undef PG8_WAIT_V
#undef PG8_WAIT_L
#undef PG8_BAR
#undef PG8_SCHED
}
}

constexpr int NTHR = 512, LDS_BYTES = 147456, LDS_MISC = 131072;
#define LAS __attribute__((address_space(3)))
typedef unsigned short bf16_t;
typedef unsigned v4u __attribute__((ext_vector_type(4)));
typedef float f32x4 __attribute__((ext_vector_type(4)));
__device__ __forceinline__ unsigned f2bf(float f) { unsigned u = __builtin_bit_cast(unsigned, f); return (u + 0x7fffu + ((u >> 16) & 1u)) >> 16; }
__device__ __forceinline__ unsigned pk2(float lo, float hi) { return f2bf(lo) | (f2bf(hi) << 16); }
__device__ __forceinline__ float bf2f(unsigned b) { return __builtin_bit_cast(float, b << 16); }
#define LDS_WAIT() asm volatile("s_waitcnt lgkmcnt(0)" ::: "memory")

struct Params {
    const float* in[30];
    float* out;
    unsigned char* ws;
    int ph_lo; int ph_hi;
};

__device__ __forceinline__ void transpose_item(const float* W, int N, bf16_t* WT  , int k0, int nlog0, LAS float* scr, int lane) {
#pragma unroll
    for (int i = 0; i < 32; ++i) { const int kk = 2 * i + (lane >> 5); scr[kk * 33 + (lane & 31)] = W[(size_t)(k0 + kk) * N + nlog0 + (lane & 31)]; }
    LDS_WAIT(); asm volatile("" ::: "memory");
    const int c = lane & 7;
#pragma unroll
    for (int j = 0; j < 4; ++j) { const int n = (lane >> 3) + 8 * j; const LAS float* s = scr + (8 * c) * 33 + n;
        v4u o; o.x = pk2(s[0 * 33], s[1 * 33]); o.y = pk2(s[2 * 33], s[3 * 33]); o.z = pk2(s[4 * 33], s[5 * 33]); o.w = pk2(s[6 * 33], s[7 * 33]);
        *(v4u*)(WT + (size_t)n * 1024 + k0 + 8 * c) = o; }
    LDS_WAIT(); asm volatile("" ::: "memory");
}
__device__ __forceinline__ int upmap(int n0) { return ((n0 & 255) >> 7) * 1024 + (n0 >> 8) * 128 + (n0 & 127); }

__device__ __forceinline__ void moe_item_addr(const Params& p, int layer, int it, const float*& W, int& N, bf16_t*& WT, int& k0, int& nlog0) {
    if (it < 32 * 1024) { const int mi = layer * 32 + (it >> 10), r = it & 1023, kb = r >> 6, n0 = (r & 63) * 32;
        W = p.in[25] + (size_t)mi * 1024 * 2048; N = 2048; WT = (bf16_t*)(p.ws + ws::WT_UP) + ((size_t)mi * 2048 + n0) * 1024; k0 = kb * 64; nlog0 = upmap(n0); }
    else { const int j = it - 32 * 1024, mi = layer * 32 + (j >> 9), r = j & 511, kb = r >> 5, n0 = (r & 31) * 32;
        W = p.in[27] + (size_t)mi * 1024 * 1024; N = 1024; WT = (bf16_t*)(p.ws + ws::WT_DN) + ((size_t)mi * 1024 + n0) * 1024; k0 = kb * 64; nlog0 = n0; }
}
__device__ __forceinline__ void moe_item_load(const Params& p, int layer, int it, int lane, f32x4 (&v)[8]) {
    const float* W; int N, k0, nlog0; bf16_t* WT; moe_item_addr(p, layer, it, W, N, WT, k0, nlog0);
    const int g = lane >> 3, nq = lane & 7;
#pragma unroll
    for (int j = 0; j < 8; ++j) v[j] = *(const f32x4*)(W + (size_t)(k0 + 8 * g + j) * N + nlog0 + 4 * nq);
}
__device__ __forceinline__ void moe_item_store(const Params& p, int layer, int it, int lane, const f32x4 (&v)[8]) {
    const float* W; int N, k0, nlog0; bf16_t* WT; moe_item_addr(p, layer, it, W, N, WT, k0, nlog0);
    const int g = lane >> 3, nq = lane & 7;
#pragma unroll
    for (int i = 0; i < 4; ++i) { v4u o; o.x = pg8::cvt_pk_bf16(v[0][i], v[1][i]); o.y = pg8::cvt_pk_bf16(v[2][i], v[3][i]); o.z = pg8::cvt_pk_bf16(v[4][i], v[5][i]); o.w = pg8::cvt_pk_bf16(v[6][i], v[7][i]);
        *(v4u*)(WT + (size_t)(4 * nq + i) * 1024 + k0 + 8 * g) = o; }
}
constexpr int SIDE_JQ = 8, SIDE_JG = 8, SIDE_JQ3 = 6;
constexpr int TAIL_Q0 = 0, POOL1_BEG = TAIL_Q0 + 640 * SIDE_JQ;
constexpr int TAIL_Q1 = 18432, POOL2_BEG = TAIL_Q1 + 640 * SIDE_JQ, TAIL2_END = POOL2_BEG;
constexpr int TAIL_G2 = 36864, TAIL_Q3 = TAIL_G2 + 1024 * SIDE_JG, TAIL3_END = TAIL_Q3 + 640 * SIDE_JQ3;
static_assert(TAIL2_END <= 49152 && TAIL3_END <= 49152, "tail side work exceeds the items");
__device__ __forceinline__ void moe_item_copy_nt(const Params& p, int layer, int it, int lane, f32x4 (&v)[8], bool store) {
    const float* W; int N, k0, nlog0; bf16_t* WT; moe_item_addr(p, layer, it, W, N, WT, k0, nlog0);
    const int g = lane >> 3, nq = lane & 7;
    if (!store) {
#pragma unroll
        for (int j = 0; j < 8; ++j) v[j] = __builtin_nontemporal_load((const f32x4*)(W + (size_t)(k0 + 8 * g + j) * N + nlog0 + 4 * nq));
    } else {
#pragma unroll
        for (int i = 0; i < 4; ++i) { v4u o; o.x = pg8::cvt_pk_bf16(v[0][i], v[1][i]); o.y = pg8::cvt_pk_bf16(v[2][i], v[3][i]); o.z = pg8::cvt_pk_bf16(v[4][i], v[5][i]); o.w = pg8::cvt_pk_bf16(v[6][i], v[7][i]);
            __builtin_nontemporal_store(o, (v4u*)(WT + (size_t)(4 * nq + i) * 1024 + k0 + 8 * g)); }
    }
}
__device__ __forceinline__ void side_tail(const Params& p, int layer, int base, int slot, int nslots, int J) {
    const int lane = otid() & 63, wave = otid() >> 6;
#pragma unroll 1
    for (int j = 0; j < J; j += 2) {
        f32x4 v0[8], v1[8];
        const int it0 = base + slot * 8 + wave + nslots * 8 * j, it1 = it0 + nslots * 8;
        moe_item_copy_nt(p, layer, it0, lane, v0, false); moe_item_copy_nt(p, layer, it1, lane, v1, false);
        moe_item_copy_nt(p, layer, it0, lane, v0, true); moe_item_copy_nt(p, layer, it1, lane, v1, true);
    }
}
constexpr int SIDE_JU = 18;
__device__ __forceinline__ int moe_tiles(const int* cnt) { int t = 0;
#pragma unroll
    for (int e = 0; e < 32; ++e) t += (cnt[e] + 255) >> 8;
    return t; }
__device__ __forceinline__ void side_range(const Params& p, int layer, int beg, int end, int first, int stride) {
    const int lane = otid() & 63;
#pragma unroll 1
    for (int it0 = beg + first; it0 < end; it0 += 3 * stride) {
        f32x4 v0[8], v1[8], v2[8]; const int it1 = it0 + stride, it2 = it1 + stride; const bool two = it1 < end, three = it2 < end;
        moe_item_copy_nt(p, layer, it0, lane, v0, false); if (two) moe_item_copy_nt(p, layer, it1, lane, v1, false); if (three) moe_item_copy_nt(p, layer, it2, lane, v2, false);
        moe_item_copy_nt(p, layer, it0, lane, v0, true); if (two) moe_item_copy_nt(p, layer, it1, lane, v1, true); if (three) moe_item_copy_nt(p, layer, it2, lane, v2, true);
    }
}
struct PoolRanges { int rem_up, ns_up, beg_up, end_up, rem_dn, ns_dn, end_dn; };
__device__ __forceinline__ PoolRanges pool_ranges(const Params& p, int L) {
    const int T = moe_tiles((const int*)(p.ws + ws::CTL) + ws::CW_CNT + L * 32);
    PoolRanges r; r.rem_up = (8 * T) & 255; r.ns_up = r.rem_up ? 256 - r.rem_up : 0; r.rem_dn = T & 63; r.ns_dn = r.rem_dn ? (64 - r.rem_dn) * 4 : 0;
    r.beg_up = L == 0 ? POOL1_BEG : POOL2_BEG; r.end_up = min(r.beg_up + r.ns_up * 8 * SIDE_JU, 49152); r.end_dn = min(r.end_up + r.ns_dn * 8 * SIDE_JU, 49152);
    return r;
}
__device__ __forceinline__ void moe_up_tail(const Params& p, int L, int bid) {
    const PoolRanges r = pool_ranges(p, L);
    if (r.ns_up && bid >= r.rem_up) side_range(p, L + 1, r.beg_up, r.end_up, (bid - r.rem_up) * 8 + (otid() >> 6), r.ns_up * 8);
}
__device__ __forceinline__ void moe_down_tail(const Params& p, int L, int bid) {
    const PoolRanges r = pool_ranges(p, L); const int j = bid >> 3, tl = (bid & 7) * 8 + (j >> 2);
    if (r.ns_dn && tl >= r.rem_dn) side_range(p, L + 1, r.end_up, r.end_dn, ((tl - r.rem_dn) * 4 + (j & 3)) * 8 + (otid() >> 6), r.ns_dn * 8);
}
__device__ __forceinline__ void moe_pool_finish(const Params& p, int L, int bid, int nb) {
    const PoolRanges r = pool_ranges(p, L);
    side_range(p, L + 1, r.end_dn, 49152, bid * 8 + (otid() >> 6), nb * 8);
}
__device__ __forceinline__ void prologue_moe_weights(const Params& p, LAS unsigned char* lds, int bid, int nb) {
    const int lane = otid() & 63, wave = otid() >> 6;
    LAS float* scr = (LAS float*)(lds + wave * 16384);
    const int gw = bid * 8 + wave, NGW = nb * 8;
    const float* w_up = p.in[25]; const float* w_dn = p.in[27];
    bf16_t* WTU = (bf16_t*)(p.ws + ws::WT_UP); bf16_t* WTD = (bf16_t*)(p.ws + ws::WT_DN);
    const int NL = nb == 256 ? 1 : 2;
    const int IU = NL * 32 * 1024, ID = NL * 32 * 512;
    for (int it = gw; it < IU + ID; it += NGW) {
        if (it < IU) { const int mi = it >> 10, r = it & 1023, kb = r >> 6, nbk = r & 63, n0 = nbk * 32;
            transpose_item(w_up + (size_t)mi * 1024 * 2048, 2048, WTU + ((size_t)mi * 2048 + n0) * 1024, kb * 64, upmap(n0), scr, lane); }
        else { const int j = it - IU, mi = j >> 9, r = j & 511, kb = r >> 5, nbk = r & 31, n0 = nbk * 32;
            transpose_item(w_dn + (size_t)mi * 1024 * 1024, 1024, WTD + ((size_t)mi * 1024 + n0) * 1024, kb * 64, n0, scr, lane); }
    }
    const int t2s = nb == 256 ? 49152 : 18432, t3s = nb == 256 ? TAIL3_END : 36864;
    const int T2 = 49152 - t2s, T3 = 49152 - t3s;
    for (int q = gw; q < T2 + T3; q += NGW) { const int layer = q < T2 ? 2 : 3, it = q < T2 ? t2s + q : t3s + q - T2;
        f32x4 v[8]; moe_item_load(p, layer, it, lane, v); moe_item_store(p, layer, it, lane, v); }
}

constexpr int TAB_TPRE = 0, TAB_OFFP = 64, TAB_UNIT = 128, TAB_CNT = 192, TAB_LX = 224;
__device__ __forceinline__ void moe_tables(const int* cnt, LAS int* tab, int ntn = 0, int c = 0, int G = 1) {
    __syncthreads();
    const int tid = otid();
    if (tid == 0) { int t = 0; for (int e = 0; e < 32; ++e) { tab[TAB_TPRE + e] = t; tab[TAB_OFFP + e] = t * 256; tab[TAB_CNT + e] = cnt[e]; t += (cnt[e] + 255) >> 8; } tab[TAB_TPRE + 32] = t; tab[TAB_OFFP + 32] = t * 256; }
    __syncthreads();
    if (ntn > 0 && tid < 32) {
        const int total = tab[TAB_TPRE + 32] * ntn; int v = -1;
        int Lx = tid * G + c;
        if (ntn == 4 && G == 256) { const int x = c & 7, j = c >> 3; Lx = (tid * 64 + x * 8 + (j >> 2)) * 4 + (j & 3); }
        if (Lx < total) { const int tile = Lx / ntn, pn = Lx % ntn; int e = 0; for (int k = 1; k < 32; ++k) e += (tab[TAB_TPRE + k] <= tile) ? 1 : 0; v = (e << 24) | ((tile - tab[TAB_TPRE + e]) << 8) | pn; }
        tab[TAB_UNIT + tid] = v; tab[TAB_LX + tid] = Lx;
    }
    __syncthreads();
}
template <bool UP> struct MoeOrder {
    const LAS int* tab; const char* A; const char* Bt; const int* list;
    static constexpr int NTN = UP ? 8 : 4;
    __device__ __forceinline__ void init(const LAS int* tab_, const void* A_, const void* Bt_, const int* list_ = nullptr) { tab = tab_; A = (const char*)A_; Bt = (const char*)Bt_; list = list_; }
    __device__ __forceinline__ const char* abase() const { return A; }
    __device__ __forceinline__ int row_index(const pg8::Unit& u, int r) const { const int pos = u.mt * 256 + r; return pos < u.cnt ? list[u.e * CAP + pos] : 0; }
    __device__ __forceinline__ bool next(int i, pg8::Unit& u) const {
        if (i >= 32) return false;
        const int v = __builtin_amdgcn_readfirstlane(tab[TAB_UNIT + i]); if (v < 0) return false;
        const int e = v >> 24, mt = (v >> 8) & 0xffff, pn = v & 0xff;
        const int offp = __builtin_amdgcn_readfirstlane(tab[TAB_OFFP + e]);
        u.e = e; u.mt = mt; u.pn = pn; u.pm = offp + mt * 256; u.cnt = __builtin_amdgcn_readfirstlane(tab[TAB_CNT + e]); u.lx = __builtin_amdgcn_readfirstlane(tab[TAB_LX + i]);
        const size_t arow = UP ? (size_t)e * CAP + (size_t)mt * 256 : (size_t)(offp + mt * 256);
        u.a = A + arow * 2048;
        u.b = Bt + ((size_t)e * (NTN * 256) + (size_t)pn * 256) * 2048;
        return true;
    }
    __device__ __forceinline__ void a_ready(const pg8::Unit&) const {}
    __device__ __forceinline__ void done(const pg8::Unit&) const {}
};
struct EpiMoeUp {
    static constexpr bool PERM = true, AFTER_DRAIN = false;
    bf16_t* ACT; const float* b_up;
    const Params* sp; int side_layer;
    __device__ __forceinline__ void operator()(const pg8::f32x4 (&acc)[2][2][4][2], const pg8::Unit& u, int wr, int wc, int fr, int fq) const {
        const bool side = side_layer >= 0 && u.lx < 2304; const int sit = u.lx * 8 + wr * 4 + wc, slane = fq * 16 + fr;
        f32x4 sv[8];
        if (side) moe_item_load(*sp, side_layer, sit, slane, sv);
        const int colj = u.pn * 128 + wc * 32 + 8 * fq;
        const float* bg = b_up + u.e * 2048 + colj;
        f32x4 bgv[2], blv[2];
#pragma unroll
        for (int n = 0; n < 2; ++n) { bgv[n] = *(const f32x4*)(bg + 4 * n); blv[n] = *(const f32x4*)(bg + 1024 + 4 * n); }
#pragma unroll
        for (int ai = 0; ai < 2; ++ai)
#pragma unroll
            for (int m = 0; m < 4; ++m) {
                const int row = u.pm + ai * 128 + wr * 64 + m * 16 + fr;
                float a[8];
#pragma unroll
                for (int n = 0; n < 2; ++n)
#pragma unroll
                    for (int j = 0; j < 4; ++j) {
                        const float g = fminf(acc[ai][0][m][n][j] + bgv[n][j], 7.f);
                        const float l = fminf(fmaxf(acc[ai][1][m][n][j] + blv[n][j], -7.f), 7.f);
                        const float sg = __builtin_amdgcn_rcpf(1.f + __builtin_amdgcn_exp2f(-1.702f * 1.4426950408889634f * g));
                        a[n * 4 + j] = g * sg * (l + 1.f);
                    }
                pg8::u32x4 w; w.x = pg8::cvt_pk_bf16(a[0], a[1]); w.y = pg8::cvt_pk_bf16(a[2], a[3]); w.z = pg8::cvt_pk_bf16(a[4], a[5]); w.w = pg8::cvt_pk_bf16(a[6], a[7]);
                *(pg8::u32x4*)(ACT + (size_t)row * 1024 + colj) = w;
            }
        if (side) moe_item_store(*sp, side_layer, sit, slane, sv);
    }
};
struct EpiMoeDown {
    static constexpr bool PERM = true, AFTER_DRAIN = false;
    bf16_t* YS; const float* b_down;
    const Params* sp; int side_layer;
    __device__ __forceinline__ void operator()(const pg8::f32x4 (&acc)[2][2][4][2], const pg8::Unit& u, int wr, int wc, int fr, int fq) const {
        const bool side = side_layer >= 0 && u.lx < 1152; const int sit = 18432 + u.lx * 8 + wr * 4 + wc, slane = fq * 16 + fr;
        f32x4 sv[8];
        if (side) moe_item_load(*sp, side_layer, sit, slane, sv);
        const int col0 = u.pn * 256 + wc * 32 + 8 * fq;
        f32x4 bv[2][2];
#pragma unroll
        for (int bj = 0; bj < 2; ++bj)
#pragma unroll
            for (int n = 0; n < 2; ++n) bv[bj][n] = *(const f32x4*)(b_down + u.e * 1024 + col0 + bj * 128 + 4 * n);
#pragma unroll
        for (int ai = 0; ai < 2; ++ai)
#pragma unroll
            for (int m = 0; m < 4; ++m) {
                bf16_t* rowp = YS + (size_t)(u.pm + ai * 128 + wr * 64 + m * 16 + fr) * 1024 + col0;
#pragma unroll
                for (int bj = 0; bj < 2; ++bj) {
                    const f32x4 v0 = acc[ai][bj][m][0] + bv[bj][0], v1 = acc[ai][bj][m][1] + bv[bj][1];
                    pg8::u32x4 w; w.x = pg8::cvt_pk_bf16(v0[0], v0[1]); w.y = pg8::cvt_pk_bf16(v0[2], v0[3]); w.z = pg8::cvt_pk_bf16(v1[0], v1[1]); w.w = pg8::cvt_pk_bf16(v1[2], v1[3]);
                    *(pg8::u32x4*)(rowp + bj * 128) = w;
                }
            }
        if (side) moe_item_store(*sp, side_layer, sit, slane, sv);
    }
};
__device__ __forceinline__ void moe_up_phase(const Params& p, int layer, LAS unsigned char* lds, int bid, int nb) {
    const int* cnt = (const int*)(p.ws + ws::CTL) + ws::CW_CNT + layer * 32;
    LAS int* tab = (LAS int*)(lds + LDS_MISC);
    moe_tables(cnt, tab, 8, bid, nb);
    MoeOrder<true> S; S.init(tab, p.ws + ws::HB, (const bf16_t*)(p.ws + ws::WT_UP) + (size_t)layer * 32 * 2048 * 1024, (const int*)(p.ws + ws::LIST));
    EpiMoeUp E; E.ACT = (bf16_t*)(p.ws + ws::ACTB); E.b_up = p.in[26] + (size_t)layer * 32 * 2048; E.sp = &p; E.side_layer = -1;
    pg8::gemm_phase<EpiMoeUp, MoeOrder<true>, true, true, true>(lds, 1024, S, E);
    if (nb == 256 && layer < 2) moe_up_tail(p, layer, bid);
}
__device__ __forceinline__ void moe_down_phase(const Params& p, int layer, LAS unsigned char* lds, int bid, int nb) {
    const int* cnt = (const int*)(p.ws + ws::CTL) + ws::CW_CNT + layer * 32;
    LAS int* tab = (LAS int*)(lds + LDS_MISC);
    moe_tables(cnt, tab, 4, bid, nb);
    MoeOrder<false> S; S.init(tab, p.ws + ws::ACTB, (const bf16_t*)(p.ws + ws::WT_DN) + (size_t)layer * 32 * 1024 * 1024);
    EpiMoeDown E; E.YS = (bf16_t*)(p.ws + ws::YSB); E.b_down = p.in[28] + (size_t)layer * 32 * 1024; E.sp = &p; E.side_layer = -1;
    pg8::gemm_phase<EpiMoeDown, MoeOrder<false>, true, true>(lds, 1024, S, E);
    if (nb == 256 && layer < 2) moe_down_tail(p, layer, bid);
}

extern __shared__ __attribute__((aligned(16))) unsigned char dyn_lds[];

constexpr float QSCALE = 0.125f * 1.4426950408889634f;
__device__ __forceinline__ int qkvmap(int n0) { const int p = n0 & 255; return (n0 >> 8) * 256 + ((p & 127) >> 5) * 64 + (p >> 7) * 32; }

__device__ __forceinline__ void prologue_dense_weights(const Params& p, LAS unsigned char* lds, int bid, int nb) {
    const int lane = otid() & 63, wave = otid() >> 6;
    LAS float* scr = (LAS float*)(lds + wave * 16384);
    const int gw = bid * 8 + wave, NGW = nb * 8;
    bf16_t* WQ = (bf16_t*)(p.ws + ws::WT_QKV); bf16_t* WO = (bf16_t*)(p.ws + ws::WT_O); bf16_t* WG = (bf16_t*)(p.ws + ws::WT_GIN);
    constexpr int IQ = 16 * 48, IO = 16 * 32, IG = 16 * 128;
    for (int it = gw; it < 3 * IQ + 4 * IO + IG; it += NGW) {
        int r = it;
        if (r < 3 * IQ) { const int mi = r / IQ, q = r % IQ, kb = q / 48, n0 = (q % 48) * 32;
            const float* W = mi == 1 ? p.in[13] : p.in[8] + (size_t)(mi == 2 ? 1 : 0) * 1024 * 1536;
            transpose_item(W, 1536, WQ + ((size_t)mi * 1536 + n0) * 1024, kb * 64, qkvmap(n0), scr, lane); continue; }
        r -= 3 * IQ;
        if (r < 4 * IO) { const int mi = r / IO, q = r % IO, kb = q / 32, n0 = (q % 32) * 32;
            const float* W = mi == 0 ? p.in[11] : mi == 1 ? p.in[16] : mi == 2 ? p.in[22] : p.in[11] + (size_t)1024 * 1024;
            transpose_item(W, 1024, WO + ((size_t)mi * 1024 + n0) * 1024, kb * 64, n0, scr, lane); continue; }
        r -= 4 * IO;
        { const int kb = r / 128, n0 = (r % 128) * 32; transpose_item(p.in[17], 4128, WG + (size_t)n0 * 1024, kb * 64, n0, scr, lane); }
    }
}

struct DenseOrder {
    const char* A; const char* Bt; int nN, c, G, total; bool latent_only;
    __device__ __forceinline__ void init(const void* A_, const void* Bt_, int nM, int nN_, int c_, int G_, bool latent_only_ = false) { A = (const char*)A_; Bt = (const char*)Bt_; nN = nN_; c = c_; G = G_; latent_only = latent_only_; total = (latent_only_ ? 64 : nM) * nN_; }
    __device__ __forceinline__ bool next(int i, pg8::Unit& u) const {
        const int Lx = i * G + c; if (Lx >= total) return false;
        const int grp = Lx / (8 * nN), r = Lx % (8 * nN);
        const int j = grp * 8 + (r & 7); u.pm = latent_only ? (j >> 3) * 9 + 1 + (j & 7) : j; u.pn = r >> 3; u.e = 0; u.mt = 0; u.cnt = 0; u.lx = Lx;
        u.a = A + (size_t)u.pm * 256 * 2048; u.b = Bt + (size_t)u.pn * 256 * 2048;
        return true;
    }
    __device__ __forceinline__ const char* abase() const { return A; }
    __device__ __forceinline__ int row_index(const pg8::Unit&, int) const { return 0; }
    __device__ __forceinline__ void a_ready(const pg8::Unit&) const {}
    __device__ __forceinline__ void done(const pg8::Unit&) const {}
};

struct EpiQKV {
    static constexpr bool PERM = true, AFTER_DRAIN = false;
    bf16_t* Q; bf16_t* Kb; bf16_t* Vb; const float* bias; const float* gq; const float* gk; const LAS float* rtab;
    __device__ __forceinline__ void operator()(const pg8::f32x4 (&acc)[2][2][4][2], const pg8::Unit& u, int wr, int wc, int fr, int fq) const {
        const int kind = u.pn < 4 ? 0 : (u.pn == 4 ? 1 : 2);
        const bool latent = (u.pm % 9) != 0;
        const int lcol = u.pn * 256 + wc * 64 + 8 * fq;
        f32x4 bv[2][2], gv[2][2];
#pragma unroll
        for (int bj = 0; bj < 2; ++bj)
#pragma unroll
            for (int n = 0; n < 2; ++n) {
                bv[bj][n] = bias ? *(const f32x4*)(bias + lcol + bj * 32 + 4 * n) : (f32x4){0.f, 0.f, 0.f, 0.f};
                const float* g = kind == 0 ? gq : gk;
                gv[bj][n] = (g && kind < 2) ? *(const f32x4*)(g + 8 * fq + bj * 32 + 4 * n) : (f32x4){1.f, 1.f, 1.f, 1.f};
            }
        const bool donorm = (gq != nullptr) && kind < 2;
        const bool dorope = latent && kind < 2;
        const int second = fq >> 1, fbase = 8 * (fq & 1);
        bf16_t* base = kind == 0 ? Q : (kind == 1 ? Kb : Vb);
        const int opitch = kind == 0 ? 1024 : 256;
        const int ocol = (kind == 0 ? u.pn * 256 : 0) + wc * 64 + 8 * fq;
#pragma unroll
        for (int ai = 0; ai < 2; ++ai)
#pragma unroll
            for (int m = 0; m < 4; ++m) {
                const int row = u.pm * 256 + ai * 128 + wr * 64 + m * 16 + fr;
                f32x4 x[2][2];
#pragma unroll
                for (int bj = 0; bj < 2; ++bj)
#pragma unroll
                    for (int n = 0; n < 2; ++n) x[bj][n] = acc[ai][bj][m][n] + bv[bj][n];
                if (donorm) {
                    float ss = 0.f;
#pragma unroll
                    for (int bj = 0; bj < 2; ++bj)
#pragma unroll
                        for (int n = 0; n < 2; ++n) ss += (x[bj][n][0] * x[bj][n][0] + x[bj][n][1] * x[bj][n][1]) + (x[bj][n][2] * x[bj][n][2] + x[bj][n][3] * x[bj][n][3]);
                    ss += __shfl_xor(ss, 16); ss += __shfl_xor(ss, 32);
                    const float rs = rsqrtf(ss * (1.f / 64.f) + EPS);
#pragma unroll
                    for (int bj = 0; bj < 2; ++bj)
#pragma unroll
                        for (int n = 0; n < 2; ++n) x[bj][n] = x[bj][n] * rs * gv[bj][n];
                }
                if (dorope) {
                    const int l = row % T - C;
                    const LAS float* tp[2] = {rtab + (l >> 6) * 32 + fbase, rtab + 32 * 32 + (l & 63) * 32 + fbase};
#pragma unroll
                    for (int bj = 0; bj < 2; ++bj)
#pragma unroll
                        for (int n = 0; n < 2; ++n) {
                            const f32x4 cs = *(const LAS f32x4*)(tp[bj] + 4 * n), sn = *(const LAS f32x4*)(tp[bj] + 16 + 4 * n);
                            f32x4 o;
#pragma unroll
                            for (int j = 0; j < 4; ++j) { const float other = __shfl_xor(x[bj][n][j], 32); o[j] = second ? (x[bj][n][j] * cs[j] + other * sn[j]) : (x[bj][n][j] * cs[j] - other * sn[j]); }
                            x[bj][n] = o;
                        }
                }
                const float sc = kind == 0 ? QSCALE : 1.f;
                bf16_t* rowp = base + (size_t)row * opitch + ocol;
#pragma unroll
                for (int bj = 0; bj < 2; ++bj) {
                    const f32x4 v0 = x[bj][0] * sc, v1 = x[bj][1] * sc;
                    pg8::u32x4 w; w.x = pg8::cvt_pk_bf16(v0[0], v0[1]); w.y = pg8::cvt_pk_bf16(v0[2], v0[3]); w.z = pg8::cvt_pk_bf16(v1[0], v1[1]); w.w = pg8::cvt_pk_bf16(v1[2], v1[3]);
                    *(pg8::u32x4*)(rowp + bj * 32) = w;
                }
            }
    }
};
struct EpiPlainBf16 {
    static constexpr bool PERM = true, AFTER_DRAIN = false;
    bf16_t* O; int ldc;
    __device__ __forceinline__ void operator()(const pg8::f32x4 (&acc)[2][2][4][2], const pg8::Unit& u, int wr, int wc, int fr, int fq) const {
        const int col0 = u.pn * 256 + wc * 32 + 8 * fq;
#pragma unroll
        for (int ai = 0; ai < 2; ++ai)
#pragma unroll
            for (int m = 0; m < 4; ++m) { bf16_t* rowp = O + (size_t)(u.pm * 256 + ai * 128 + wr * 64 + m * 16 + fr) * ldc + col0;
#pragma unroll
                for (int bj = 0; bj < 2; ++bj) { const f32x4 v0 = acc[ai][bj][m][0], v1 = acc[ai][bj][m][1];
                    pg8::u32x4 w; w.x = pg8::cvt_pk_bf16(v0[0], v0[1]); w.y = pg8::cvt_pk_bf16(v0[2], v0[3]); w.z = pg8::cvt_pk_bf16(v1[0], v1[1]); w.w = pg8::cvt_pk_bf16(v1[2], v1[3]);
                    *(pg8::u32x4*)(rowp + bj * 128) = w; } }
    }
};
struct EpiResid {
    static constexpr bool PERM = true, AFTER_DRAIN = false;
    bf16_t* X; const float* bias; const float* gate;
    int rowoff = 0, nai = 2;
    __device__ __forceinline__ void operator()(const pg8::f32x4 (&acc)[2][2][4][2], const pg8::Unit& u, int wr, int wc, int fr, int fq) const {
        const int col0 = u.pn * 256 + wc * 32 + 8 * fq;
        const int cr = (u.pm % 9) == 0 ? 8 : u.pm / 9;
        f32x4 bv[2][2], gv[2][2];
#pragma unroll
        for (int bj = 0; bj < 2; ++bj)
#pragma unroll
            for (int n = 0; n < 2; ++n) { const int c = col0 + bj * 128 + 4 * n;
                bv[bj][n] = bias ? *(const f32x4*)(bias + c) : (f32x4){0.f, 0.f, 0.f, 0.f}; gv[bj][n] = *(const f32x4*)(gate + (size_t)cr * 6144 + c); }
#pragma unroll
        for (int ai = 0; ai < 2; ++ai) if (ai < nai)
#pragma unroll
            for (int m = 0; m < 4; ++m) { bf16_t* rowp = X + (size_t)(u.pm * 256 + rowoff + ai * 128 + wr * 64 + m * 16 + fr) * 1024 + col0;
#pragma unroll
                for (int bj = 0; bj < 2; ++bj) { pg8::u32x4* ptr = (pg8::u32x4*)(rowp + bj * 128); const pg8::u32x4 xo = *ptr;
                    const f32x4 v0 = gv[bj][0] * (acc[ai][bj][m][0] + bv[bj][0]), v1 = gv[bj][1] * (acc[ai][bj][m][1] + bv[bj][1]);
                    pg8::u32x4 w;
                    w.x = pg8::cvt_pk_bf16(bf2f(xo.x & 0xffffu) + v0[0], bf2f(xo.x >> 16) + v0[1]); w.y = pg8::cvt_pk_bf16(bf2f(xo.y & 0xffffu) + v0[2], bf2f(xo.y >> 16) + v0[3]);
                    w.z = pg8::cvt_pk_bf16(bf2f(xo.z & 0xffffu) + v1[0], bf2f(xo.z >> 16) + v1[1]); w.w = pg8::cvt_pk_bf16(bf2f(xo.w & 0xffffu) + v1[2], bf2f(xo.w >> 16) + v1[3]);
                    *ptr = w; } }
    }
};
__device__ __forceinline__ int qkv_slot(int layer) { return layer == 0 ? 0 : (layer == 1 ? 1 : 2); }
constexpr int LDS_ROPE = LDS_MISC + 4096;
__device__ __forceinline__ void qkv_phase(const Params& p, int layer, LAS unsigned char* lds, int bid, int nb) {
    LAS float* rtab = (LAS float*)(lds + LDS_ROPE);
    __syncthreads();
    for (int i = otid(); i < 96 * 32; i += NTHR) {
        const int rr = i >> 5, j = i & 31, f = j & 15, l = rr < 32 ? rr * 64 : rr - 32, axis = rr < 32 ? 0 : 1;
        const float* rope = (const float*)(p.ws + ws::ROPE);
        rtab[i] = rope[(j < 16 ? 0 : L * 32) + l * 32 + axis * 16 + f];
    }
    __syncthreads();
    DenseOrder S; S.init(p.ws + ws::HB, (const bf16_t*)(p.ws + ws::WT_QKV) + (size_t)qkv_slot(layer) * 1536 * 1024, 72, 6, bid, nb);
    EpiQKV E; E.Q = (bf16_t*)(p.ws + ws::QB); E.Kb = (bf16_t*)(p.ws + ws::KB); E.Vb = (bf16_t*)(p.ws + ws::VB); E.rtab = rtab;
    if (layer == 1) { E.bias = nullptr; E.gq = p.in[14]; E.gk = p.in[15]; } else { E.bias = p.in[9] + (layer == 3 ? 1536 : 0); E.gq = nullptr; E.gk = nullptr; }
    pg8::gemm_phase<EpiQKV, DenseOrder, true, true>(lds, 1024, S, E);
    if (nb == 256 && bid >= 176) side_tail(p, layer == 0 ? 1 : (layer == 1 ? 2 : 3), layer == 0 ? TAIL_Q0 : (layer == 1 ? TAIL_Q1 : TAIL_Q3), bid - 176, 80, layer < 2 ? SIDE_JQ : SIDE_JQ3);
}
__device__ __forceinline__ void gin_phase(const Params& p, LAS unsigned char* lds, int bid, int nb) {
    DenseOrder S; S.init(p.ws + ws::HB, p.ws + ws::WT_GIN, 72, 16, bid, nb);
    EpiPlainBf16 E; E.O = (bf16_t*)(p.ws + ws::PB); E.ldc = 4096;
    pg8::gemm_phase<EpiPlainBf16, DenseOrder, true, true>(lds, 1024, S, E);
    if (nb == 256 && bid >= 128) side_tail(p, 3, TAIL_G2, bid - 128, 128, SIDE_JG);
}
struct OneUnit {
    const char* A; const char* Bt; int pm, pn, rowoff;
    __device__ __forceinline__ bool next(int i, pg8::Unit& u) const { if (i > 0) return false; u.pm = pm; u.pn = pn; u.e = 0; u.mt = 0; u.cnt = 0; u.lx = 0; u.a = A + ((size_t)pm * 256 + rowoff) * 2048; u.b = Bt + (size_t)pn * 256 * 2048; return true; }
    __device__ __forceinline__ const char* abase() const { return A; }
    __device__ __forceinline__ int row_index(const pg8::Unit&, int) const { return 0; }
    __device__ __forceinline__ void a_ready(const pg8::Unit&) const {}
    __device__ __forceinline__ void done(const pg8::Unit&) const {}
};
__device__ __forceinline__ void oproj_ctx_unit(const Params& p, int layer, LAS unsigned char* lds, int b, int pn, int half) {
    OneUnit S; S.A = (const char*)(p.ws + ws::OBF); S.Bt = (const char*)((const bf16_t*)(p.ws + ws::WT_O) + (size_t)layer * 1024 * 1024); S.pm = 9 * b; S.pn = pn; S.rowoff = 128 * half;
    EpiResid E; E.X = (bf16_t*)(p.ws + ws::X); E.bias = layer == 0 ? p.in[12] : (layer == 3 ? p.in[12] + 1024 : nullptr);
    E.gate = (const float*)(p.ws + ws::MODS) + (size_t)layer * 9 * 6144 + 2 * 1024; E.rowoff = 128 * half; E.nai = 1;
    pg8::gemm_phase<EpiResid, OneUnit, true, true, false, true>(lds, 1024, S, E);
}
__device__ __forceinline__ void oproj_phase(const Params& p, int layer, LAS unsigned char* lds, int bid, int nb) {
    DenseOrder S; S.init(p.ws + ws::OBF, (const bf16_t*)(p.ws + ws::WT_O) + (size_t)layer * 1024 * 1024, 72, 4, bid, nb, layer == 3 || nb == 256);
    EpiResid E; E.X = (bf16_t*)(p.ws + ws::X); E.bias = layer == 0 ? p.in[12] : (layer == 3 ? p.in[12] + 1024 : nullptr);
    E.gate = (const float*)(p.ws + ws::MODS) + (size_t)layer * 9 * 6144 + 2 * 1024;
    pg8::gemm_phase<EpiResid, DenseOrder, true, true>(lds, 1024, S, E);
}

#include <hip/hip_bf16.h>
#include <cmath>
namespace attn_body {
using bf16=__hip_bfloat16;
using bf16x8=__attribute__((ext_vector_type(8)))short;
using s16x4=__attribute__((ext_vector_type(4)))short;
using f32x16=__attribute__((ext_vector_type(16)))float;
using u32x4=__attribute__((ext_vector_type(4)))unsigned;
constexpr int D=64,DM=1024,KVP=256;
constexpr int NW=8,QBLK=32,KVBLK=64;
__device__ __forceinline__ int crow(int r,int hi){return (r&3)+8*(r>>2)+4*hi;}
#define SBAR() __builtin_amdgcn_sched_barrier(0)
__device__ __forceinline__ void wmask(f32x16&p0,f32x16&p1,int kv0,int qi,int hi){
  const float NEG=-INFINITY; const int dlt=kv0+4*hi-qi;
  #pragma unroll
  for(int r=0;r<16;++r){const int d0=dlt+(r&3)+8*(r>>2); if(d0>128||d0<-128)p0[r]=NEG; if(d0+32>128||d0+32<-128)p1[r]=NEG;}
}

constexpr int NSLOT=3, SLOTB=8192;
constexpr int LDS_K=0, LDS_V=NSLOT*SLOTB, LDS_WS=2*NSLOT*SLOTB, LDS_OST=LDS_WS+NW*64*4, LDS_BYTES=LDS_OST+NW*4096;
constexpr float C2=0.125f*1.4426950408889634f;
__device__ __forceinline__ void glds16(const void*gsrc,unsigned lds_dst){unsigned keep;
  asm volatile("s_mov_b32 %0, m0\n\ts_mov_b32 m0, %2\n\ts_nop 0\n\tglobal_load_lds_dwordx4 %1, off\n\ts_mov_b32 m0, %0":"=&s"(keep):"v"(gsrc),"s"(lds_dst):"memory");}
__device__ __forceinline__ float max3f(float a,float b,float c){float r;asm("v_max3_f32 %0, %1, %2, %3":"=v"(r):"v"(a),"v"(b),"v"(c));return r;}
__device__ __forceinline__ float max2f(float a,float b){float r;asm("v_max_f32_e32 %0, %1, %2":"=v"(r):"v"(a),"v"(b));return r;}
__device__ __forceinline__ float fadd_s(float a,float b){float r;asm("v_add_f32_e32 %0, %1, %2":"=v"(r):"v"(a),"v"(b));return r;}
__device__ __forceinline__ float fsub_s(float a,float b){float r;asm("v_sub_f32_e32 %0, %1, %2":"=v"(r):"v"(a),"v"(b));return r;}
typedef float f32x2_t __attribute__((ext_vector_type(2))); typedef __bf16 bf16x2_t __attribute__((ext_vector_type(2)));
__device__ __forceinline__ unsigned cvtpk_s(float lo,float hi){f32x2_t v={lo,hi};bf16x2_t b=__builtin_convertvector(v,bf16x2_t);return __builtin_bit_cast(unsigned,b);}
#define WAIT_BAR(N) asm volatile("s_waitcnt vmcnt(" #N ") lgkmcnt(0)\n\ts_barrier":::"memory")

__device__ __forceinline__ void qkt(f32x16&p0,f32x16&p1,const char*Kslot,const bf16x8*qr,const f32x16&negm,int r32,int hi){
  const char*kb=Kslot+hi*1024+r32*16;
  #pragma unroll
  for(int d0=0;d0<4;++d0){
    const bf16x8 b0=*reinterpret_cast<const bf16x8*>(kb+d0*2048);
    const bf16x8 b1=*reinterpret_cast<const bf16x8*>(kb+d0*2048+512);
    if(d0==0){p0=__builtin_amdgcn_mfma_f32_32x32x16_bf16(b0,qr[0],negm,0,0,0);p1=__builtin_amdgcn_mfma_f32_32x32x16_bf16(b1,qr[0],negm,0,0,0);}
    else{p0=__builtin_amdgcn_mfma_f32_32x32x16_bf16(b0,qr[d0],p0,0,0,0);p1=__builtin_amdgcn_mfma_f32_32x32x16_bf16(b1,qr[d0],p1,0,0,0);}}
}
typedef __attribute__((address_space(3))) const char* lds_cptr;
typedef short v4i16_t __attribute__((ext_vector_type(4)));
__device__ __forceinline__ void kload8(bf16x8*kf,lds_cptr kp){
  kf[0]=*(const __attribute__((address_space(3))) bf16x8*)(kp);      kf[1]=*(const __attribute__((address_space(3))) bf16x8*)(kp+512);
  kf[2]=*(const __attribute__((address_space(3))) bf16x8*)(kp+2048); kf[3]=*(const __attribute__((address_space(3))) bf16x8*)(kp+2560);
  kf[4]=*(const __attribute__((address_space(3))) bf16x8*)(kp+4096); kf[5]=*(const __attribute__((address_space(3))) bf16x8*)(kp+4608);
  kf[6]=*(const __attribute__((address_space(3))) bf16x8*)(kp+6144); kf[7]=*(const __attribute__((address_space(3))) bf16x8*)(kp+6656);
}
__device__ __forceinline__ void kload2(bf16x8*kf,lds_cptr kp,int j){ kf[2*j]=*(const __attribute__((address_space(3))) bf16x8*)(kp+j*2048); kf[2*j+1]=*(const __attribute__((address_space(3))) bf16x8*)(kp+j*2048+512); }
__device__ __forceinline__ s16x4 vtr(lds_cptr p){ return __builtin_bit_cast(s16x4,__builtin_amdgcn_ds_read_tr16_b64_v4i16((__attribute__((address_space(3))) v4i16_t*)p)); }
__device__ __forceinline__ float rowmax(const f32x16&p0,const f32x16&p1){
  float a=max3f(p0[0],p0[1],p1[0]),b=max3f(p0[2],p0[3],p1[1]);a=max3f(a,p1[2],p1[3]);
  #pragma unroll
  for(int r=4;r<16;r+=4){a=max3f(a,p0[r],p0[r+1]);b=max3f(b,p0[r+2],p0[r+3]);a=max3f(a,p1[r],p1[r+1]);b=max3f(b,p1[r+2],p1[r+3]);}
  const float m=max2f(a,b);
  auto rr=__builtin_amdgcn_permlane32_swap(__float_as_uint(m),__float_as_uint(m),false,false);
  return max2f(__uint_as_float(rr[0]),__uint_as_float(rr[1]));
}
__device__ __forceinline__ void pv(f32x16*o,int vb,bf16x8 pa0,bf16x8 pa1,bf16x8 pa2,bf16x8 pa3){
  #pragma unroll
  for(int d0=0;d0<2;++d0){s16x4 lo[4],hi[4];
    #pragma unroll
    for(int ks=0;ks<4;++ks){
      asm volatile("ds_read_b64_tr_b16 %0,%1 offset:%c2":"=&v"(lo[ks]):"v"(vb),"i"(d0*4096+ks*1024):"memory");
      asm volatile("ds_read_b64_tr_b16 %0,%1 offset:%c2":"=&v"(hi[ks]):"v"(vb),"i"(d0*4096+ks*1024+512):"memory");}
    asm volatile("s_waitcnt lgkmcnt(0)":::"memory");SBAR();
    #define PK(k) (bf16x8){lo[k][0],lo[k][1],lo[k][2],lo[k][3],hi[k][0],hi[k][1],hi[k][2],hi[k][3]}
    o[d0]=__builtin_amdgcn_mfma_f32_32x32x16_bf16(pa0,PK(0),o[d0],0,0,0);
    o[d0]=__builtin_amdgcn_mfma_f32_32x32x16_bf16(pa1,PK(1),o[d0],0,0,0);
    o[d0]=__builtin_amdgcn_mfma_f32_32x32x16_bf16(pa2,PK(2),o[d0],0,0,0);
    o[d0]=__builtin_amdgcn_mfma_f32_32x32x16_bf16(pa3,PK(3),o[d0],0,0,0);
    #undef PK
  }
}

#ifndef ATTN_STORE16
#define ATTN_STORE16(p,v) (*(u32x4*)(p)=(v))
#endif
template<int THRL> __device__ __forceinline__ void attn_unit(long qrow,int h0,int kvh,long krow,int j0,int NT,bool win,int i0,const float*sink,const bf16*Q,const bf16*__restrict__ K,const bf16*__restrict__ V,bf16*O,char*shm){
  int tid=otid();
  const int lane=tid&63,r32=lane&31,hi=lane>>5; const int wid=__builtin_amdgcn_readfirstlane(tid>>6);
  const int hh=h0+(wid>>2);
  const bf16*Qw=Q+(qrow+(wid&3)*QBLK)*DM+hh*D;
  const bf16*Kh=K+krow*KVP+kvh*D,*Vh=V+krow*KVP+kvh*D;
  const unsigned lds0=(unsigned)(uintptr_t)shm;
  float*wsf=(float*)(shm+LDS_WS)+wid*64;
  const bf16*ksrc=Kh+(long)lane*KVP+wid*8;
  const bf16*vsrc=Vh+(long)(16*(wid&3)+(lane>>2))*KVP+(wid>>2)*32+(lane&3)*8;
  const unsigned kdst=lds0+LDS_K+wid*1024, vdst=lds0+LDS_V+wid*1024;
  #define TROW(t) ((t)<4?64*(t):256+64*(j0+(t)-4))
  #define DMA_K(t,slot) glds16(ksrc+(long)TROW(t)*KVP,(unsigned)__builtin_amdgcn_readfirstlane(kdst+(slot)))
  #define DMA_V(t,slot) glds16(vsrc+(long)TROW(t)*KVP,(unsigned)__builtin_amdgcn_readfirstlane(vdst+(slot)))
  const int vb0=(int)(lds0+LDS_V)+((lane>>4)&1)*32+(lane&3)*8+(4*hi+((lane&15)>>2))*64;
  const char*Kbase=shm+LDS_K; bf16x8 kf[8];
  const lds_cptr shm3=(lds_cptr)shm; const lds_cptr kp0=shm3+LDS_K+hi*1024+r32*16; const lds_cptr vp0=shm3+LDS_V+((lane>>4)&1)*32+(lane&3)*8+(4*hi+((lane&15)>>2))*64;
  DMA_K(0,0);DMA_V(0,0);DMA_K(1,SLOTB);
  bf16x8 qr[4];
  #pragma unroll
  for(int d0=0;d0<4;++d0)qr[d0]=*reinterpret_cast<const bf16x8*>(&Qw[(long)r32*DM+d0*16+hi*8]);
  float mhat=0.f,l_reg=0.f;f32x16 o[2];o[0]=f32x16{};o[1]=f32x16{};f32x16 negm=f32x16{};asm volatile("":"+v"(negm));
  const int qi=i0+(wid&3)*QBLK+r32;
  #define CMASK(P0,P1,t) do{ if(win&&(t)>=4)wmask(P0,P1,64*(j0+(t)-4),qi,hi); }while(0)
  bool resc=false;
  #define START(P0,P1) do{ const float rm=rowmax(P0,P1); resc=false; \
    { const float dl=rm; mhat=fadd_s(mhat,dl); \
      _Pragma("unroll") for(int r=0;r<16;++r){P0[r]=fsub_s(P0[r],dl);P1[r]=fsub_s(P1[r],dl);} \
      _Pragma("unroll") for(int r=0;r<16;++r)negm[r]=-mhat; asm volatile("":"+v"(negm)); } \
    _Pragma("unroll") for(int r=0;r<16;++r)P0[r]=__builtin_amdgcn_exp2f(P0[r]); }while(0)
  #define RESC() do{ if(resc){ asm volatile("s_waitcnt lgkmcnt(0)":::"memory"); \
      _Pragma("unroll") for(int d_=0;d_<2;++d_) _Pragma("unroll") for(int r=0;r<16;++r)o[d_][r]*=wsf[crow(r,hi)]; } }while(0)
  f32x16 pA0,pA1,pB0,pB1;
  int sl_prev=0,sl_cur=0,sl_next=SLOTB;
  #define ROT() do{sl_prev=sl_cur;sl_cur=sl_next;sl_next=(sl_next==(NSLOT-1)*SLOTB)?0:sl_next+SLOTB;}while(0)
  DMA_K(2,2*SLOTB);
  WAIT_BAR(3);
  qkt(pA0,pA1,Kbase,qr,negm,r32,hi);asm volatile("s_nop 15\n\ts_nop 7":"+v"(pA0),"+v"(pA1));CMASK(pA0,pA1,0);
  START(pA0,pA1);
  _Pragma("unroll") for(int r=0;r<16;++r)pA1[r]=__builtin_amdgcn_exp2f(pA1[r]);
  WAIT_BAR(0);
  DMA_K(3,0);DMA_V(1,SLOTB);
  ROT();
  kload8(kf,kp0+sl_cur);
  WAIT_BAR(2);
  s16x4 vlo[8],vhi[8]; u32x4 pw0,pw1,pw2,pw3;
  #define PKW(P,B) cvtpk_s(P[B],P[B+1])
  #define PAF(k) __builtin_bit_cast(bf16x8,pw##k)
  #define VFR(i) (bf16x8){vlo[i][0],vlo[i][1],vlo[i][2],vlo[i][3],vhi[i][0],vhi[i][1],vhi[i][2],vhi[i][3]}
  #define PIN(x) asm volatile("":"+v"(x))
  #define MX3(a,b,c) __builtin_fmaxf(__builtin_fmaxf((a),(b)),(c))
  #define GAPA(MF,A0,A1,A2,A3,W0,W1,PW) do{ MF; sacc+=A0; sacc+=A1; sacc+=A2; sacc+=A3; PIN(sacc); W0; W1; PIN(PW); SBAR(); }while(0)
  #define EX(v) __builtin_amdgcn_exp2f(v)
  #define GAPB(MF,X,B) do{ MF; X[B]=EX(X[B]); X[B+1]=EX(X[B+1]); X[B+2]=EX(X[B+2]); X[B+3]=EX(X[B+3]); PIN(X); SBAR(); }while(0)
  #define VRD(i) do{ vlo[i]=vtr(vp_+(((i)>>2)*4096+((i)&3)*1024)); vhi[i]=vtr(vp_+(((i)>>2)*4096+((i)&3)*1024+512)); }while(0)
  #define KRD(G,j) do{ if(G){ kload2(kf,kp0+sl_next,j); SBAR(); } }while(0)
  #define STEP(C0,C1,P0,P1,t,GK,GV,GL) do{ SBAR(); \
    const lds_cptr vp_=vp0+sl_prev; \
    VRD(0); SBAR(); float sacc=(P0[0]+P0[1]); \
    GAPA(C0=__builtin_amdgcn_mfma_f32_32x32x16_bf16(kf[0],qr[0],negm,0,0,0), P0[2],P0[3],P0[4],P0[5],     pw0[0]=PKW(P0,0), pw0[1]=PKW(P0,2), pw0); \
    VRD(4); SBAR(); GAPA(C1=__builtin_amdgcn_mfma_f32_32x32x16_bf16(kf[1],qr[0],negm,0,0,0), P0[6],P0[7],P0[8],P0[9],     pw0[2]=PKW(P0,4), pw0[3]=PKW(P0,6), pw0); \
    VRD(1); SBAR(); GAPA(C0=__builtin_amdgcn_mfma_f32_32x32x16_bf16(kf[2],qr[1],C0,0,0,0),   P0[10],P0[11],P0[12],P0[13], pw1[0]=PKW(P0,8), pw1[1]=PKW(P0,10), pw1); \
    VRD(5); SBAR(); GAPA(C1=__builtin_amdgcn_mfma_f32_32x32x16_bf16(kf[3],qr[1],C1,0,0,0),   P0[14],P0[15],P1[0],P1[1],   pw1[2]=PKW(P0,12),pw1[3]=PKW(P0,14), pw1); \
    VRD(2); SBAR(); GAPA(C0=__builtin_amdgcn_mfma_f32_32x32x16_bf16(kf[4],qr[2],C0,0,0,0),   P1[2],P1[3],P1[4],P1[5],     pw2[0]=PKW(P1,0), pw2[1]=PKW(P1,2), pw2); \
    VRD(6); SBAR(); GAPA(C1=__builtin_amdgcn_mfma_f32_32x32x16_bf16(kf[5],qr[2],C1,0,0,0),   P1[6],P1[7],P1[8],P1[9],     pw2[2]=PKW(P1,4), pw2[3]=PKW(P1,6), pw2); \
    VRD(3); SBAR(); GAPA(C0=__builtin_amdgcn_mfma_f32_32x32x16_bf16(kf[6],qr[3],C0,0,0,0),   P1[10],P1[11],P1[12],P1[13], pw3[0]=PKW(P1,8), pw3[1]=PKW(P1,10), pw3); \
    VRD(7); SBAR(); GAPA(C1=__builtin_amdgcn_mfma_f32_32x32x16_bf16(kf[7],qr[3],C1,0,0,0),   P1[14],P1[15],0.f,0.f,       pw3[2]=PKW(P1,12),pw3[3]=PKW(P1,14), pw3); \
    l_reg+=sacc; \
    if(GK){DMA_K((t)+3,sl_cur);} if(GV){DMA_V((t)+1,sl_next);} \
    CMASK(C0,C1,t); \
    { float a=MX3(C0[0],C0[1],C1[0]),b=MX3(C0[2],C0[3],C1[1]); a=MX3(a,C1[2],C1[3]); \
      _Pragma("unroll") for(int r=4;r<16;r+=4){a=MX3(a,C0[r],C0[r+1]);b=MX3(b,C0[r+2],C0[r+3]);a=MX3(a,C1[r],C1[r+1]);b=MX3(b,C1[r+2],C1[r+3]);} \
      float rm=__builtin_fmaxf(a,b); { auto rr=__builtin_amdgcn_permlane32_swap(__float_as_uint(rm),__float_as_uint(rm),false,false); rm=__builtin_fmaxf(__uint_as_float(rr[0]),__uint_as_float(rr[1])); } \
      resc=false; \
      if(__builtin_expect(__any(rm>(float)THRL),0)){ const float dl=__builtin_fmaxf(rm,0.f); mhat+=dl; \
        _Pragma("unroll") for(int r=0;r<16;++r){C0[r]-=dl;C1[r]-=dl;} \
        _Pragma("unroll") for(int r=0;r<16;++r)negm[r]=-mhat; asm volatile("":"+v"(negm)); \
        const float f=__builtin_amdgcn_exp2f(-dl); l_reg*=f; if(hi==0)wsf[r32]=f; resc=true; } } \
    SBAR(); \
    GAPB(o[0]=__builtin_amdgcn_mfma_f32_32x32x16_bf16(PAF(0),VFR(0),o[0],0,0,0), C0,0); \
    GAPB(o[1]=__builtin_amdgcn_mfma_f32_32x32x16_bf16(PAF(0),VFR(4),o[1],0,0,0), C0,4); \
    KRD(GL,0); GAPB(o[0]=__builtin_amdgcn_mfma_f32_32x32x16_bf16(PAF(1),VFR(1),o[0],0,0,0), C0,8); \
    KRD(GL,1); GAPB(o[1]=__builtin_amdgcn_mfma_f32_32x32x16_bf16(PAF(1),VFR(5),o[1],0,0,0), C0,12); \
    KRD(GL,2); GAPB(o[0]=__builtin_amdgcn_mfma_f32_32x32x16_bf16(PAF(2),VFR(2),o[0],0,0,0), C1,0); \
    KRD(GL,3); GAPB(o[1]=__builtin_amdgcn_mfma_f32_32x32x16_bf16(PAF(2),VFR(6),o[1],0,0,0), C1,4); \
    GAPB(o[0]=__builtin_amdgcn_mfma_f32_32x32x16_bf16(PAF(3),VFR(3),o[0],0,0,0), C1,8); \
    GAPB(o[1]=__builtin_amdgcn_mfma_f32_32x32x16_bf16(PAF(3),VFR(7),o[1],0,0,0), C1,12); \
    }while(0)
  int t=1;
  for(;t+5<NT;t+=2){
    STEP(pB0,pB1,pA0,pA1,t,true,true,true);     WAIT_BAR(2); RESC(); ROT();
    STEP(pA0,pA1,pB0,pB1,t+1,true,true,true);   WAIT_BAR(2); RESC(); ROT();
  }
  #define ENDW(tt) do{ if((tt)+3<NT){WAIT_BAR(2);} else if((tt)+2<NT){WAIT_BAR(1);} else {WAIT_BAR(0);} }while(0)
  for(;t+1<NT;t+=2){
    STEP(pB0,pB1,pA0,pA1,t,(t+3<NT),(t+1<NT),(t+1<NT));       ENDW(t);   RESC(); ROT();
    STEP(pA0,pA1,pB0,pB1,t+1,(t+4<NT),(t+2<NT),(t+2<NT));     ENDW(t+1); RESC(); ROT();
  }
  STEP(pB0,pB1,pA0,pA1,NT-1,false,false,false); RESC();
  { float sacc=pB0[0]+pB0[1]; _Pragma("unroll") for(int r=2;r<16;++r)sacc+=pB0[r]; _Pragma("unroll") for(int r=0;r<16;++r)sacc+=pB1[r]; l_reg+=sacc;
    pw0=(u32x4){PKW(pB0,0),PKW(pB0,2),PKW(pB0,4),PKW(pB0,6)};pw1=(u32x4){PKW(pB0,8),PKW(pB0,10),PKW(pB0,12),PKW(pB0,14)};pw2=(u32x4){PKW(pB1,0),PKW(pB1,2),PKW(pB1,4),PKW(pB1,6)};pw3=(u32x4){PKW(pB1,8),PKW(pB1,10),PKW(pB1,12),PKW(pB1,14)};
    SBAR(); pv(o,vb0+sl_cur,PAF(0),PAF(1),PAF(2),PAF(3)); }
  #undef PKW
  #undef PAF
  #undef VFR
  #undef PIN
  #undef MX3
  #undef GAPA
  #undef GAPB
  #undef EX
  #undef VRD
  #undef KRD
  #undef STEP
  #undef ENDW
  {auto rr=__builtin_amdgcn_permlane32_swap(__float_as_uint(l_reg),__float_as_uint(l_reg),false,false);l_reg=__uint_as_float(rr[0])+__uint_as_float(rr[1]);}
  if(sink)l_reg+=__builtin_amdgcn_exp2f(sink[hh]*1.4426950408889634f-mhat);
  if(hi==0)wsf[32+r32]=l_reg;asm volatile("s_waitcnt lgkmcnt(0)":::"memory");
  float rli[16];
  #pragma unroll
  for(int r=0;r<16;++r)rli[r]=__builtin_amdgcn_rcpf(wsf[32+crow(r,hi)]);
  bf16*Ow=O+(qrow+(wid&3)*QBLK)*DM+hh*D;
  { bf16*stg=(bf16*)(shm+LDS_OST)+wid*2048;
    #pragma unroll
    for(int r=0;r<16;++r){const int orow=crow(r,hi);
      #pragma unroll
      for(int d0=0;d0<2;++d0)stg[orow*64+d0*32+r32]=__float2bfloat16(o[d0][r]*rli[r]);}
    asm volatile("s_waitcnt lgkmcnt(0)":::"memory");
    #pragma unroll
    for(int i=0;i<4;++i){const int row=i*8+(lane>>3),ch=lane&7; const u32x4 v=*(const u32x4*)(stg+row*64+ch*8); ATTN_STORE16(Ow+(long)row*DM+ch*8,v);} }
  asm volatile("s_waitcnt lgkmcnt(0)\n\ts_barrier":::"memory");
  #undef DMA_K
  #undef TROW
  #undef DMA_V
  #undef CMASK
  #undef START
  #undef RESC
  #undef ROT
}
constexpr int ATTN_LDS_BYTES=LDS_BYTES;
#undef SBAR
#undef WAIT_BAR
}
__device__ __forceinline__ void attn_phase_fn(const Params& p, int layer, LAS unsigned char* lds, int bid, int nb) {
    using attn_body::bf16;
    const bf16* Q = (const bf16*)(p.ws + ws::QB); const bf16* K = (const bf16*)(p.ws + ws::KB); const bf16* V = (const bf16*)(p.ws + ws::VB); bf16* O = (bf16*)(p.ws + ws::OBF);
    const bool win = layer != 1; const bool need_ctx = layer < 3;
    const float* sink = win ? p.in[10] + (layer == 3 ? 16 : 0) : nullptr;
    char* shm = (char*)lds;
    for (int u = bid; u < 1024; u += nb) {
        const int b = u & 7, idx = u >> 3, hp = idx >> 4, qblk = idx & 15;
        const int i0 = qblk * 128;
        int j0 = 0, NT = 36;
        if (win) { const int jlo = max(0, i0 / 64 - 2), jhi = min(31, i0 / 64 + 3); j0 = jlo; NT = 4 + jhi - jlo + 1; }
        attn_body::attn_unit<8>((long)b * T + C + i0, hp * 2, hp >> 1, (long)b * T, j0, NT, win, i0, sink, Q, K, V, O, shm);
    }
    if (need_ctx) for (int u = bid; u < 128; u += nb) {
        const int b = u & 7, idx = u >> 3, hp = idx >> 1, qblk = idx & 1;
        attn_body::attn_unit<8>((long)b * T + qblk * 128, hp * 2, hp >> 1, (long)b * T, 0, 4, false, 0, sink, Q, K, V, O, shm);
    }
}

namespace gdn {
typedef short bf16x8 __attribute__((ext_vector_type(8)));
typedef short bf16x4 __attribute__((ext_vector_type(4)));
typedef float f32x4 __attribute__((ext_vector_type(4)));
typedef float f32x2_t __attribute__((ext_vector_type(2))); typedef __bf16 bf16x2_t __attribute__((ext_vector_type(2)));
__device__ __forceinline__ unsigned cvtpk(float lo, float hi) { f32x2_t v = {lo, hi}; bf16x2_t b = __builtin_convertvector(v, bf16x2_t); return __builtin_bit_cast(unsigned, b); }
__device__ __forceinline__ float bfl(unsigned u) { return __builtin_bit_cast(float, u << 16); }
__device__ __forceinline__ float bfh(unsigned u) { return __builtin_bit_cast(float, u & 0xffff0000u); }
#define MFMA16(a, b, c) __builtin_amdgcn_mfma_f32_16x16x32_bf16((a), (b), (c), 0, 0, 0)
constexpr size_t SZ_W = 16384, SZ_Q = 16384, SZ_KT = 16384, SZ_I = 8192, SZ_U = 16384, SZ_O = 16384;
constexpr size_t NSLOT = (size_t)NB * 36 * 8 * 2;
constexpr size_t OFF_W = 0, OFF_Q = OFF_W + NSLOT * SZ_W, OFF_KT = OFF_Q + NSLOT * SZ_Q, OFF_I = OFF_KT + NSLOT * SZ_KT, OFF_U = OFF_I + NSLOT * SZ_I, OFF_O = OFF_U + NSLOT * SZ_U, OFF_EG = OFF_O + NSLOT * SZ_O, OFF_END = OFF_EG + NSLOT * 4;
static_assert(OFF_END <= (size_t)NB * 36 * 8 * 2 * 90120, "GDN scratch size");
constexpr int QLS = 136, KTST = 72, FS = 65;
constexpr int O_QL = 0, O_KL = 17408, O_AT0 = 0, O_AT1 = 16640, O_KT = 34816, O_VT = 53248, O_KTS = 71680, O_KK = 90112, O_TT1 = 90112, O_QKB = 106752, O_TT0 = 106752, O_TB = 0, O_TG = 9216, O_GV = 125184;
constexpr int GV_BETA = 0, GV_GC = 128, GV_GL = 256;

__device__ __forceinline__ bf16x8 pack8(const f32x4& a, const f32x4& b) { typedef unsigned u4 __attribute__((ext_vector_type(4))); u4 p; p.x = cvtpk(a[0], a[1]); p.y = cvtpk(a[2], a[3]); p.z = cvtpk(b[0], b[1]); p.w = cvtpk(b[2], b[3]); return __builtin_bit_cast(bf16x8, p); }
__device__ __forceinline__ unsigned long long pack4(const f32x4& a) { return (unsigned long long)cvtpk(a[0], a[1]) | ((unsigned long long)cvtpk(a[2], a[3]) << 32); }
__device__ __forceinline__ bf16x8 ldperm_lds(const LAS bf16_t* p) { const bf16x4 a = *(const LAS bf16x4*)p, b = *(const LAS bf16x4*)(p + 16); return (bf16x8){a[0], a[1], a[2], a[3], b[0], b[1], b[2], b[3]}; }
__device__ __forceinline__ bf16x8 ldperm_g(const bf16_t* p) { const bf16x4 a = *(const bf16x4*)p, b = *(const bf16x4*)(p + 16); return (bf16x8){a[0], a[1], a[2], a[3], b[0], b[1], b[2], b[3]}; }

__device__ __forceinline__ void mm16f(f32x4& acc, const LAS float* pa, const LAS float* pb, int lane) {
    const int m = lane & 15, q = lane >> 4;
#pragma unroll
    for (int s = 0; s < 4; ++s) acc = __builtin_amdgcn_mfma_f32_16x16x4f32(pa[m * FS + 4 * s + q], pb[(4 * s + q) * FS + m], acc, 0, 0, 0);
}
__device__ __forceinline__ void st16f(LAS float* pd, const f32x4& v, int lane, float sgn) { const int m = lane & 15, q = lane >> 4;
#pragma unroll
    for (int r = 0; r < 4; ++r) pd[(4 * q + r) * FS + m] = sgn * v[r]; }

__device__ __forceinline__ void g3_item(const Params& p, int b, int c, int h, LAS unsigned char* lds, int side_it) {
    const int tid = otid(), lane = tid & 63, wave = __builtin_amdgcn_readfirstlane(tid >> 6);
    const bf16_t* PBp = (const bf16_t*)(p.ws + ws::PB); const float* SPp = (const float*)(p.ws + ws::SP);
    unsigned char* G = p.ws + ws::GDNS;
    const float* conv_w = p.in[18]; const float* a_log = p.in[19]; const float* dt_bias = p.in[20];
    LAS bf16_t* QL = (LAS bf16_t*)(lds + O_QL); LAS bf16_t* KL = (LAS bf16_t*)(lds + O_KL); LAS bf16_t* KT = (LAS bf16_t*)(lds + O_KT); LAS bf16_t* VT = (LAS bf16_t*)(lds + O_VT);
    LAS bf16_t* KTS = (LAS bf16_t*)(lds + O_KTS); LAS float* KK = (LAS float*)(lds + O_KK); LAS bf16_t* QKB = (LAS bf16_t*)(lds + O_QKB);
    LAS bf16_t* TB = (LAS bf16_t*)(lds + O_TB); LAS bf16_t* TG = (LAS bf16_t*)(lds + O_TG);
    LAS float* GV = (LAS float*)(lds + O_GV);
    const size_t n0 = (size_t)b * T + 64 * c;
    const int seg_lo = c < 4 ? 0 : C, seg_hi = c < 4 ? C : T;
    const size_t sl0 = (((size_t)b * 36 + c) * 8 + h) * 2;
    LDS_BARRIER();
    { PSEC_BEGIN();
    {
        const int task = tid < 256 ? tid : 256 + ((tid - 256) & 127);
        const int hb = tid < 256 ? 0 : (wave >> 1) - 2, he = tid < 256 ? 2 : hb + 1;
        const int rg = task / 48, kind = (task % 48) >> 4, cg = task & 15;
        const int ch = kind * 1024 + h * 128 + 8 * cg;
        v4u raw[12]; f32x4 w0[5], w1[5];
#pragma unroll
        for (int rr = 0; rr < 12; ++rr) { const int pp = 64 * c + 8 * rg + rr - 2;
            raw[rr] = (pp >= seg_lo && pp < seg_hi && rr >= 4 * hb && rr < 4 * he + 4) ? *(const v4u*)(PBp + ((size_t)b * T + pp) * 4096 + ch) : (v4u){0u, 0u, 0u, 0u}; }
#pragma unroll
        for (int j = 0; j < 5; ++j) { w0[j] = *(const f32x4*)(conv_w + j * 3072 + ch); w1[j] = *(const f32x4*)(conv_w + j * 3072 + ch + 4); }
#pragma unroll
        for (int half = 0; half < 2; ++half) if (half >= hb && half < he) {
            float o[4][8];
#pragma unroll
            for (int r = 0; r < 4; ++r) {
#pragma unroll
                for (int e = 0; e < 8; ++e) o[r][e] = 0.f;
#pragma unroll
                for (int j = 0; j < 5; ++j) { const v4u x = raw[4 * half + r + j]; const unsigned xs[4] = {x.x, x.y, x.z, x.w};
#pragma unroll
                    for (int e2 = 0; e2 < 4; ++e2) { const float wa = e2 < 2 ? w0[j][2 * e2] : w1[j][2 * e2 - 4], wb = e2 < 2 ? w0[j][2 * e2 + 1] : w1[j][2 * e2 - 3];
                        o[r][2 * e2] += bfl(xs[e2]) * wa; o[r][2 * e2 + 1] += bfh(xs[e2]) * wb; } }
                float ss = 0.f;
#pragma unroll
                for (int e = 0; e < 8; ++e) { const float v = o[r][e]; o[r][e] = v * __builtin_amdgcn_rcpf(1.f + __expf(-v)); ss += o[r][e] * o[r][e]; }
                ss += __shfl_xor(ss, 1); ss += __shfl_xor(ss, 2); ss += __shfl_xor(ss, 4); ss += __shfl_xor(ss, 8);
                if (kind < 2) { const float rs = rsqrtf(ss + EPS) * (kind == 0 ? 0.08838834764831845f : 1.f);
#pragma unroll
                    for (int e = 0; e < 8; ++e) o[r][e] *= rs; }
            }
            if (kind < 2) { LAS bf16_t* dst = kind == 0 ? QL : KL;
#pragma unroll
                for (int r = 0; r < 4; ++r) { v4u w; w.x = cvtpk(o[r][0], o[r][1]); w.y = cvtpk(o[r][2], o[r][3]); w.z = cvtpk(o[r][4], o[r][5]); w.w = cvtpk(o[r][6], o[r][7]);
                    *(LAS v4u*)(dst + (8 * rg + 4 * half + r) * QLS + 8 * cg) = w; } }
            if (kind >= 1) { LAS bf16_t* dst = kind == 1 ? KT : VT;
#pragma unroll
                for (int e = 0; e < 8; ++e) { const unsigned long long w = (unsigned long long)cvtpk(o[0][e], o[1][e]) | ((unsigned long long)cvtpk(o[2][e], o[3][e]) << 32);
                    *(LAS unsigned long long*)(dst + (8 * cg + e) * KTST + 8 * rg + 4 * half) = w; } }
        }
    }
    if (tid >= 384) {
        const int i = lane;
        { const int d = wave & 1;
            const float bl = SPp[(n0 + i) * 32 + d * 8 + h];
            const float a = SPp[(n0 + i) * 32 + 16 + d * 8 + h] + dt_bias[d * 8 + h];
            const float sp = a > 15.f ? a : __logf(1.f + __expf(a));
            float g = -__expf(a_log[d * 8 + h]) * sp;
#pragma unroll
            for (int o = 1; o < 64; o <<= 1) { const float t = d == 0 ? __shfl_up(g, o) : __shfl_down(g, o); if (d == 0 ? (i >= o) : (i + o < 64)) g += t; }
            GV[GV_BETA + d * 64 + i] = 1.f / (1.f + __expf(-bl)); GV[GV_GC + d * 64 + i] = g;
            if (d == 0 ? (i == 63) : (i == 0)) GV[GV_GL + d] = g;
        }
    }
    LDS_BARRIER();
    PSEC_END(1, lds, tid); }
    f32x4 sv[8];
    if (side_it >= 0) moe_item_load(p, 2, side_it * 8 + wave, lane, sv);
    { PSEC_BEGIN();
    {
        const int which = wave >> 2, rb = wave & 3, m = lane & 15, q = lane >> 4;
        const LAS bf16_t* Ab = (which ? QL : KL) + (16 * rb + m) * QLS + 8 * q;
        bf16x8 af[4];
#pragma unroll
        for (int s = 0; s < 4; ++s) af[s] = *(const LAS bf16x8*)(Ab + 32 * s);
#pragma unroll
        for (int cb = 0; cb < 4; ++cb) {
            f32x4 acc = {0.f, 0.f, 0.f, 0.f};
#pragma unroll
            for (int s = 0; s < 4; ++s) acc = MFMA16(af[s], *(const LAS bf16x8*)(KL + (16 * cb + m) * QLS + 8 * q + 32 * s), acc);
#pragma unroll
            for (int r = 0; r < 4; ++r) { const int i = 16 * rb + 4 * q + r, j = 16 * cb + m;
                if (which == 0) KK[i * FS + j] = acc[r]; else QKB[i * KTST + j] = (bf16_t)(cvtpk(acc[r], 0.f) & 0xffffu); }
        }
    }
    LDS_BARRIER();
    PSEC_END(2, lds, tid); }
    { PSEC_BEGIN();
#pragma unroll
    for (int it = 0; it < 4; ++it) { const int idx = tid + 512 * it, d = idx >> 10, i = (idx >> 4) & 63, ck = idx & 15;
        const float sc = __expf(GV[GV_GC + d * 64 + i]);
        const v4u x = *(const LAS v4u*)(QL + i * QLS + 8 * ck); v4u w;
        w.x = cvtpk(bfl(x.x) * sc, bfh(x.x) * sc); w.y = cvtpk(bfl(x.y) * sc, bfh(x.y) * sc); w.z = cvtpk(bfl(x.z) * sc, bfh(x.z) * sc); w.w = cvtpk(bfl(x.w) * sc, bfh(x.w) * sc);
        *(v4u*)(G + OFF_Q + (sl0 + d) * SZ_Q + ((size_t)i * 128 + 8 * ck) * 2) = w; }
#pragma unroll
    for (int it = 0; it < 2; ++it) { const int idx = tid + 512 * it, d = idx >> 9, i = (idx >> 3) & 63, ck = idx & 7;
        const float gi = GV[GV_GC + d * 64 + i];
        const v4u x = *(const LAS v4u*)(QKB + i * KTST + 8 * ck); const unsigned xs[4] = {x.x, x.y, x.z, x.w}; unsigned ws_[4];
#pragma unroll
        for (int e2 = 0; e2 < 4; ++e2) { const int j0 = 8 * ck + 2 * e2, j1 = j0 + 1;
            const bool k0 = d == 0 ? (j0 <= i) : (j0 >= i), k1 = d == 0 ? (j1 <= i) : (j1 >= i);
            const float v0 = k0 ? bfl(xs[e2]) * __expf(gi - GV[GV_GC + d * 64 + j0]) : 0.f, v1 = k1 ? bfh(xs[e2]) * __expf(gi - GV[GV_GC + d * 64 + j1]) : 0.f;
            ws_[e2] = cvtpk(v0, v1); }
        *(v4u*)(G + OFF_I + (sl0 + d) * SZ_I + ((size_t)i * 64 + 8 * ck) * 2) = (v4u){ws_[0], ws_[1], ws_[2], ws_[3]}; }
    LDS_BARRIER();
    PSEC_END(3, lds, tid); }
    { PSEC_BEGIN();
#pragma unroll
    for (int d = 0; d < 2; ++d) { LAS float* AT = (LAS float*)(lds + (d ? O_AT1 : O_AT0));
#pragma unroll
        for (int e = 0; e < 8; ++e) { const int idx = tid * 8 + e, it = idx >> 6, jt = idx & 63, ip = d ? 63 - it : it, jp = d ? 63 - jt : jt;
            float v = 0.f;
            if (jt < it) v = GV[GV_BETA + d * 64 + ip] * KK[ip * FS + jp] * __expf(GV[GV_GC + d * 64 + ip] - GV[GV_GC + d * 64 + jp]);
            AT[it * FS + jt] = v; } }
    LDS_BARRIER();
    PSEC_END(4, lds, tid); }
    { PSEC_BEGIN();
    {
        const int sd = wave < 4 ? (wave & 1) : 1 - (wave & 1), sw = wave < 4 ? (wave >> 1) : 3 - ((wave - 4) >> 1);
        LAS float* AT = (LAS float*)(lds + (sd ? O_AT1 : O_AT0)); LAS float* TT = (LAS float*)(lds + (sd ? O_TT1 : O_TT0));
        if (sw == 0) { const int g = lane >> 4, cc = lane & 15; const LAS float* ab = AT + (16 * g) * FS + 16 * g;
            float t[16];
#pragma unroll
            for (int r = 0; r < 16; ++r) { float acc = (r == cc) ? 1.f : 0.f;
#pragma unroll
                for (int j = 0; j < 16; ++j) if (j < r) acc -= ab[r * FS + j] * t[j];
                t[r] = acc; }
#pragma unroll
            for (int r = 0; r < 16; ++r) TT[(16 * g + r) * FS + 16 * g + cc] = t[r]; }
        LDS_BARRIER();
        if (sw < 3) { const int bi = sw + 1, bj = sw; f32x4 x = {0.f, 0.f, 0.f, 0.f};
            mm16f(x, AT + (16 * bi) * FS + 16 * bj, TT + (16 * bj) * FS + 16 * bj, lane);
            st16f(TT + (16 * bi) * FS + 16 * bj, x, lane, 1.f); LDS_WAIT();
            f32x4 y = {0.f, 0.f, 0.f, 0.f}; mm16f(y, TT + (16 * bi) * FS + 16 * bi, TT + (16 * bi) * FS + 16 * bj, lane);
            st16f(TT + (16 * bi) * FS + 16 * bj, y, lane, -1.f); }
        LDS_BARRIER();
        if (sw < 2) { const int bi = sw + 2, bj = sw; f32x4 x = {0.f, 0.f, 0.f, 0.f};
            mm16f(x, AT + (16 * bi) * FS + 16 * bj, TT + (16 * bj) * FS + 16 * bj, lane);
            mm16f(x, AT + (16 * bi) * FS + 16 * (bj + 1), TT + (16 * (bj + 1)) * FS + 16 * bj, lane);
            st16f(TT + (16 * bi) * FS + 16 * bj, x, lane, 1.f); LDS_WAIT();
            f32x4 y = {0.f, 0.f, 0.f, 0.f}; mm16f(y, TT + (16 * bi) * FS + 16 * bi, TT + (16 * bi) * FS + 16 * bj, lane);
            st16f(TT + (16 * bi) * FS + 16 * bj, y, lane, -1.f); }
        LDS_BARRIER();
        if (sw == 0) { f32x4 x = {0.f, 0.f, 0.f, 0.f};
            mm16f(x, AT + 48 * FS + 0, TT + 0, lane); mm16f(x, AT + 48 * FS + 16, TT + 16 * FS, lane); mm16f(x, AT + 48 * FS + 32, TT + 32 * FS, lane);
            st16f(TT + 48 * FS, x, lane, 1.f); LDS_WAIT();
            f32x4 y = {0.f, 0.f, 0.f, 0.f}; mm16f(y, TT + 48 * FS + 48, TT + 48 * FS, lane);
            st16f(TT + 48 * FS, y, lane, -1.f); }
        LDS_BARRIER();
    }
    PSEC_END(5, lds, tid); }
    for (int d = 0; d < 2; ++d) {
        const float gl = GV[GV_GL + d];
        const LAS float* TT = (const LAS float*)(lds + (d ? O_TT1 : O_TT0));
        { PSEC_BEGIN();
#pragma unroll
        for (int e = 0; e < 8; e += 2) { const int idx = tid * 8 + e, i = idx >> 6, j = idx & 63;
            const int ti = d ? 63 - i : i, tj0 = d ? 63 - j : j, tj1 = d ? 62 - j : j + 1;
            const float t0 = tj0 <= ti ? TT[ti * FS + tj0] : 0.f, t1 = tj1 <= ti ? TT[ti * FS + tj1] : 0.f;
            const float b0 = GV[GV_BETA + d * 64 + j], b1 = GV[GV_BETA + d * 64 + j + 1];
            const float e0 = __expf(GV[GV_GC + d * 64 + j]), e1 = __expf(GV[GV_GC + d * 64 + j + 1]);
            *(LAS unsigned*)(TB + i * KTST + j) = cvtpk(t0 * b0, t1 * b1); *(LAS unsigned*)(TG + i * KTST + j) = cvtpk(t0 * b0 * e0, t1 * b1 * e1); }
#pragma unroll
        for (int it = 0; it < 2; ++it) { const int idx = tid + 512 * it, a = idx >> 3, ck = idx & 7;
            const v4u x = *(const LAS v4u*)(KT + a * KTST + 8 * ck); const unsigned xs[4] = {x.x, x.y, x.z, x.w}; unsigned w4[4];
#pragma unroll
            for (int e2 = 0; e2 < 4; ++e2) { const int i0 = 8 * ck + 2 * e2; w4[e2] = cvtpk(bfl(xs[e2]) * __expf(gl - GV[GV_GC + d * 64 + i0]), bfh(xs[e2]) * __expf(gl - GV[GV_GC + d * 64 + i0 + 1])); }
            *(LAS v4u*)(KTS + a * KTST + 8 * ck) = (v4u){w4[0], w4[1], w4[2], w4[3]}; }
        LDS_BARRIER();
        PSEC_END(6, lds, tid); }
        { PSEC_BEGIN();
        {
            const int w = wave, m = lane & 15, q = lane >> 4;
            const size_t sl = sl0 + d;
            bf16x8 bv[2], bk[2];
#pragma unroll
            for (int s = 0; s < 2; ++s) { bv[s] = *(const LAS bf16x8*)(VT + (16 * w + m) * KTST + 32 * s + 8 * q); bk[s] = *(const LAS bf16x8*)(KT + (16 * w + m) * KTST + 32 * s + 8 * q); }
#pragma unroll
            for (int rb = 0; rb < 4; ++rb) { f32x4 U = {0.f, 0.f, 0.f, 0.f}, wt = {0.f, 0.f, 0.f, 0.f};
#pragma unroll
                for (int s = 0; s < 2; ++s) { U = MFMA16(*(const LAS bf16x8*)(TB + (16 * rb + m) * KTST + 32 * s + 8 * q), bv[s], U);
                    wt = MFMA16(bk[s], *(const LAS bf16x8*)(TG + (16 * rb + m) * KTST + 32 * s + 8 * q), wt); }
                *(unsigned long long*)(G + OFF_U + sl * SZ_U + ((size_t)(16 * w + m) * 64 + 16 * rb + 4 * q) * 2) = pack4(U);
                *(unsigned long long*)(G + OFF_W + sl * SZ_W + ((size_t)(16 * rb + m) * 128 + 16 * w + 4 * q) * 2) = pack4(wt);
            }
#pragma unroll
            for (int it = 0; it < 2; ++it) { const int idx = tid + 512 * it, a_ = idx >> 3, ck = idx & 7;
                *(v4u*)(G + OFF_KT + sl * SZ_KT + ((size_t)a_ * 64 + 8 * ck) * 2) = *(const LAS v4u*)(KTS + a_ * KTST + 8 * ck); }
            if (tid == 0) *(float*)(G + OFF_EG + sl * 4) = __expf(gl);
        }
        LDS_BARRIER();
        PSEC_END(7, lds, tid); }
    }
    if (side_it >= 0) moe_item_store(p, 2, side_it * 8 + wave, lane, sv);
}

constexpr int G4_SLOT = 57344;
__device__ __forceinline__ bf16x8 ldperm_sw256(const LAS unsigned char* base, int row, int s, int q) {
    const int c0 = 4 * s + (q >> 1), half = (q & 1) * 8;
    const bf16x4 a = *(const LAS bf16x4*)(base + row * 256 + ((c0 ^ (row & 15)) << 4) + half), b = *(const LAS bf16x4*)(base + row * 256 + (((c0 + 2) ^ (row & 15)) << 4) + half);
    return (bf16x8){a[0], a[1], a[2], a[3], b[0], b[1], b[2], b[3]};
}
__device__ __forceinline__ bf16x8 ldperm_sw128(const LAS unsigned char* base, int row, int s, int q) {
    const int c0 = 4 * s + (q >> 1), half = (q & 1) * 8, f = (row >> 1) & 7;
    const bf16x4 a = *(const LAS bf16x4*)(base + row * 128 + ((c0 ^ f) << 4) + half), b = *(const LAS bf16x4*)(base + row * 128 + (((c0 + 2) ^ f) << 4) + half);
    return (bf16x8){a[0], a[1], a[2], a[3], b[0], b[1], b[2], b[3]};
}
__device__ __forceinline__ void g4_block(const Params& p, int ch, int half_, LAS unsigned char* lds, int tid, int unit, bool side) {
    unsigned char* G = p.ws + ws::GDNS;
    const int lane = tid & 63, wave = __builtin_amdgcn_readfirstlane(tid >> 6);
    const int b = ch >> 4, h = (ch >> 1) & 7, d = ch & 1, m = lane & 15, q = lane >> 4;
    const bool loader = wave >= 4;
    const int cb = half_ * 4 + (wave & 3);
    f32x4 S[8];
#pragma unroll
    for (int ab = 0; ab < 8; ++ab) S[ab] = (f32x4){0.f, 0.f, 0.f, 0.f};
    auto slot_of = [&](int step) -> size_t { const int c = d == 0 ? step : (step < 4 ? 3 - step : 39 - step); return (((size_t)b * 36 + c) * 8 + h) * 2 + d; };
    auto issue = [&](int step, int slot, bool warm) {
        const size_t sl = slot_of(step); const int lw = wave - 4;
        int ln = lane; asm volatile("" : "+v"(ln));
#pragma unroll
        for (int r = 0; r < 16; ++r) {
            const int t = (r & 3) * 256 + lw * 64 + ln;
            const unsigned char* src;
            if (r < 8) { const int row = t >> 4, cc = (t & 15) ^ (row & 15); src = G + (r < 4 ? OFF_W + sl * SZ_W : OFF_Q + sl * SZ_Q) + (size_t)row * 256 + cc * 16; }
            else if (r < 14) { const int row = t >> 3, cc = (t & 7) ^ ((row >> 1) & 7); src = G + (r < 12 ? OFF_KT + sl * SZ_KT : OFF_I + sl * SZ_I) + (size_t)row * 128 + cc * 16; }
            else { const int t2 = (r - 14) * 256 + lw * 64 + ln, row = t2 >> 3, cc = (t2 & 7) ^ ((row >> 1) & 7); src = G + OFF_U + sl * SZ_U + (size_t)(64 * half_ + row) * 128 + cc * 16; }
            const int ldsoff = r < 14 ? slot * G4_SLOT + (r < 4 ? 0 : r < 8 ? 16384 : r < 12 ? 32768 : 49152) + ((r & 3) * 256 + lw * 64) * 16 : 2 * G4_SLOT + slot * 8192 + ((r - 14) * 256 + lw * 64) * 16;
            __builtin_amdgcn_global_load_lds((const unsigned*)src, (LAS unsigned*)(lds + ldsoff), 16, 0, 0);
        }
    };
    int oA[4], oB[4], pA[2], pB[2], uo[4];
    { const int m_ = lane & 15, q_ = lane >> 4, qh = q_ >> 1, hf = (q_ & 1) * 8, f_ = (m_ >> 1) & 7;
#pragma unroll
      for (int rb = 0; rb < 4; ++rb) uo[rb] = (16 * (wave & 3) + m_) * 128 + hf + (((2 * rb + qh) ^ f_) << 4);
#pragma unroll
      for (int s = 0; s < 4; ++s) { oA[s] = m_ * 256 + hf + (((4 * s + qh) ^ m_) << 4); oB[s] = m_ * 256 + hf + (((4 * s + qh + 2) ^ m_) << 4); }
#pragma unroll
      for (int s = 0; s < 2; ++s) { pA[s] = m_ * 128 + hf + (((4 * s + qh) ^ f_) << 4); pB[s] = m_ * 128 + hf + (((4 * s + qh + 2) ^ f_) << 4); } }
    auto ld2 = [&](const LAS unsigned char* base, int offa, int offb) -> bf16x8 { const bf16x4 a = *(const LAS bf16x4*)(base + offa), b = *(const LAS bf16x4*)(base + offb); return (bf16x8){a[0], a[1], a[2], a[3], b[0], b[1], b[2], b[3]}; };
    f32x4 sva[8];
#pragma unroll
    for (int j = 0; j < 8; ++j) sva[j] = (f32x4){0.f, 0.f, 0.f, 0.f};
    LAS float* eglds = (LAS float*)(lds + LDS_MISC + 1664);
    auto fetch_egl = [&](int step, int slot) { if (wave == 4 && lane == 0) eglds[slot] = *(const float*)(G + OFF_EG + slot_of(step) * 4); };
    __syncthreads();
    if (loader) { issue(0, 0, false); fetch_egl(0, 0); if (side) moe_item_load(p, 3, unit * 4 + (wave - 4), lane, sva); asm volatile("s_waitcnt vmcnt(0)" ::: "memory"); }
    __syncthreads();
    for (int step = 0; step < 36; ++step) {
        const int slot = step & 1;
        if (loader) {
            PSEC_BEGIN();
            const int glw = unit * 4 + (wave - 4);
            float egl_n = 0.f;
            if (step + 1 < 36) { issue(step + 1, slot ^ 1, false); if (wave == 4 && lane == 0) egl_n = *(const float*)(G + OFF_EG + slot_of(step + 1) * 4); }
            asm volatile("s_waitcnt vmcnt(0)" ::: "memory");
            PSEC_END(9, lds, tid - 256);
            if (step + 1 < 36 && wave == 4 && lane == 0) eglds[slot ^ 1] = egl_n;
            if (side) { moe_item_store(p, 3, glw + 1024 * step, lane, sva); if (step + 1 < 36) moe_item_load(p, 3, glw + 1024 * (step + 1), lane, sva); }
            asm volatile("s_waitcnt lgkmcnt(0)" ::: "memory");
            PSEC_END(10, lds, tid - 256);
        }
        else {
            PSEC_BEGIN();
            const int m = lane & 15, q = lane >> 4;
            const size_t sl = slot_of(step);
            const LAS unsigned char* LW = lds + slot * G4_SLOT; const LAS unsigned char* LQ = LW + 16384; const LAS unsigned char* LK = LW + 32768; const LAS unsigned char* LI = LW + 49152;
            const LAS unsigned char* LU = lds + 2 * G4_SLOT + slot * 8192;
            uint2 uv[4];
#pragma unroll
            for (int rb = 0; rb < 4; ++rb) { const unsigned long long t_ = *(const LAS unsigned long long*)(LU + uo[rb]); uv[rb].x = (unsigned)t_; uv[rb].y = (unsigned)(t_ >> 32); }
            const float egl = eglds[slot];
#define G4_SCHED() __builtin_amdgcn_sched_barrier(0)
            bf16x8 fw[2][4], fq[2][4], fi[8], fk[2][8];
#pragma unroll
            for (int s = 0; s < 4; ++s) { fw[0][s] = ld2(LW, oA[s], oB[s]); fq[0][s] = ld2(LQ, oA[s], oB[s]); }
            bf16x8 PS[4];
#pragma unroll
            for (int s = 0; s < 4; ++s) PS[s] = pack8(S[2 * s], S[2 * s + 1]);
            f32x4 o[4], vn[4];
#pragma unroll
            for (int rb = 0; rb < 4; ++rb) { const int cur = rb & 1, nxt = cur ^ 1;
                if (rb < 3) {
#pragma unroll
                    for (int s = 0; s < 4; ++s) { fw[nxt][s] = ld2(LW + (rb + 1) * 4096, oA[s], oB[s]); fq[nxt][s] = ld2(LQ + (rb + 1) * 4096, oA[s], oB[s]); } }
                else {
#pragma unroll
                    for (int r2 = 0; r2 < 4; ++r2)
#pragma unroll
                        for (int s = 0; s < 2; ++s) fi[2 * r2 + s] = ld2(LI + r2 * 2048, pA[s], pB[s]); }
                G4_SCHED();
                f32x4 t1 = {0.f, 0.f, 0.f, 0.f}; o[rb] = (f32x4){0.f, 0.f, 0.f, 0.f};
#pragma unroll
                for (int s = 0; s < 4; ++s) { t1 = MFMA16(fw[cur][s], PS[s], t1); o[rb] = MFMA16(fq[cur][s], PS[s], o[rb]); }
                vn[rb] = (f32x4){bfl(uv[rb].x) - t1[0], bfh(uv[rb].x) - t1[1], bfl(uv[rb].y) - t1[2], bfh(uv[rb].y) - t1[3]};
                G4_SCHED(); }
#pragma unroll
            for (int ab = 0; ab < 4; ++ab)
#pragma unroll
                for (int s = 0; s < 2; ++s) fk[0][2 * ab + s] = ld2(LK + ab * 2048, pA[s], pB[s]);
            bf16x8 PV[2];
#pragma unroll
            for (int s = 0; s < 2; ++s) PV[s] = pack8(vn[2 * s], vn[2 * s + 1]);
            G4_SCHED();
#pragma unroll
            for (int rb = 0; rb < 4; ++rb) {
#pragma unroll
                for (int s = 0; s < 2; ++s) o[rb] = MFMA16(fi[2 * rb + s], PV[s], o[rb]);
                *(unsigned long long*)(G + OFF_O + sl * SZ_O + ((size_t)(16 * cb + m) * 64 + 16 * rb + 4 * q) * 2) = pack4(o[rb]); }
#pragma unroll
            for (int ab = 0; ab < 4; ++ab)
#pragma unroll
                for (int s = 0; s < 2; ++s) fk[1][2 * ab + s] = ld2(LK + (4 + ab) * 2048, pA[s], pB[s]);
            G4_SCHED();
#pragma unroll
            for (int ab = 0; ab < 4; ++ab) { S[ab] = S[ab] * egl;
#pragma unroll
                for (int s = 0; s < 2; ++s) S[ab] = MFMA16(fk[0][2 * ab + s], PV[s], S[ab]); }
            G4_SCHED();
#pragma unroll
            for (int ab = 0; ab < 4; ++ab) { S[4 + ab] = S[4 + ab] * egl;
#pragma unroll
                for (int s = 0; s < 2; ++s) S[4 + ab] = MFMA16(fk[1][2 * ab + s], PV[s], S[4 + ab]); }
#undef G4_SCHED
            asm volatile("s_waitcnt lgkmcnt(0)" ::: "memory");
            PSEC_END(8, lds, tid);
        }
        asm volatile("" ::: "memory"); __builtin_amdgcn_s_barrier(); asm volatile("" ::: "memory");
    }
    asm volatile("s_waitcnt vmcnt(0)" ::: "memory");
    __syncthreads();
}

__device__ __forceinline__ void g5_item(const Params& p, int b, int c, int h, LAS unsigned char* lds, int tid) {
    unsigned char* G = p.ws + ws::GDNS;
    const bf16_t* PBp = (const bf16_t*)(p.ws + ws::PB); bf16_t* Op = (bf16_t*)(p.ws + ws::OBF);
    const float* g_out = p.in[21];
    LAS float* Tt = (LAS float*)lds;
    const size_t n0 = (size_t)b * T + 64 * c;
    const size_t sl0 = (((size_t)b * 36 + c) * 8 + h) * 2;
    LDS_BARRIER();
#pragma unroll
    for (int it = 0; it < 2; ++it) { const int idx = tid + 512 * it, dv = idx >> 3, ck = idx & 7;
        const v4u a = *(const v4u*)(G + OFF_O + sl0 * SZ_O + ((size_t)dv * 64 + 8 * ck) * 2), bb = *(const v4u*)(G + OFF_O + (sl0 + 1) * SZ_O + ((size_t)dv * 64 + 8 * ck) * 2);
        const unsigned as[4] = {a.x, a.y, a.z, a.w}, bs[4] = {bb.x, bb.y, bb.z, bb.w};
#pragma unroll
        for (int e2 = 0; e2 < 4; ++e2) { Tt[dv * 65 + 8 * ck + 2 * e2] = bfl(as[e2]) + bfl(bs[e2]); Tt[dv * 65 + 8 * ck + 2 * e2 + 1] = bfh(as[e2]) + bfh(bs[e2]); } }
    LDS_BARRIER();
    { const int i = tid >> 3, dc = tid & 7;
        float o[16]; float ss = 0.f;
#pragma unroll
        for (int e = 0; e < 16; ++e) { o[e] = Tt[(16 * dc + e) * 65 + i]; ss += o[e] * o[e]; }
        ss += __shfl_xor(ss, 1); ss += __shfl_xor(ss, 2); ss += __shfl_xor(ss, 4);
        const float rs = rsqrtf(ss * (1.f / 128.f) + EPS);
        const bf16_t* zp = PBp + (n0 + i) * 4096 + 3072 + h * 128 + 16 * dc;
        const v4u z0 = *(const v4u*)zp, z1 = *(const v4u*)(zp + 8); const unsigned zs[8] = {z0.x, z0.y, z0.z, z0.w, z1.x, z1.y, z1.z, z1.w};
        unsigned w8[8];
#pragma unroll
        for (int e2 = 0; e2 < 8; ++e2) { const float za = bfl(zs[e2]), zb = bfh(zs[e2]);
            const float va = o[2 * e2] * rs * g_out[16 * dc + 2 * e2] * (za * __builtin_amdgcn_rcpf(1.f + __expf(-za)));
            const float vb = o[2 * e2 + 1] * rs * g_out[16 * dc + 2 * e2 + 1] * (zb * __builtin_amdgcn_rcpf(1.f + __expf(-zb)));
            w8[e2] = cvtpk(va, vb); }
        bf16_t* op = Op + (n0 + i) * 1024 + h * 128 + 16 * dc;
        *(v4u*)op = (v4u){w8[0], w8[1], w8[2], w8[3]}; *(v4u*)(op + 8) = (v4u){w8[4], w8[5], w8[6], w8[7]}; }
}
}

__device__ __forceinline__ void gdn_g3_phase(const Params& p, LAS unsigned char* lds, int bid, int nb) {
    for (int it = bid; it < NB * 36 * 8; it += nb) { const int h = it & 7, bc = it >> 3; gdn::g3_item(p, bc / 36, bc % 36, h, lds, it); }
}
__device__ __forceinline__ void gdn_g4_phase(const Params& p, LAS unsigned char* lds, int bid, int nb) {
    const int tid = otid();
    for (int u = bid; u < 256; u += nb) gdn::g4_block(p, (u >> 4) * 8 + (u & 7), (u >> 3) & 1, lds, tid, u, true);
}
__device__ __forceinline__ void gdn_g5_phase(const Params& p, LAS unsigned char* lds, int bid, int nb) {
    for (int it = bid; it < NB * 36 * 8; it += nb) { const int h = it & 7, bc = it >> 3; gdn::g5_item(p, bc / 36, bc % 36, h, lds, otid()); }
}

__device__ __forceinline__ float wave_sum(float v) {
#pragma unroll
    for (int o = 1; o < 64; o <<= 1) v += __shfl_xor(v, o);
    return v;
}
__device__ __forceinline__ void ld16f(const float* src, int lane, float (&x)[16]) {
#pragma unroll
    for (int hf = 0; hf < 2; ++hf) { const f32x4 a = *(const f32x4*)(src + 512 * hf + 8 * lane), b = *(const f32x4*)(src + 512 * hf + 8 * lane + 4);
        x[8 * hf + 0] = a[0]; x[8 * hf + 1] = a[1]; x[8 * hf + 2] = a[2]; x[8 * hf + 3] = a[3]; x[8 * hf + 4] = b[0]; x[8 * hf + 5] = b[1]; x[8 * hf + 6] = b[2]; x[8 * hf + 7] = b[3]; }
}
__device__ __forceinline__ void ld16b(const bf16_t* src, int lane, float (&x)[16]) {
#pragma unroll
    for (int hf = 0; hf < 2; ++hf) { const v4u y = *(const v4u*)(src + 512 * hf + 8 * lane);
        x[8 * hf + 0] = bf2f(y.x & 0xffffu); x[8 * hf + 1] = bf2f(y.x >> 16); x[8 * hf + 2] = bf2f(y.y & 0xffffu); x[8 * hf + 3] = bf2f(y.y >> 16);
        x[8 * hf + 4] = bf2f(y.z & 0xffffu); x[8 * hf + 5] = bf2f(y.z >> 16); x[8 * hf + 6] = bf2f(y.w & 0xffffu); x[8 * hf + 7] = bf2f(y.w >> 16); }
}
__device__ __forceinline__ void st16f(float* dst, int lane, const float (&x)[16]) {
#pragma unroll
    for (int hf = 0; hf < 2; ++hf) { *(f32x4*)(dst + 512 * hf + 8 * lane) = (f32x4){x[8 * hf], x[8 * hf + 1], x[8 * hf + 2], x[8 * hf + 3]}; *(f32x4*)(dst + 512 * hf + 8 * lane + 4) = (f32x4){x[8 * hf + 4], x[8 * hf + 5], x[8 * hf + 6], x[8 * hf + 7]}; }
}
__device__ __forceinline__ void st16b(bf16_t* dst, int lane, const float (&x)[16]) {
#pragma unroll
    for (int hf = 0; hf < 2; ++hf) { v4u w; w.x = pk2(x[8 * hf], x[8 * hf + 1]); w.y = pk2(x[8 * hf + 2], x[8 * hf + 3]); w.z = pk2(x[8 * hf + 4], x[8 * hf + 5]); w.w = pk2(x[8 * hf + 6], x[8 * hf + 7]); *(v4u*)(dst + 512 * hf + 8 * lane) = w; }
}
__device__ __forceinline__ int swz32(int k, int c) { return ((k ^ ((k >> 6) & 1)) << 5) + ((c ^ ((k >> 3) & 7)) << 2); }
__device__ __forceinline__ void stage_w32(const float* W, int ldw, LAS float* sw) {
    for (int i = otid(); i < 1024 * 8; i += NTHR) { const int k = i >> 3, c = i & 7; const f32x4 v = *(const f32x4*)(W + (size_t)k * ldw + 4 * c); *(LAS f32x4*)(sw + swz32(k, c)) = v; }
}
__device__ __forceinline__ void dot32x2(const float (&h0)[16], const float (&h1)[16], const LAS float* sw, int lane, float (&p0)[32], float (&p1)[32]) {
#pragma unroll
    for (int e = 0; e < 32; ++e) { p0[e] = 0.f; p1[e] = 0.f; }
#pragma unroll
    for (int j = 0; j < 16; ++j) { const int k = (j >> 3) * 512 + 8 * lane + (j & 7);
#pragma unroll
        for (int c = 0; c < 8; ++c) { const f32x4 w = *(const LAS f32x4*)(sw + swz32(k, c));
#pragma unroll
            for (int e = 0; e < 4; ++e) { p0[4 * c + e] += h0[j] * w[e]; p1[4 * c + e] += h1[j] * w[e]; } } }
}
__device__ __forceinline__ float reduce32(float (&p)[32], int lane) {
#pragma unroll
    for (int e = 0; e < 16; ++e) { const bool up = (lane & 32) != 0; const float send = up ? p[e] : p[e + 16]; const float keep = up ? p[e + 16] : p[e]; p[e] = keep + __shfl_xor(send, 32); }
#pragma unroll
    for (int e = 0; e < 8; ++e) { const bool up = (lane & 16) != 0; const float send = up ? p[e] : p[e + 8]; const float keep = up ? p[e + 8] : p[e]; p[e] = keep + __shfl_xor(send, 16); }
#pragma unroll
    for (int e = 0; e < 4; ++e) { const bool up = (lane & 8) != 0; const float send = up ? p[e] : p[e + 4]; const float keep = up ? p[e + 4] : p[e]; p[e] = keep + __shfl_xor(send, 8); }
#pragma unroll
    for (int e = 0; e < 2; ++e) { const bool up = (lane & 4) != 0; const float send = up ? p[e] : p[e + 2]; const float keep = up ? p[e + 2] : p[e]; p[e] = keep + __shfl_xor(send, 4); }
    { const bool up = (lane & 2) != 0; const float send = up ? p[0] : p[1]; const float keep = up ? p[1] : p[0]; p[0] = keep + __shfl_xor(send, 2); }
    return p[0] + __shfl_xor(p[0], 1);
}
__device__ __forceinline__ void load_row(const Params& p, int layer, int n, int lane, bool combine, float (&x)[16], const LAS int* tab = nullptr) {
    const int b = n / T, pp = n % T;
    if (layer == 0) ld16f(pp < C ? p.in[2] + ((size_t)b * C + pp) * D : p.in[0] + ((size_t)b * L + (pp - C)) * D, lane, x);
    else ld16b((const bf16_t*)(p.ws + ws::X) + (size_t)n * D, lane, x);
    if (combine) {
        const bf16_t* Y = (const bf16_t*)(p.ws + ws::YSB);
        const int* posi = (const int*)(p.ws + ws::POSI) + (size_t)n * 4; const float* gate = (const float*)(p.ws + ws::GATE) + (size_t)n * 4;
        float gt[16]; ld16f((const float*)(p.ws + ws::MODS) + ((size_t)(layer - 1) * 9 + (pp < C ? 8 : b)) * 6144 + 5 * 1024, lane, gt);
        float s[16];
#pragma unroll
        for (int j = 0; j < 16; ++j) s[j] = 0.f;
#pragma unroll
        for (int k = 0; k < 4; ++k) { const int inf = posi[k]; const float gk = gate[k];
            const bf16_t* ys = Y + (size_t)(tab[TAB_OFFP + (inf >> 20)] + (inf & 0xfffff)) * D;
#pragma unroll
            for (int hf = 0; hf < 2; ++hf) { const v4u y = *(const v4u*)(ys + 512 * hf + 8 * lane);
                s[8 * hf + 0] += gk * bf2f(y.x & 0xffffu); s[8 * hf + 1] += gk * bf2f(y.x >> 16); s[8 * hf + 2] += gk * bf2f(y.y & 0xffffu); s[8 * hf + 3] += gk * bf2f(y.y >> 16);
                s[8 * hf + 4] += gk * bf2f(y.z & 0xffffu); s[8 * hf + 5] += gk * bf2f(y.z >> 16); s[8 * hf + 6] += gk * bf2f(y.w & 0xffffu); s[8 * hf + 7] += gk * bf2f(y.w >> 16); } }
#pragma unroll
        for (int j = 0; j < 16; ++j) x[j] += gt[j] * s[j];
    }
}
__device__ __forceinline__ void normmod_row(const Params& p, int layer, int n, int lane, const float* g, int sh_chunk, const float (&x)[16], float (&h)[16]) {
    float ss = 0.f;
#pragma unroll
    for (int j = 0; j < 16; ++j) ss += x[j] * x[j];
    const float rs = rsqrtf(wave_sum(ss) * (1.f / D) + EPS);
    const int b = n / T, pp = n % T;
    const float* md = (const float*)(p.ws + ws::MODS) + ((size_t)layer * 9 + (pp < C ? 8 : b)) * 6144 + sh_chunk * 1024;
    float gg[16], sh[16], sc[16]; ld16f(g, lane, gg); ld16f(md, lane, sh); ld16f(md + 1024, lane, sc);
#pragma unroll
    for (int j = 0; j < 16; ++j) h[j] = x[j] * rs * gg[j] * (1.f + sc[j]) + sh[j];
}
__device__ __forceinline__ void phaseA(const Params& p, int layer, LAS unsigned char* lds, int bid, int nb) {
    const int tid = otid(), lane = tid & 63, wave = __builtin_amdgcn_readfirstlane(tid >> 6);
    LAS float* sw = (LAS float*)lds;
    LAS int* tab = (LAS int*)(lds + LDS_MISC);
    const bool gdnl = layer == 2;
    if (layer > 0) moe_tables((const int*)(p.ws + ws::CTL) + ws::CW_CNT + (layer - 1) * 32, tab); else __syncthreads();
    if (gdnl) { stage_w32(p.in[17] + 4096, GIN, sw); __syncthreads(); }
    bf16_t* X = (bf16_t*)(p.ws + ws::X); bf16_t* HB = (bf16_t*)(p.ws + ws::HB); float* SPp = (float*)(p.ws + ws::SP);
    const float* g = p.in[6] + layer * D;
    if (bid < 9) {
        const float* md2 = (const float*)(p.ws + ws::MODS) + ((size_t)layer * 9 + bid) * 6144 + 3 * 1024; float* ab = (float*)(p.ws + ws::MODAB) + ((size_t)layer * 9 + bid) * 2048;
        for (int k = tid; k < 1024; k += NTHR) { ab[k] = p.in[7][layer * D + k] * (1.f + md2[1024 + k]); ab[1024 + k] = md2[k]; } }
    for (int pr = bid * 8 + wave; pr < NTOK / 2; pr += nb * 8) {
        const int n0 = 2 * pr, n1 = n0 + 1;
        float x0[16], x1[16], h0[16], h1[16];
        load_row(p, layer, n0, lane, layer > 0, x0, tab); load_row(p, layer, n1, lane, layer > 0, x1, tab);
        st16b(X + (size_t)n0 * D, lane, x0); st16b(X + (size_t)n1 * D, lane, x1);
        normmod_row(p, layer, n0, lane, g, 0, x0, h0); normmod_row(p, layer, n1, lane, g, 0, x1, h1);
        st16b(HB + (size_t)n0 * D, lane, h0); st16b(HB + (size_t)n1 * D, lane, h1);
        if (gdnl) { float p0[32], p1[32]; dot32x2(h0, h1, sw, lane, p0, p1); const float r0 = reduce32(p0, lane), r1 = reduce32(p1, lane);
            if ((lane & 1) == 0) { SPp[(size_t)n0 * 32 + (lane >> 1)] = r0; SPp[(size_t)n1 * 32 + (lane >> 1)] = r1; } }
    }
}
__device__ __forceinline__ void top4(float v, int lane, int (&idx)[4], float (&val)[4]) {
    const int e = lane >> 1;
#pragma unroll
    for (int k = 0; k < 4; ++k) {
        float bv = v; int bi = e;
#pragma unroll
        for (int o = 2; o < 64; o <<= 1) { const float ov = __shfl_xor(bv, o); const int oi = __shfl_xor(bi, o); if (ov > bv || (ov == bv && oi < bi)) { bv = ov; bi = oi; } }
        idx[k] = bi; val[k] = bv;
        if (e == bi) v = -INFINITY;
    }
}
constexpr int E_BCNT = LDS_MISC + 2048, E_BASE = LDS_MISC + 2176, E_INFO = LDS_MISC + 2304, E_MAXTOK = 512, E_TOKN = E_INFO + E_MAXTOK * 16;
constexpr int CW_CTXC = 8192;
typedef short e_bf16x8 __attribute__((ext_vector_type(8)));
__device__ __forceinline__ unsigned e_cvtpk(float lo, float hi) { typedef float f2 __attribute__((ext_vector_type(2))); typedef __bf16 b2 __attribute__((ext_vector_type(2))); f2 v = {lo, hi}; b2 b = __builtin_convertvector(v, b2); return __builtin_bit_cast(unsigned, b); }
__device__ __forceinline__ void phaseE(const Params& p, int layer, LAS unsigned char* lds, int bid, int nb) {
    const int tid = otid(), lane = tid & 63, wave = __builtin_amdgcn_readfirstlane(tid >> 6), m = lane & 15, q = lane >> 4;
    LAS int* bcnt = (LAS int*)(lds + E_BCNT); LAS int* base = (LAS int*)(lds + E_BASE); LAS int* info = (LAS int*)(lds + E_INFO);
    const bool ctxmode = layer < 3 && nb == 256;
    const bool special = ctxmode && bid < 64;
    if (special) {
        oproj_ctx_unit(p, layer, lds, bid >> 3, bid & 3, (bid >> 2) & 1);
        unsigned* ctr = (unsigned*)(p.ws + ws::CTL) + CW_CTXC + (layer * 8 + (bid >> 3)) * 64;
        asm volatile("s_waitcnt vmcnt(0)" ::: "memory");
        __syncthreads();
        if (tid == 0) {
            __builtin_amdgcn_fence(__ATOMIC_RELEASE, "agent"); asm volatile("s_waitcnt vmcnt(0)" ::: "memory");
            __hip_atomic_fetch_add(ctr, 1u, __ATOMIC_RELAXED, __HIP_MEMORY_SCOPE_AGENT);
        }
    }
    __syncthreads();
    {
        const v4u* src = (const v4u*)(p.ws + ws::WT_RT + (size_t)layer * 2 * 32 * 1024 * 2);
        for (int i = tid; i < 8192; i += NTHR) { const int row = i >> 7, ck = i & 127; *(LAS v4u*)(lds + row * 2048 + ((ck ^ (row & 15)) << 4)) = src[i]; }
    }
    if (tid < 32) bcnt[tid] = 0;
    for (int i = tid; i < E_MAXTOK * 4; i += NTHR) info[i] = -1;
    LAS int* tokn = (LAS int*)(lds + E_TOKN);
    __syncthreads();
    const float* g = p.in[7] + layer * D; const float* br = p.in[24] + layer * NE;
    int* cnt = (int*)(p.ws + ws::CTL) + ws::CW_CNT + layer * 32; int* posi = (int*)(p.ws + ws::POSI); float* gate = (float*)(p.ws + ws::GATE); int* list = (int*)(p.ws + ws::LIST);
    const bf16_t* X = (const bf16_t*)(p.ws + ws::X); bf16_t* HB = (bf16_t*)(p.ws + ws::HB);
    const bool skip_ctx = layer == 3;
    const float bias0 = br[m], bias1 = br[16 + m];
    int it = 0;
    int li0 = 0, lstep = 1, lend = 0;
    if (!ctxmode) { li0 = bid + wave * nb; lstep = 8 * nb; lend = NTOK / 16; }
    else if (!special && wave < 6) { li0 = (bid - 64) + wave * 192; lstep = 1 << 20; lend = 1024; }
    else if (special) { li0 = 1024 + 16 * (bid >> 3) + 2 * (bid & 7) + (wave >> 2); lstep = 1 << 20; lend = 1152; }
    const bool ksplit = special; const int kq = wave & 3;
    LAS float* ssp = (LAS float*)(lds + LDS_MISC);
    for (int li = li0; li < lend; li += lstep, ++it) {
        int gi = li;
        if (ctxmode) {
            if (li >= 1024) { const int cg = li - 1024, cb = cg >> 4; gi = 144 * cb + (cg & 15);
                unsigned* ctr = (unsigned*)(p.ws + ws::CTL) + CW_CTXC + (layer * 8 + cb) * 64;
                unsigned sp = 0; while ((unsigned)__builtin_amdgcn_readfirstlane(__hip_atomic_load(ctr, __ATOMIC_RELAXED, __HIP_MEMORY_SCOPE_AGENT)) < 8u) { __builtin_amdgcn_s_sleep(2); if (++sp > (1u << 22)) break; }
                __builtin_amdgcn_fence(__ATOMIC_ACQUIRE, "agent"); asm volatile("s_waitcnt vmcnt(0)" ::: "memory"); }
            else gi = (li >> 7) * 144 + 16 + (li & 127);
        }
        const int nbase = 16 * gi, pp0 = nbase % T, bb = nbase / T;
        if (skip_ctx && pp0 < C) continue;
        const int n = nbase + m;
        const bf16_t* xr = X + (size_t)n * D + 8 * q;
        const float* ab = (const float*)(p.ws + ws::MODAB) + ((size_t)layer * 9 + (pp0 < C ? 8 : bb)) * 2048 + 8 * q;
        float ss = 0.f;
#define E_SSTEP(s) { const v4u y = *(const v4u*)(xr + 32 * (s)); \
            const float a0 = bf2f(y.x & 0xffffu), a1 = bf2f(y.x >> 16), a2 = bf2f(y.y & 0xffffu), a3 = bf2f(y.y >> 16), b0 = bf2f(y.z & 0xffffu), b1 = bf2f(y.z >> 16), b2 = bf2f(y.w & 0xffffu), b3 = bf2f(y.w >> 16); \
            ss += (a0 * a0 + a1 * a1) + (a2 * a2 + a3 * a3) + (b0 * b0 + b1 * b1) + (b2 * b2 + b3 * b3); }
        if (ksplit) {
#pragma unroll
            for (int s8 = 0; s8 < 8; ++s8) E_SSTEP(8 * kq + s8)
            ss += __shfl_xor(ss, 16); ss += __shfl_xor(ss, 32);
            if (q == 0) ssp[wave * 16 + m] = ss;
            __syncthreads();
            const int w0 = wave & 4;
            ss = (ssp[w0 * 16 + m] + ssp[(w0 + 1) * 16 + m]) + (ssp[(w0 + 2) * 16 + m] + ssp[(w0 + 3) * 16 + m]);
        } else {
#pragma unroll 16
            for (int s = 0; s < 32; ++s) E_SSTEP(s)
            ss += __shfl_xor(ss, 16); ss += __shfl_xor(ss, 32);
        }
#undef E_SSTEP
        const float rs = rsqrtf(ss * (1.f / D) + EPS);
        f32x4 acc0 = {0.f, 0.f, 0.f, 0.f}, acc1 = {0.f, 0.f, 0.f, 0.f};
        bf16_t* hbr = HB + (size_t)n * D + 8 * q;
#define E_KSTEP(s) { \
            const v4u xy = *(const v4u*)(xr + 32 * (s)); \
            const f32x4 xa = {bf2f(xy.x & 0xffffu), bf2f(xy.x >> 16), bf2f(xy.y & 0xffffu), bf2f(xy.y >> 16)}, xb = {bf2f(xy.z & 0xffffu), bf2f(xy.z >> 16), bf2f(xy.w & 0xffffu), bf2f(xy.w >> 16)}; \
            const f32x4 aa = *(const f32x4*)(ab + 32 * (s)), abv = *(const f32x4*)(ab + 32 * (s) + 4); \
            const f32x4 ba = *(const f32x4*)(ab + 1024 + 32 * (s)), bbv = *(const f32x4*)(ab + 1024 + 32 * (s) + 4); \
            float h[8]; \
            _Pragma("unroll") \
            for (int j = 0; j < 4; ++j) { h[j] = xa[j] * rs * aa[j] + ba[j]; h[4 + j] = xb[j] * rs * abv[j] + bbv[j]; } \
            v4u hi, lo; \
            hi.x = e_cvtpk(h[0], h[1]); hi.y = e_cvtpk(h[2], h[3]); hi.z = e_cvtpk(h[4], h[5]); hi.w = e_cvtpk(h[6], h[7]); \
            lo.x = e_cvtpk(h[0] - bf2f(hi.x & 0xffffu), h[1] - bf2f(hi.x >> 16)); lo.y = e_cvtpk(h[2] - bf2f(hi.y & 0xffffu), h[3] - bf2f(hi.y >> 16)); \
            lo.z = e_cvtpk(h[4] - bf2f(hi.z & 0xffffu), h[5] - bf2f(hi.z >> 16)); lo.w = e_cvtpk(h[6] - bf2f(hi.w & 0xffffu), h[7] - bf2f(hi.w >> 16)); \
            *(v4u*)(hbr + 32 * (s)) = hi; \
            const e_bf16x8 ahi = __builtin_bit_cast(e_bf16x8, hi), alo = __builtin_bit_cast(e_bf16x8, lo); \
            const int ck = 4 * (s) + q; \
            const e_bf16x8 b0h = *(const LAS e_bf16x8*)(lds + m * 2048 + ((ck ^ m) << 4)), b1h = *(const LAS e_bf16x8*)(lds + (16 + m) * 2048 + ((ck ^ m) << 4)); \
            const e_bf16x8 b0l = *(const LAS e_bf16x8*)(lds + (32 + m) * 2048 + ((ck ^ m) << 4)), b1l = *(const LAS e_bf16x8*)(lds + (48 + m) * 2048 + ((ck ^ m) << 4)); \
            acc0 = __builtin_amdgcn_mfma_f32_16x16x32_bf16(ahi, b0h, acc0, 0, 0, 0); acc1 = __builtin_amdgcn_mfma_f32_16x16x32_bf16(ahi, b1h, acc1, 0, 0, 0); \
            acc0 = __builtin_amdgcn_mfma_f32_16x16x32_bf16(alo, b0h, acc0, 0, 0, 0); acc1 = __builtin_amdgcn_mfma_f32_16x16x32_bf16(alo, b1h, acc1, 0, 0, 0); \
            acc0 = __builtin_amdgcn_mfma_f32_16x16x32_bf16(ahi, b0l, acc0, 0, 0, 0); acc1 = __builtin_amdgcn_mfma_f32_16x16x32_bf16(ahi, b1l, acc1, 0, 0, 0); \
        }
        if (ksplit) {
#pragma unroll
            for (int s8 = 0; s8 < 8; ++s8) E_KSTEP(8 * kq + s8)
            __syncthreads();
            { LAS f32x4* ap = (LAS f32x4*)(lds + wave * 2048 + lane * 32); ap[0] = acc0; ap[1] = acc1; }
            __syncthreads();
            { const int w0 = wave & 4; const LAS f32x4* a0p = (const LAS f32x4*)(lds + w0 * 2048 + lane * 32);
              acc0 = (a0p[0] + a0p[128]) + (a0p[256] + a0p[384]); acc1 = (a0p[1] + a0p[129]) + (a0p[257] + a0p[385]); }
        } else {
#pragma unroll 8
            for (int s = 0; s < 32; ++s) E_KSTEP(s)
        }
#undef E_KSTEP
#pragma unroll
        for (int r = 0; r < 4; ++r) if (!ksplit || r == kq) {
            float v0 = acc0[r] + bias0, v1 = acc1[r] + bias1;
            int idx[4]; float val[4];
#pragma unroll
            for (int k = 0; k < 4; ++k) {
                float bv = v0; int bi = m; if (v1 > v0) { bv = v1; bi = 16 + m; }
#pragma unroll
                for (int o = 1; o < 16; o <<= 1) { const float ov = __shfl_xor(bv, o); const int oi = __shfl_xor(bi, o); if (ov > bv || (ov == bv && oi < bi)) { bv = ov; bi = oi; } }
                idx[k] = bi; val[k] = bv;
                if (bi == m) v0 = -INFINITY; if (bi == 16 + m) v1 = -INFINITY;
            }
            float ex[4], sum = 0.f;
#pragma unroll
            for (int k = 0; k < 4; ++k) { ex[k] = __expf(val[k] - val[0]); sum += ex[k]; }
            const float inv = 1.f / sum;
            if (m == 0) { const int tok = 4 * q + r, tl = (wave + 8 * it) * 16 + tok, nt = nbase + tok;
                if (tl < E_MAXTOK) { tokn[tl] = nt;
#pragma unroll
                    for (int k = 0; k < 4; ++k) { const int lpos = atomicAdd((int*)&bcnt[idx[k]], 1); info[tl * 4 + k] = (idx[k] << 16) | lpos; gate[nt * 4 + k] = ex[k] * inv; } } }
        }
    }
    __syncthreads();
    if (tid < 32) base[tid] = atomicAdd(&cnt[tid], bcnt[tid]);
    __syncthreads();
    for (int i = tid; i < E_MAXTOK * 4; i += NTHR) { const int inf = info[i];
        if (inf >= 0) { const int tl = i >> 2, k = i & 3, n = tokn[tl];
            const int e_ = inf >> 16, pos = base[e_] + (inf & 0xffff);
            list[e_ * CAP + pos] = n; posi[n * 4 + k] = (e_ << 20) | pos; } }
}
__device__ __forceinline__ void prologue_router(const Params& p, int bid, int nb) {
    bf16_t* wt = (bf16_t*)(p.ws + ws::WT_RT);
    for (int gidx = bid * NTHR + otid(); gidx < DEPTH * 32 * 1024; gidx += nb * NTHR) {
        const int layer = gidx >> 15, e = (gidx >> 10) & 31, k = gidx & 1023;
        const float w = p.in[23][((size_t)layer * 1024 + k) * 32 + e];
        const unsigned hi = f2bf(w); const unsigned lo = f2bf(w - bf2f(hi));
        wt[((size_t)(layer * 2 + 0) * 32 + e) * 1024 + k] = (bf16_t)hi; wt[((size_t)(layer * 2 + 1) * 32 + e) * 1024 + k] = (bf16_t)lo;
    }
}
__device__ __forceinline__ void phaseFinal(const Params& p, LAS unsigned char* lds, int bid, int nb) {
    const int tid = otid(), lane = tid & 63, wave = __builtin_amdgcn_readfirstlane(tid >> 6);
    LAS int* tab = (LAS int*)(lds + LDS_MISC);
    moe_tables((const int*)(p.ws + ws::CTL) + ws::CW_CNT + 3 * 32, tab);
    float gg[16]; ld16f(p.in[29], lane, gg);
    for (int i = bid * 8 + wave; i < NB * L; i += nb * 8) {
        const int b = i / L, l = i % L, n = b * T + C + l;
        float x[16]; load_row(p, 4, n, lane, true, x, tab);
        float ss = 0.f;
#pragma unroll
        for (int j = 0; j < 16; ++j) ss += x[j] * x[j];
        const float rs = rsqrtf(wave_sum(ss) * (1.f / D) + EPS);
#pragma unroll
        for (int j = 0; j < 16; ++j) x[j] = x[j] * rs * gg[j];
        st16f(p.out + (size_t)i * D, lane, x);
    }
}
__device__ __forceinline__ void prologue_mods(const Params& p, LAS unsigned char* lds, int bid, int nb) {
    const int tid = otid(), lane = tid & 63, wave = tid >> 6;
    LAS float* sc = (LAS float*)lds;
    LAS float* part = (LAS float*)(lds + 36864);
    float* mods = (float*)(p.ws + ws::MODS);
    __syncthreads();
    for (int i = tid; i < 9 * 1024; i += NTHR) { const int r = i >> 10, k = i & 1023; const float v = r < 8 ? p.in[1][r * 1024 + k] : p.in[3][k]; sc[i] = v / (1.f + expf(-v)); }
    __syncthreads();
    for (int task = bid; task < DEPTH * 96; task += nb) {
        const int layer = task / 96, col = (task % 96) * 64 + lane;
        const float* w = p.in[4] + (size_t)layer * 1024 * 6144 + col;
        float acc[9];
#pragma unroll
        for (int r = 0; r < 9; ++r) acc[r] = 0.f;
#pragma unroll 32
        for (int kk = 0; kk < 128; ++kk) { const int k = wave * 128 + kk; const float wv = w[(size_t)k * 6144];
#pragma unroll
            for (int r = 0; r < 9; ++r) acc[r] += sc[r * 1024 + k] * wv; }
#pragma unroll
        for (int r = 0; r < 9; ++r) part[(wave * 9 + r) * 64 + lane] = acc[r];
        __syncthreads();
        for (int i = tid; i < 9 * 64; i += NTHR) { const int r = i >> 6, cc = i & 63; float s = 0.f;
#pragma unroll
            for (int ww = 0; ww < 8; ++ww) s += part[(ww * 9 + r) * 64 + cc];
            const int c2 = (task % 96) * 64 + cc; mods[((size_t)layer * 9 + r) * 6144 + c2] = s + p.in[5][layer * 6144 + c2]; }
        __syncthreads();
    }
    float* rope = (float*)(p.ws + ws::ROPE);
    for (int gid = bid * NTHR + tid; gid < L * 32; gid += nb * NTHR) {
        const int l = gid >> 5, j = gid & 31, axis = j >> 4, f = j & 15;
        const float pos = (float)(axis == 0 ? (l / 64) : (l % 64));
        const float inv = (float)pow(10000.0, -(double)(2 * f) / 32.0);
        const float ang = pos * inv;
        rope[gid] = (float)cos((double)ang); rope[L * 32 + gid] = (float)sin((double)ang);
    }
}

#define XB_TMO      128
#define XB_XCNT(j)  (256  + 64 * (j))
#define XB_XSUB(j)  (1280 + 64 * (j))
#define XB_XGEN(j)  (2304 + 64 * (j))
#define XB_TOP      3328
#define XB_TOPGEN   3392
#define XCD_BAR_WORDS 3456
#define XB_SPIN_CAP (1u << 18)

__device__ __forceinline__ unsigned xb_ld(unsigned* p)              { return __hip_atomic_load(p, __ATOMIC_RELAXED, __HIP_MEMORY_SCOPE_AGENT); }
__device__ __forceinline__ unsigned xb_add(unsigned* p, unsigned v) { return __hip_atomic_fetch_add(p, v, __ATOMIC_RELAXED, __HIP_MEMORY_SCOPE_AGENT); }
__device__ __forceinline__ unsigned xb_xcc_id() { return (unsigned)__builtin_amdgcn_s_getreg((3 << 11) | 20) & 0xFu; }
#define XB_SPIN(cond, bar) do { unsigned _sp = 0; while (cond) { __builtin_amdgcn_s_sleep(1); \
    if ((++_sp & 255u) == 0u) { if (xb_ld(&(bar)[XB_TMO])) break; if (_sp > XB_SPIN_CAP) { atomicAdd(&(bar)[XB_TMO], 1u); break; } } } } while (0)

struct XcdBarrier {
    unsigned* bar; unsigned x;
    volatile LAS unsigned* st;
};

__device__ __forceinline__ XcdBarrier xcd_barrier_post(unsigned* bar, volatile LAS unsigned* st) {
    XcdBarrier b; b.bar = bar; b.x = xb_xcc_id(); b.st = st;
    if (threadIdx.x == 0) (void)xb_add(&bar[XB_XCNT(b.x)], 1u);
    return b;
}
__device__ __forceinline__ void xcd_barrier_complete(unsigned* bar, unsigned x, unsigned& nloc, unsigned& nx) {
    const unsigned G = gridDim.x * gridDim.y * gridDim.z;
    unsigned sum, cnt, mine, sp = 0u;
    for (;;) {
        sum = 0u; cnt = 0u; mine = 0u;
#pragma unroll
        for (unsigned j = 0; j < 16; ++j) { const unsigned c = xb_ld(&bar[XB_XCNT(j)]); sum += c; cnt += (c > 0u) ? 1u : 0u; mine = (j == x) ? c : mine; }
        if (sum == G) break;
        __builtin_amdgcn_s_sleep(1);
        if ((++sp & 255u) == 0u) { if (xb_ld(&bar[XB_TMO])) break; if (sp > XB_SPIN_CAP) { atomicAdd(&bar[XB_TMO], 1u); break; } }
    }
    nloc = mine > 0u ? mine : 1u; nx = cnt > 0u ? cnt : 1u;
}

__device__ __forceinline__ void xcd_barrier(const XcdBarrier& b) {
    asm volatile("s_waitcnt vmcnt(0)" ::: "memory");
    __syncthreads();
    if (threadIdx.x == 0) {
        unsigned* bar = b.bar;
        __builtin_amdgcn_s_waitcnt(0);
        unsigned nloc = b.st[0], nx = b.st[1];
        if (nloc == 0u) { xcd_barrier_complete(bar, b.x, nloc, nx); b.st[0] = nloc; b.st[1] = nx; }
        const unsigned old = xb_add(&bar[XB_XSUB(b.x)], 1u);
        const unsigned gen = old / nloc;
        if (old + 1u == (gen + 1u) * nloc) {
            __builtin_amdgcn_fence(__ATOMIC_RELEASE, "agent");
            asm volatile("s_waitcnt vmcnt(0)" ::: "memory");
            const unsigned og = xb_add(&bar[XB_TOP], 1u);
            const unsigned tg = og / nx;
            if (og + 1u == (tg + 1u) * nx) xb_add(&bar[XB_TOPGEN], 1u);
            else XB_SPIN(xb_ld(&bar[XB_TOPGEN]) == tg, bar);
            __builtin_amdgcn_fence(__ATOMIC_ACQUIRE, "agent");
            xb_add(&bar[XB_XGEN(b.x)], 1u);
            asm volatile("s_waitcnt vmcnt(0)" ::: "memory");
        } else {
            XB_SPIN(xb_ld(&bar[XB_XGEN(b.x)]) == gen, bar);
            __builtin_amdgcn_fence(__ATOMIC_ACQUIRE, "agent");
            asm volatile("s_waitcnt vmcnt(0)" ::: "memory");
        }
    }
    __syncthreads();
}


#ifndef MK_MULTI
#define MK_MULTI 0
#endif
constexpr int CW_BAR = 4096;
constexpr int N_PHASES = 38;
__global__ void __launch_bounds__(NTHR, 2) mega(Params p) {
    LAS unsigned char* lds = (LAS unsigned char*)dyn_lds;
    volatile LAS unsigned* st = (volatile LAS unsigned*)(lds + LDS_MISC + 1024);
    if (threadIdx.x == 0) { st[0] = 0u; st[1] = 0u; st[2] = 0u; st[3] = 0u; }
    __syncthreads();
#if defined(PROBE_SECTION)
    if (threadIdx.x == 0) *PSEC_ACC(lds) = 0ull;
#endif
    const int bid = blockIdx.x, nb = gridDim.x;
    const int lo = p.ph_lo, hi = p.ph_hi;
    const bool one = (hi - lo) == N_PHASES;
    XcdBarrier xb; xb.bar = (unsigned*)(p.ws + ws::CTL) + CW_BAR; xb.x = 0; xb.st = st;
    if (one) xb = xcd_barrier_post((unsigned*)(p.ws + ws::CTL) + CW_BAR, st);
#define PH(idx) ((idx) >= lo && (idx) < hi)
#if defined(PROBE_MASK)
    unsigned long long t_acc = 0ull, t_prev = __builtin_amdgcn_s_memrealtime(); int ph_cur = 0;
#define SEAM() do { if (one) xcd_barrier(xb); { const unsigned long long now_ = __builtin_amdgcn_s_memrealtime(); if ((PROBE_MASK >> ph_cur) & 1ull) t_acc += now_ - t_prev; t_prev = now_; ++ph_cur; } } while (0)
#define SKIPPH(n) do { ph_cur += (n); } while (0)
#else
#define SEAM() do { if (one) xcd_barrier(xb); } while (0)
#define SKIPPH(n) do { } while (0)
#endif
    if (PH(0)) { prologue_router(p, bid, nb); prologue_mods(p, lds, bid, nb); prologue_dense_weights(p, lds, bid, nb); prologue_moe_weights(p, lds, bid, nb); }
    SEAM();
    for (int layer = 0; layer < DEPTH; ++layer) {
        const int pb = 1 + 9 * layer;
        if (PH(pb + 0)) { if (layer == 1 && nb == 256) moe_pool_finish(p, 0, bid, nb); phaseA(p, layer, lds, bid, nb); }
        SEAM();
        if (layer == 2) {
            if (PH(pb + 1)) gin_phase(p, lds, bid, nb);
            SEAM();
            if (PH(pb + 2)) gdn_g3_phase(p, lds, bid, nb);
            SEAM();
            if (PH(pb + 3)) gdn_g4_phase(p, lds, bid, nb);
            SEAM();
            if (PH(pb + 4)) { gdn_g5_phase(p, lds, bid, nb); if (nb == 256) moe_pool_finish(p, 1, bid, nb); }
        } else {
            if (PH(pb + 1)) qkv_phase(p, layer, lds, bid, nb);
            SEAM();
            if (PH(pb + 2)) attn_phase_fn(p, layer, lds, bid, nb);
            SKIPPH(2);
        }
        SEAM();
        if (PH(pb + 5)) oproj_phase(p, layer, lds, bid, nb);
        SEAM();
        if (PH(pb + 6)) phaseE(p, layer, lds, bid, nb);
        SEAM();
        if (PH(pb + 7)) moe_up_phase(p, layer, lds, bid, nb);
        SEAM();
        if (PH(pb + 8)) moe_down_phase(p, layer, lds, bid, nb);
        SEAM();
    }
    if (PH(37)) phaseFinal(p, lds, bid, nb);
#if defined(PROBE_SECTION)
    __syncthreads();
    if (bid == 0 && otid() == 0) { const unsigned long long acc_ = *PSEC_ACC(lds), t0_ = __builtin_amdgcn_s_memrealtime(); while (__builtin_amdgcn_s_memrealtime() - t0_ < 9ull * acc_) __builtin_amdgcn_s_sleep(8); }
#endif
#if defined(PROBE_MASK)
    { const unsigned long long now_ = __builtin_amdgcn_s_memrealtime(); if ((PROBE_MASK >> 37) & 1ull) t_acc += now_ - t_prev;
      if (bid == 0 && otid() == 0) { const unsigned long long t0_ = __builtin_amdgcn_s_memrealtime(); while (__builtin_amdgcn_s_memrealtime() - t0_ < 9ull * t_acc) __builtin_amdgcn_s_sleep(8); } }
#endif
#undef PH
#undef SEAM
#undef SKIPPH
}

extern "C" void kernel_launch(void* const* d_in, const int* in_sizes, int n_in, void* d_out, int out_size, void* d_ws, size_t ws_size, hipStream_t stream) {
    static int grid = 0;
    if (grid == 0) {
        int dev = 0, cus = 0, per_cu = 0;
        if (ws_size < ws::END) { fprintf(stderr, "kernel_launch: workspace too small: %zu < %zu\n", ws_size, (size_t)ws::END); grid = -1; return; }
        if (hipGetDevice(&dev) != hipSuccess || hipDeviceGetAttribute(&cus, hipDeviceAttributeMultiprocessorCount, dev) != hipSuccess) { grid = -1; return; }
        if (hipFuncSetAttribute((const void*)mega, hipFuncAttributeMaxDynamicSharedMemorySize, LDS_BYTES) != hipSuccess) { fprintf(stderr, "kernel_launch: hipFuncSetAttribute failed\n"); grid = -1; return; }
        if (hipOccupancyMaxActiveBlocksPerMultiprocessor(&per_cu, (const void*)mega, NTHR, LDS_BYTES) != hipSuccess || per_cu < 1) { fprintf(stderr, "kernel_launch: occupancy query says %d\n", per_cu); per_cu = 1; }
        (void)hipGetLastError();
        grid = cus;
    }
    if (grid < 0) return;
    (void)hipMemsetAsync((char*)d_ws + ws::CTL, 0, 65536, stream);
    Params prm{};
    for (int q = 0; q < 30; ++q) prm.in[q] = (const float*)d_in[q];
    prm.out = (float*)d_out; prm.ws = (unsigned char*)d_ws;
#if MK_MULTI
    for (int ph = 0; ph < N_PHASES; ++ph) { prm.ph_lo = ph; prm.ph_hi = ph + 1; hipLaunchKernelGGL(mega, dim3(grid), dim3(NTHR), LDS_BYTES, stream, prm); }
#else
    prm.ph_lo = 0; prm.ph_hi = N_PHASES;
    hipLaunchKernelGGL(mega, dim3(grid), dim3(NTHR), LDS_BYTES, stream, prm);
#endif
}
```

```cpp
#include <hip/hip_runtime.h>
#include <stdint.h>
#include <cstdio>

namespace cfg {
constexpr int D = 1024, NB = 8, L = 2048, C = 256, T = L + C, NTOK = NB * T, DEPTH = 4;
constexpr int HD = 64, NH = 16, NKV = 4, QKV = 1536, WINDOW = 128;
constexpr int GH = 8, GDK = 128, GIN = 4128;
constexpr int NE = 32, TOPK = 4, CAP = NTOK;
constexpr float EPS = 1e-6f;
}
using namespace cfg;

namespace ws {
constexpr size_t al(size_t x) { return (x + 4095) & ~(size_t)4095; }
constexpr size_t CTL = 0;
constexpr size_t MODS = 65536;
constexpr size_t ROPE = al(MODS + (size_t)DEPTH * 9 * 6144 * 4);
constexpr size_t X = al(ROPE + (size_t)L * 32 * 2 * 4);
constexpr size_t SP = al(X + (size_t)NTOK * D * 4);
constexpr size_t LIST = al(SP + (size_t)NTOK * 32 * 4);
constexpr size_t GATE = al(LIST + (size_t)NE * CAP * 4);
constexpr size_t POSI = al(GATE + (size_t)NTOK * 4 * 4);
constexpr size_t HB = al(POSI + (size_t)NTOK * 4 * 4);
constexpr size_t QB = al(HB + (size_t)NTOK * 1024 * 2);
constexpr size_t KB = al(QB + (size_t)NTOK * 1024 * 2);
constexpr size_t VB = al(KB + (size_t)NTOK * 256 * 2);
constexpr size_t PB = al(VB + (size_t)NTOK * 256 * 2);
constexpr size_t OBF = al(PB + (size_t)NTOK * 4096 * 2);
constexpr size_t ACTB = al(OBF + (size_t)NTOK * 1024 * 2);
constexpr size_t YSB = al(ACTB + (size_t)81920 * 1024 * 2);
constexpr size_t GDNS = al(YSB + (size_t)81920 * 1024 * 2);
constexpr size_t WT_UP = al(GDNS + (size_t)NB * 36 * 8 * 2 * 90120);
constexpr size_t WT_DN = al(WT_UP + (size_t)4 * 32 * 2048 * 1024 * 2);
constexpr size_t WT_QKV = al(WT_DN + (size_t)4 * 32 * 1024 * 1024 * 2);
constexpr size_t WT_O = al(WT_QKV + (size_t)3 * 1536 * 1024 * 2);
constexpr size_t WT_GIN = al(WT_O + (size_t)4 * 1024 * 1024 * 2);
constexpr size_t WT_RT = al(WT_GIN + (size_t)4096 * 1024 * 2);
constexpr size_t MODAB = al(WT_RT + (size_t)4 * 2 * 32 * 1024 * 2);
constexpr size_t SSQ = al(MODAB + (size_t)4 * 9 * 2 * 1024 * 4);
constexpr size_t END = al(SSQ + (size_t)NTOK * 16 * 4);
constexpr int CW_CNT = 1024;
constexpr int CW_OFFS = 2048;
}

__device__ __forceinline__ int cond_row(int n) { int b = n / T, p = n % T; return p < C ? 8 : b; }
__device__ __forceinline__ float silu_f(float v) { return v / (1.f + expf(-v)); }

__device__ __forceinline__ int otid() { int t = threadIdx.x; asm volatile("" : "+v"(t)); return t; }
#if defined(PROBE_SECTION)
#define PSEC_ACC(lds_) ((__attribute__((address_space(3))) unsigned long long*)((lds_) + 131072 + 1536))
#define PSEC_BEGIN() const unsigned long long psec_t0_ = __builtin_amdgcn_s_memrealtime()
#define PSEC_END(id, lds_, tid_) do { if ((id) == PROBE_SECTION && (tid_) == 0) *PSEC_ACC(lds_) += __builtin_amdgcn_s_memrealtime() - psec_t0_; } while (0)
#else
#define PSEC_BEGIN() do { } while (0)
#define PSEC_END(id, lds_, tid_) do { } while (0)
#endif
#define LDS_BARRIER() do { asm volatile("s_waitcnt lgkmcnt(0)" ::: "memory"); __builtin_amdgcn_s_barrier(); asm volatile("" ::: "memory"); } while (0)

namespace pg8 {
#define PG8_LAS __attribute__((address_space(3)))
typedef unsigned short bf16_t;
typedef short bf16x8 __attribute__((ext_vector_type(8)));
typedef float f32x4 __attribute__((ext_vector_type(4)));
typedef unsigned u32x4 __attribute__((ext_vector_type(4)));
constexpr int BM = 256, BK = 64, HALF = 128, HTB = HALF * BK * 2  , STAGE_BYTES = 8 * HTB;
__host__ __device__ __forceinline__ int lds_byte(int r, int c) { const int st = (r >> 4) * 2 + (c >> 5), rr = r & 15, cc = c & 31, ob = rr * 64 + cc * 2; return st * 1024 + (ob ^ (((ob >> 9) & 1) << 5)); }
__host__ __device__ __forceinline__ void stage_rc(int b, int& R, int& C) { const int st = b / 1024, sb = b % 1024, swz = sb ^ (((sb >> 9) & 1) << 5); R = (st >> 1) * 16 + swz / 64; C = (st & 1) * 32 + (swz % 64) / 2; }
__host__ __device__ __forceinline__ int perm32(int rho) { const int n = rho >> 4, i = rho & 15; return 8 * (i >> 2) + 4 * n + (i & 3); }
struct Unit { const char* a; const char* b; int pm, pn, e, mt, cnt, lx; };
__device__ __forceinline__ unsigned cvt_pk_bf16(float lo, float hi) { unsigned r; asm volatile("v_cvt_pk_bf16_f32 %0, %1, %2" : "=v"(r) : "v"(lo), "v"(hi)); return r; }
template <class Epi, class Sched, bool ALIGN_EPI = false, bool SP2 = false, bool GATHER = false, bool HALFM = false>
__device__ __forceinline__ void gemm_phase(PG8_LAS unsigned char* lds, const int Kdim, const Sched& S, const Epi& E) {
    const int tid = otid(), wid = __builtin_amdgcn_readfirstlane(tid >> 6), lane = tid & 63, wr = wid >> 2, wc = wid & 3, fr = lane & 15, fq = lane >> 4;
    const int K = Kdim, nt = K / BK;
    unsigned voffA[2], voffB[2];
#pragma unroll
    for (int i = 0; i < 2; ++i) { int R, C; stage_rc(tid * 16 + i * 8192, R, C); const int Rb = Epi::PERM ? ((R & ~31) + perm32(R & 31)) : R;
        voffA[i] = (unsigned)(R * K + C) * 2u; voffB[i] = (unsigned)(Rb * K + C) * 2u; }
    int RA[2]; unsigned CA2[2];
#pragma unroll
    for (int i = 0; i < 2; ++i) { int R, C; stage_rc(tid * 16 + i * 8192, R, C); RA[i] = R; CA2[i] = (unsigned)C * 2u; }
    const size_t kstep = (size_t)(BK * 2);
    const size_t hstep = (size_t)HALF * K * 2;
    const unsigned ldsw = (unsigned)wid * 1024u;
    const int aoff = lds_byte(wr * 64 + fr, fq * 8), boff = lds_byte(wc * 32 + fr, fq * 8);
#define PG8_SA(b, h) (((b) * 2 + (h)) * HTB)
#define PG8_SB(b, h) ((4 + (b) * 2 + (h)) * HTB)
#define PG8_STAGE(bufoff, gbase, voff) do { _Pragma("unroll") for (int _i = 0; _i < 2; ++_i) \
        __builtin_amdgcn_global_load_lds((const unsigned*)((const char*)(gbase) + (voff)[_i]), (PG8_LAS unsigned*)(lds + (bufoff) + ldsw + _i * 8192), 16, 0, 0); } while (0)
#define PG8_STAGE_G(bufoff, kb, g) do { _Pragma("unroll") for (int _i = 0; _i < 2; ++_i) \
        __builtin_amdgcn_global_load_lds((const unsigned*)(gA + (size_t)(kb) + (g)[_i]), (PG8_LAS unsigned*)(lds + (bufoff) + ldsw + _i * 8192), 16, 0, 0); } while (0)
#define PG8_LDA(dst, b, h) do { _Pragma("unroll") for (int m = 0; m < 4; ++m) _Pragma("unroll") for (int k = 0; k < 2; ++k) dst[m][k] = *(const PG8_LAS bf16x8*)(lds + PG8_SA(b, h) + aoff + m * 2048 + k * 1024); } while (0)
#define PG8_LDB(dst, b, h) do { _Pragma("unroll") for (int n = 0; n < 2; ++n) _Pragma("unroll") for (int k = 0; k < 2; ++k) dst[n][k] = *(const PG8_LAS bf16x8*)(lds + PG8_SB(b, h) + boff + n * 2048 + k * 1024); } while (0)
#define PG8_MMA(ai, bj, At, Bt) do { __builtin_amdgcn_s_setprio(1); _Pragma("unroll") for (int m = 0; m < 4; ++m) _Pragma("unroll") for (int n = 0; n < 2; ++n) _Pragma("unroll") for (int k = 0; k < 2; ++k) \
        acc[ai][bj][m][n] = __builtin_amdgcn_mfma_f32_16x16x32_bf16(Bt[n][k], At[m][k], acc[ai][bj][m][n], 0, 0, 0); __builtin_amdgcn_s_setprio(0); } while (0)
#define PG8_WAIT_V(n) asm volatile("s_waitcnt vmcnt(" #n ")" ::: "memory")
#define PG8_WAIT_L(n) asm volatile("s_waitcnt lgkmcnt(" #n ")" ::: "memory")
#define PG8_BAR __builtin_amdgcn_s_barrier()
#define PG8_SCHED __builtin_amdgcn_sched_barrier(0)
    Unit cur, nxt; int ui = 0;
    if (!S.next(0, cur)) return;
    f32x4 acc[2][2][4][2];
#pragma unroll
    for (int a = 0; a < 2; ++a)
#pragma unroll
        for (int b = 0; b < 2; ++b)
#pragma unroll
            for (int m = 0; m < 4; ++m)
#pragma unroll
                for (int n = 0; n < 2; ++n) acc[a][b][m][n] = (f32x4){0.f, 0.f, 0.f, 0.f};
    bf16x8 At[4][2], B0[2][2], B1[2][2];
    const char* cA = cur.a; const char* cB = cur.b;
    S.a_ready(cur);
    const char* gA = nullptr; unsigned gc[2][2] = {{0u, 0u}, {0u, 0u}}, gn[2][2] = {{0u, 0u}, {0u, 0u}};
    if constexpr (GATHER) { static_assert(SP2, "GATHER needs the SP2 loop"); gA = S.abase();
        Unit u1; const bool h1 = S.next(1, u1);
#pragma unroll
        for (int h = 0; h < 2; ++h)
#pragma unroll
            for (int i = 0; i < 2; ++i) { gc[h][i] = (unsigned)S.row_index(cur, h * HALF + RA[i]) * (unsigned)(K * 2) + CA2[i]; gn[h][i] = h1 ? (unsigned)S.row_index(u1, h * HALF + RA[i]) * (unsigned)(K * 2) + CA2[i] : gc[h][i]; } }
    if constexpr (SP2) {
        PG8_STAGE(PG8_SB(0, 0), cB, voffB); PG8_STAGE(PG8_SB(0, 1), cB + hstep, voffB);
        if constexpr (GATHER) { PG8_STAGE_G(PG8_SA(0, 0), 0, gc[0]); PG8_STAGE_G(PG8_SA(0, 1), 0, gc[1]); } else { PG8_STAGE(PG8_SA(0, 0), cA, voffA); PG8_STAGE(PG8_SA(0, 1), cA + hstep, voffA); }
        if (wr == 1) PG8_BAR;
        PG8_WAIT_V(2); PG8_BAR;
        PG8_STAGE(PG8_SB(1, 0), cB + kstep, voffB); if constexpr (GATHER) PG8_STAGE_G(PG8_SA(1, 0), kstep, gc[0]); else PG8_STAGE(PG8_SA(1, 0), cA + kstep, voffA); PG8_STAGE(PG8_SB(1, 1), cB + hstep + kstep, voffB);
        PG8_WAIT_V(6); PG8_BAR;
    } else {
        PG8_STAGE(PG8_SB(0, 0), cB, voffB); PG8_STAGE(PG8_SA(0, 0), cA, voffA); PG8_STAGE(PG8_SB(0, 1), cB + hstep, voffB); PG8_STAGE(PG8_SA(0, 1), cA + hstep, voffA);
        if (wr == 1) PG8_BAR;
        PG8_WAIT_V(4); PG8_BAR;
        PG8_STAGE(PG8_SB(1, 0), cB + kstep, voffB); PG8_STAGE(PG8_SA(1, 0), cA + kstep, voffA); PG8_STAGE(PG8_SB(1, 1), cB + hstep + kstep, voffB);
        PG8_WAIT_V(6); PG8_BAR;
    }
    for (;;) {
        const bool has_next = S.next(ui + 1, nxt);
        int ix[2][2] = {{0, 0}, {0, 0}}; bool has_nn = false;
        if constexpr (GATHER) { Unit nn; has_nn = has_next && S.next(ui + 2, nn);
            if (has_nn) {
#pragma unroll
                for (int h = 0; h < 2; ++h)
#pragma unroll
                    for (int i = 0; i < 2; ++i) ix[h][i] = S.row_index(nn, h * HALF + RA[i]); } }
        const char* nA = has_next ? nxt.a : cA; const char* nB = has_next ? nxt.b : cB;
        for (int t = 0; t < nt; t += 2) {
            const bool last = (t == nt - 2);
            const char* a1 = cA + (size_t)(t + 1) * kstep;
            const char* a2 = last ? nA : cA + (size_t)(t + 2) * kstep; const char* b2 = last ? nB : cB + (size_t)(t + 2) * kstep;
            const char* a3 = a2 + kstep; const char* b3 = b2 + kstep;
            if (last && has_next) S.a_ready(nxt);
            unsigned s0[2] = {0u, 0u}, s1[2] = {0u, 0u}; size_t kb2 = 0;
            if constexpr (GATHER) { kb2 = last ? (size_t)0 : (size_t)(t + 2) * kstep;
#pragma unroll
                for (int i = 0; i < 2; ++i) { s0[i] = last ? gn[0][i] : gc[0][i]; s1[i] = last ? gn[1][i] : gc[1][i]; } }
            if constexpr (SP2) {
            PG8_LDB(B0, 0, 0); PG8_LDB(B1, 0, 1); PG8_SCHED; PG8_LDA(At, 0, 0); if constexpr (GATHER) PG8_STAGE_G(PG8_SA(1, 1), (size_t)(t + 1) * kstep, gc[1]); else PG8_STAGE(PG8_SA(1, 1), a1 + hstep, voffA);
            PG8_WAIT_V(8); PG8_WAIT_L(0); PG8_BAR; PG8_MMA(0, 0, At, B0); PG8_MMA(0, 1, At, B1); PG8_BAR; PG8_SCHED;
            if constexpr (!HALFM) PG8_LDA(At, 0, 1); PG8_STAGE(PG8_SB(0, 0), b2, voffB); PG8_STAGE(PG8_SB(0, 1), b2 + hstep, voffB); if constexpr (GATHER) PG8_STAGE_G(PG8_SA(0, 0), kb2, s0); else PG8_STAGE(PG8_SA(0, 0), a2, voffA);
            PG8_WAIT_V(8); PG8_WAIT_L(0); PG8_BAR; if constexpr (!HALFM) { PG8_MMA(1, 0, At, B0); PG8_MMA(1, 1, At, B1); } PG8_BAR; PG8_SCHED;
            PG8_LDB(B0, 1, 0); PG8_LDB(B1, 1, 1); PG8_SCHED; PG8_LDA(At, 1, 0); if constexpr (GATHER) PG8_STAGE_G(PG8_SA(0, 1), kb2, s1); else PG8_STAGE(PG8_SA(0, 1), a2 + hstep, voffA);
            PG8_WAIT_V(8); PG8_WAIT_L(0); PG8_BAR; PG8_MMA(0, 0, At, B0); PG8_MMA(0, 1, At, B1); PG8_BAR; PG8_SCHED;
            if constexpr (!HALFM) PG8_LDA(At, 1, 1); PG8_STAGE(PG8_SB(1, 0), b3, voffB); PG8_STAGE(PG8_SB(1, 1), b3 + hstep, voffB); if constexpr (GATHER) PG8_STAGE_G(PG8_SA(1, 0), kb2 + kstep, s0); else PG8_STAGE(PG8_SA(1, 0), a3, voffA);
            PG8_WAIT_V(8); PG8_WAIT_L(0); PG8_BAR; if constexpr (!HALFM) { PG8_MMA(1, 0, At, B0); PG8_MMA(1, 1, At, B1); } PG8_BAR; PG8_SCHED;
            } else {
            PG8_LDB(B0, 0, 0); PG8_SCHED; PG8_LDA(At, 0, 0); PG8_STAGE(PG8_SA(1, 1), a1 + hstep, voffA);
            PG8_WAIT_L(8); PG8_BAR; PG8_WAIT_L(0); PG8_MMA(0, 0, At, B0); PG8_BAR; PG8_SCHED;
            PG8_LDB(B1, 0, 1); PG8_STAGE(PG8_SB(0, 0), b2, voffB);
            PG8_BAR; PG8_WAIT_L(0); PG8_MMA(0, 1, At, B1); PG8_BAR;
            PG8_LDA(At, 0, 1); PG8_STAGE(PG8_SA(0, 0), a2, voffA);
            PG8_BAR; PG8_WAIT_L(0); PG8_MMA(1, 0, At, B0); PG8_BAR; PG8_SCHED;
            PG8_STAGE(PG8_SB(0, 1), b2 + hstep, voffB);
            PG8_WAIT_V(6); PG8_BAR; PG8_MMA(1, 1, At, B1); PG8_BAR;
            PG8_LDB(B0, 1, 0); PG8_SCHED; PG8_LDA(At, 1, 0); PG8_STAGE(PG8_SA(0, 1), a2 + hstep, voffA);
            PG8_WAIT_L(8); PG8_BAR; PG8_WAIT_L(0); PG8_MMA(0, 0, At, B0); PG8_BAR; PG8_SCHED;
            PG8_LDB(B1, 1, 1); PG8_STAGE(PG8_SB(1, 0), b3, voffB);
            PG8_BAR; PG8_WAIT_L(0); PG8_MMA(0, 1, At, B1); PG8_BAR;
            PG8_LDA(At, 1, 1); PG8_STAGE(PG8_SA(1, 0), a3, voffA);
            PG8_BAR; PG8_WAIT_L(0); PG8_MMA(1, 0, At, B0); PG8_BAR; PG8_SCHED;
            PG8_STAGE(PG8_SB(1, 1), b3 + hstep, voffB);
            PG8_WAIT_V(6); PG8_BAR; PG8_MMA(1, 1, At, B1); PG8_BAR;
            }
        }
        if constexpr (ALIGN_EPI) { if (wr == 0) PG8_BAR; }
        if constexpr (!Epi::AFTER_DRAIN) { E(acc, cur, wr, wc, fr, fq); S.done(cur); }
        if (!has_next) break;
#pragma unroll
        for (int a = 0; a < 2; ++a)
#pragma unroll
            for (int b = 0; b < 2; ++b)
#pragma unroll
                for (int m = 0; m < 4; ++m)
#pragma unroll
                    for (int n = 0; n < 2; ++n) acc[a][b][m][n] = (f32x4){0.f, 0.f, 0.f, 0.f};
        cur = nxt; cA = nA; cB = nB; ++ui;
        if constexpr (GATHER) {
#pragma unroll
            for (int h = 0; h < 2; ++h)
#pragma unroll
                for (int i = 0; i < 2; ++i) { gc[h][i] = gn[h][i]; if (has_nn) gn[h][i] = (unsigned)ix[h][i] * (unsigned)(K * 2) + CA2[i]; } }
        if constexpr (ALIGN_EPI) { if (wr == 1) PG8_BAR; }
    }
    PG8_WAIT_V(0);
    if constexpr (!ALIGN_EPI) { if (wr == 0) PG8_BAR; }
    PG8_BAR;
    if constexpr (Epi::AFTER_DRAIN) { E.fused(acc, cur, wr, wc, fr, fq, lds, wid, lane); S.done(cur); }
#undef PG8_SA
#undef PG8_SB
#undef PG8_STAGE
#undef PG8_STAGE_G
#undef PG8_LDA
#undef PG8_LDB
#undef PG8_MMA
#undef PG8_WAIT_V
#undef PG8_WAIT_L
#undef PG8_BAR
#undef PG8_SCHED
}
}

constexpr int NTHR = 512, LDS_BYTES = 147456, LDS_MISC = 131072;
#define LAS __attribute__((address_space(3)))
typedef unsigned short bf16_t;
typedef unsigned v4u __attribute__((ext_vector_type(4)));
typedef float f32x4 __attribute__((ext_vector_type(4)));
__device__ __forceinline__ unsigned f2bf(float f) { unsigned u = __builtin_bit_cast(unsigned, f); return (u + 0x7fffu + ((u >> 16) & 1u)) >> 16; }
__device__ __forceinline__ unsigned pk2(float lo, float hi) { return f2bf(lo) | (f2bf(hi) << 16); }
__device__ __forceinline__ float bf2f(unsigned b) { return __builtin_bit_cast(float, b << 16); }
#define LDS_WAIT() asm volatile("s_waitcnt lgkmcnt(0)" ::: "memory")

struct Params {
    const float* in[30];
    float* out;
    unsigned char* ws;
    int ph_lo; int ph_hi;
};

__device__ __forceinline__ void transpose_item(const float* W, int N, bf16_t* WT  , int k0, int nlog0, LAS float* scr, int lane) {
#pragma unroll
    for (int i = 0; i < 32; ++i) { const int kk = 2 * i + (lane >> 5); scr[kk * 33 + (lane & 31)] = W[(size_t)(k0 + kk) * N + nlog0 + (lane & 31)]; }
    LDS_WAIT(); asm volatile("" ::: "memory");
    const int c = lane & 7;
#pragma unroll
    for (int j = 0; j < 4; ++j) { const int n = (lane >> 3) + 8 * j; const LAS float* s = scr + (8 * c) * 33 + n;
        v4u o; o.x = pk2(s[0 * 33], s[1 * 33]); o.y = pk2(s[2 * 33], s[3 * 33]); o.z = pk2(s[4 * 33], s[5 * 33]); o.w = pk2(s[6 * 33], s[7 * 33]);
        *(v4u*)(WT + (size_t)n * 1024 + k0 + 8 * c) = o; }
    LDS_WAIT(); asm volatile("" ::: "memory");
}
__device__ __forceinline__ int upmap(int n0) { return ((n0 & 255) >> 7) * 1024 + (n0 >> 8) * 128 + (n0 & 127); }

__device__ __forceinline__ void moe_item_addr(const Params& p, int layer, int it, const float*& W, int& N, bf16_t*& WT, int& k0, int& nlog0) {
    if (it < 32 * 1024) { const int mi = layer * 32 + (it >> 10), r = it & 1023, kb = r >> 6, n0 = (r & 63) * 32;
        W = p.in[25] + (size_t)mi * 1024 * 2048; N = 2048; WT = (bf16_t*)(p.ws + ws::WT_UP) + ((size_t)mi * 2048 + n0) * 1024; k0 = kb * 64; nlog0 = upmap(n0); }
    else { const int j = it - 32 * 1024, mi = layer * 32 + (j >> 9), r = j & 511, kb = r >> 5, n0 = (r & 31) * 32;
        W = p.in[27] + (size_t)mi * 1024 * 1024; N = 1024; WT = (bf16_t*)(p.ws + ws::WT_DN) + ((size_t)mi * 1024 + n0) * 1024; k0 = kb * 64; nlog0 = n0; }
}
__device__ __forceinline__ void moe_item_load(const Params& p, int layer, int it, int lane, f32x4 (&v)[8]) {
    const float* W; int N, k0, nlog0; bf16_t* WT; moe_item_addr(p, layer, it, W, N, WT, k0, nlog0);
    const int g = lane >> 3, nq = lane & 7;
#pragma unroll
    for (int j = 0; j < 8; ++j) v[j] = *(const f32x4*)(W + (size_t)(k0 + 8 * g + j) * N + nlog0 + 4 * nq);
}
__device__ __forceinline__ void moe_item_store(const Params& p, int layer, int it, int lane, const f32x4 (&v)[8]) {
    const float* W; int N, k0, nlog0; bf16_t* WT; moe_item_addr(p, layer, it, W, N, WT, k0, nlog0);
    const int g = lane >> 3, nq = lane & 7;
#pragma unroll
    for (int i = 0; i < 4; ++i) { v4u o; o.x = pg8::cvt_pk_bf16(v[0][i], v[1][i]); o.y = pg8::cvt_pk_bf16(v[2][i], v[3][i]); o.z = pg8::cvt_pk_bf16(v[4][i], v[5][i]); o.w = pg8::cvt_pk_bf16(v[6][i], v[7][i]);
        *(v4u*)(WT + (size_t)(4 * nq + i) * 1024 + k0 + 8 * g) = o; }
}
constexpr int SIDE_JQ = 8, SIDE_JG = 8, SIDE_JQ3 = 6;
constexpr int TAIL_Q0 = 0, POOL1_BEG = TAIL_Q0 + 640 * SIDE_JQ;
constexpr int TAIL_Q1 = 18432, POOL2_BEG = TAIL_Q1 + 640 * SIDE_JQ, TAIL2_END = POOL2_BEG;
constexpr int POOL2_END = 49152 - 1024 * SIDE_JG;
constexpr int POOL3_BEG = 36864, POOL3_END = POOL3_BEG + 8192, TAIL_Q3 = POOL3_END, TAIL3_END = TAIL_Q3 + 640 * SIDE_JQ3;
static_assert(TAIL2_END <= POOL2_END && TAIL3_END <= 49152, "tail side work exceeds the items");
__device__ __forceinline__ void moe_item_copy_nt(const Params& p, int layer, int it, int lane, f32x4 (&v)[8], bool store) {
    const float* W; int N, k0, nlog0; bf16_t* WT; moe_item_addr(p, layer, it, W, N, WT, k0, nlog0);
    const int g = lane >> 3, nq = lane & 7;
    if (!store) {
#pragma unroll
        for (int j = 0; j < 8; ++j) v[j] = __builtin_nontemporal_load((const f32x4*)(W + (size_t)(k0 + 8 * g + j) * N + nlog0 + 4 * nq));
    } else {
#pragma unroll
        for (int i = 0; i < 4; ++i) { v4u o; o.x = pg8::cvt_pk_bf16(v[0][i], v[1][i]); o.y = pg8::cvt_pk_bf16(v[2][i], v[3][i]); o.z = pg8::cvt_pk_bf16(v[4][i], v[5][i]); o.w = pg8::cvt_pk_bf16(v[6][i], v[7][i]);
            __builtin_nontemporal_store(o, (v4u*)(WT + (size_t)(4 * nq + i) * 1024 + k0 + 8 * g)); }
    }
}
__device__ __forceinline__ void side_tail(const Params& p, int layer, int base, int slot, int nslots, int J) {
    const int lane = otid() & 63, wave = otid() >> 6;
#pragma unroll 1
    for (int j = 0; j < J; j += 2) {
        f32x4 v0[8], v1[8];
        const int it0 = base + slot * 8 + wave + nslots * 8 * j, it1 = it0 + nslots * 8;
        moe_item_copy_nt(p, layer, it0, lane, v0, false); moe_item_copy_nt(p, layer, it1, lane, v1, false);
        moe_item_copy_nt(p, layer, it0, lane, v0, true); moe_item_copy_nt(p, layer, it1, lane, v1, true);
    }
}
constexpr int SIDE_JU = 12;
__device__ __forceinline__ int moe_tiles(const int* cnt) { int t = 0;
#pragma unroll
    for (int e = 0; e < 32; ++e) t += (cnt[e] + 255) >> 8;
    return t; }
__device__ __forceinline__ void side_range(const Params& p, int layer, int beg, int end, int first, int stride) {
    const int lane = otid() & 63;
#pragma unroll 1
    for (int it0 = beg + first; it0 < end; it0 += 2 * stride) {
        f32x4 v0[8], v1[8]; const int it1 = it0 + stride; const bool two = it1 < end;
        moe_item_copy_nt(p, layer, it0, lane, v0, false); if (two) moe_item_copy_nt(p, layer, it1, lane, v1, false);
        moe_item_copy_nt(p, layer, it0, lane, v0, true); if (two) moe_item_copy_nt(p, layer, it1, lane, v1, true);
    }
}
struct PoolRanges { int rem_up, ns_up, beg_up, end_up, rem_dn, ns_dn, end_dn, pool_end; };
__device__ __forceinline__ PoolRanges pool_ranges(const Params& p, int L) {
    const int T = moe_tiles((const int*)(p.ws + ws::CTL) + ws::CW_CNT + L * 32);
    PoolRanges r; r.rem_up = (8 * T) & 255; r.ns_up = r.rem_up ? 256 - r.rem_up : 0; r.rem_dn = T & 63; r.ns_dn = r.rem_dn ? (64 - r.rem_dn) * 4 : 0;
    r.beg_up = L == 0 ? POOL1_BEG : (L == 1 ? POOL2_BEG : POOL3_BEG); r.pool_end = L == 0 ? 49152 : (L == 1 ? POOL2_END : POOL3_END);
    r.end_up = min(r.beg_up + r.ns_up * 8 * SIDE_JU, r.pool_end); r.end_dn = min(r.end_up + r.ns_dn * 8 * SIDE_JU, r.pool_end);
    return r;
}
__device__ __forceinline__ void moe_up_tail(const Params& p, int L, int bid) {
    const PoolRanges r = pool_ranges(p, L);
    if (r.ns_up && bid >= r.rem_up) side_range(p, L + 1, r.beg_up, r.end_up, (bid - r.rem_up) * 8 + (otid() >> 6), r.ns_up * 8);
}
__device__ __forceinline__ void moe_down_tail(const Params& p, int L, int bid) {
    const PoolRanges r = pool_ranges(p, L); const int j = bid >> 3, tl = (bid & 7) * 8 + (j >> 2);
    if (r.ns_dn && tl >= r.rem_dn) side_range(p, L + 1, r.end_up, r.end_dn, ((tl - r.rem_dn) * 4 + (j & 3)) * 8 + (otid() >> 6), r.ns_dn * 8);
}
__device__ __forceinline__ void moe_pool_finish(const Params& p, int L, int bid, int nb) {
    const PoolRanges r = pool_ranges(p, L);
    side_range(p, L + 1, r.end_dn, r.pool_end, bid * 8 + (otid() >> 6), nb * 8);
}
__device__ __forceinline__ void prologue_moe_weights(const Params& p, LAS unsigned char* lds, int bid, int nb) {
    const int lane = otid() & 63, wave = otid() >> 6;
    LAS float* scr = (LAS float*)(lds + wave * 16384);
    const int gw = bid * 8 + wave, NGW = nb * 8;
    const float* w_up = p.in[25]; const float* w_dn = p.in[27];
    bf16_t* WTU = (bf16_t*)(p.ws + ws::WT_UP); bf16_t* WTD = (bf16_t*)(p.ws + ws::WT_DN);
    const int NL = nb == 256 ? 1 : 2;
    const int IU = NL * 32 * 1024, ID = NL * 32 * 512;
    for (int it = gw; it < IU + ID; it += NGW) {
        if (it < IU) { const int mi = it >> 10, r = it & 1023, kb = r >> 6, nbk = r & 63, n0 = nbk * 32;
            transpose_item(w_up + (size_t)mi * 1024 * 2048, 2048, WTU + ((size_t)mi * 2048 + n0) * 1024, kb * 64, upmap(n0), scr, lane); }
        else { const int j = it - IU, mi = j >> 9, r = j & 511, kb = r >> 5, nbk = r & 31, n0 = nbk * 32;
            transpose_item(w_dn + (size_t)mi * 1024 * 1024, 1024, WTD + ((size_t)mi * 1024 + n0) * 1024, kb * 64, n0, scr, lane); }
    }
    const int t2s = nb == 256 ? 49152 : 18432, t3s = nb == 256 ? TAIL3_END : 36864;
    const int T2 = 49152 - t2s, T3 = 49152 - t3s;
    for (int q = gw; q < T2 + T3; q += NGW) { const int layer = q < T2 ? 2 : 3, it = q < T2 ? t2s + q : t3s + q - T2;
        f32x4 v[8]; moe_item_load(p, layer, it, lane, v); moe_item_store(p, layer, it, lane, v); }
}

constexpr int TAB_TPRE = 0, TAB_OFFP = 64, TAB_UNIT = 128, TAB_CNT = 192, TAB_LX = 224;
__device__ __forceinline__ void moe_tables(const int* cnt, LAS int* tab, int ntn = 0, int c = 0, int G = 1) {
    __syncthreads();
    const int tid = otid();
    if (tid == 0) { int t = 0; for (int e = 0; e < 32; ++e) { tab[TAB_TPRE + e] = t; tab[TAB_OFFP + e] = t * 256; tab[TAB_CNT + e] = cnt[e]; t += (cnt[e] + 255) >> 8; } tab[TAB_TPRE + 32] = t; tab[TAB_OFFP + 32] = t * 256; }
    __syncthreads();
    if (ntn > 0 && tid < 32) {
        const int total = tab[TAB_TPRE + 32] * ntn; int v = -1;
        int Lx = tid * G + c;
        if (ntn == 4 && G == 256) { const int x = c & 7, j = c >> 3; Lx = (tid * 64 + x * 8 + (j >> 2)) * 4 + (j & 3); }
        if (Lx < total) { const int tile = Lx / ntn, pn = Lx % ntn; int e = 0; for (int k = 1; k < 32; ++k) e += (tab[TAB_TPRE + k] <= tile) ? 1 : 0; v = (e << 24) | ((tile - tab[TAB_TPRE + e]) << 8) | pn; }
        tab[TAB_UNIT + tid] = v; tab[TAB_LX + tid] = Lx;
    }
    __syncthreads();
}
template <bool UP> struct MoeOrder {
    const LAS int* tab; const char* A; const char* Bt; const int* list;
    static constexpr int NTN = UP ? 8 : 4;
    __device__ __forceinline__ void init(const LAS int* tab_, const void* A_, const void* Bt_, const int* list_ = nullptr) { tab = tab_; A = (const char*)A_; Bt = (const char*)Bt_; list = list_; }
    __device__ __forceinline__ const char* abase() const { return A; }
    __device__ __forceinline__ int row_index(const pg8::Unit& u, int r) const { const int pos = u.mt * 256 + r; return pos < u.cnt ? list[u.e * CAP + pos] : 0; }
    __device__ __forceinline__ bool next(int i, pg8::Unit& u) const {
        if (i >= 32) return false;
        const int v = __builtin_amdgcn_readfirstlane(tab[TAB_UNIT + i]); if (v < 0) return false;
        const int e = v >> 24, mt = (v >> 8) & 0xffff, pn = v & 0xff;
        const int offp = __builtin_amdgcn_readfirstlane(tab[TAB_OFFP + e]);
        u.e = e; u.mt = mt; u.pn = pn; u.pm = offp + mt * 256; u.cnt = __builtin_amdgcn_readfirstlane(tab[TAB_CNT + e]); u.lx = __builtin_amdgcn_readfirstlane(tab[TAB_LX + i]);
        const size_t arow = UP ? (size_t)e * CAP + (size_t)mt * 256 : (size_t)(offp + mt * 256);
        u.a = A + arow * 2048;
        u.b = Bt + ((size_t)e * (NTN * 256) + (size_t)pn * 256) * 2048;
        return true;
    }
    __device__ __forceinline__ void a_ready(const pg8::Unit&) const {}
    __device__ __forceinline__ void done(const pg8::Unit&) const {}
};
struct EpiMoeUp {
    static constexpr bool PERM = true, AFTER_DRAIN = false;
    bf16_t* ACT; const float* b_up;
    const Params* sp; int side_layer;
    __device__ __forceinline__ void operator()(const pg8::f32x4 (&acc)[2][2][4][2], const pg8::Unit& u, int wr, int wc, int fr, int fq) const {
        const bool side = side_layer >= 0 && u.lx < 2304; const int sit = u.lx * 8 + wr * 4 + wc, slane = fq * 16 + fr;
        f32x4 sv[8];
        if (side) moe_item_load(*sp, side_layer, sit, slane, sv);
        const int colj = u.pn * 128 + wc * 32 + 8 * fq;
        const float* bg = b_up + u.e * 2048 + colj;
        f32x4 bgv[2], blv[2];
#pragma unroll
        for (int n = 0; n < 2; ++n) { bgv[n] = *(const f32x4*)(bg + 4 * n); blv[n] = *(const f32x4*)(bg + 1024 + 4 * n); }
#pragma unroll
        for (int ai = 0; ai < 2; ++ai)
#pragma unroll
            for (int m = 0; m < 4; ++m) {
                const int row = u.pm + ai * 128 + wr * 64 + m * 16 + fr;
                float a[8];
#pragma unroll
                for (int n = 0; n < 2; ++n)
#pragma unroll
                    for (int j = 0; j < 4; ++j) {
                        const float g = fminf(acc[ai][0][m][n][j] + bgv[n][j], 7.f);
                        const float l = fminf(fmaxf(acc[ai][1][m][n][j] + blv[n][j], -7.f), 7.f);
                        const float sg = __builtin_amdgcn_rcpf(1.f + __builtin_amdgcn_exp2f(-1.702f * 1.4426950408889634f * g));
                        a[n * 4 + j] = g * sg * (l + 1.f);
                    }
                pg8::u32x4 w; w.x = pg8::cvt_pk_bf16(a[0], a[1]); w.y = pg8::cvt_pk_bf16(a[2], a[3]); w.z = pg8::cvt_pk_bf16(a[4], a[5]); w.w = pg8::cvt_pk_bf16(a[6], a[7]);
                *(pg8::u32x4*)(ACT + (size_t)row * 1024 + colj) = w;
            }
        if (side) moe_item_store(*sp, side_layer, sit, slane, sv);
    }
};
struct EpiMoeDown {
    static constexpr bool PERM = true, AFTER_DRAIN = false;
    bf16_t* YS; const float* b_down;
    const Params* sp; int side_layer;
    __device__ __forceinline__ void operator()(const pg8::f32x4 (&acc)[2][2][4][2], const pg8::Unit& u, int wr, int wc, int fr, int fq) const {
        const bool side = side_layer >= 0 && u.lx < 1152; const int sit = 18432 + u.lx * 8 + wr * 4 + wc, slane = fq * 16 + fr;
        f32x4 sv[8];
        if (side) moe_item_load(*sp, side_layer, sit, slane, sv);
        const int col0 = u.pn * 256 + wc * 32 + 8 * fq;
        f32x4 bv[2][2];
#pragma unroll
        for (int bj = 0; bj < 2; ++bj)
#pragma unroll
            for (int n = 0; n < 2; ++n) bv[bj][n] = *(const f32x4*)(b_down + u.e * 1024 + col0 + bj * 128 + 4 * n);
#pragma unroll
        for (int ai = 0; ai < 2; ++ai)
#pragma unroll
            for (int m = 0; m < 4; ++m) {
                bf16_t* rowp = YS + (size_t)(u.pm + ai * 128 + wr * 64 + m * 16 + fr) * 1024 + col0;
#pragma unroll
                for (int bj = 0; bj < 2; ++bj) {
                    const f32x4 v0 = acc[ai][bj][m][0] + bv[bj][0], v1 = acc[ai][bj][m][1] + bv[bj][1];
                    pg8::u32x4 w; w.x = pg8::cvt_pk_bf16(v0[0], v0[1]); w.y = pg8::cvt_pk_bf16(v0[2], v0[3]); w.z = pg8::cvt_pk_bf16(v1[0], v1[1]); w.w = pg8::cvt_pk_bf16(v1[2], v1[3]);
                    *(pg8::u32x4*)(rowp + bj * 128) = w;
                }
            }
        if (side) moe_item_store(*sp, side_layer, sit, slane, sv);
    }
};
__device__ __forceinline__ void moe_up_phase(const Params& p, int layer, LAS unsigned char* lds, int bid, int nb) {
    const int* cnt = (const int*)(p.ws + ws::CTL) + ws::CW_CNT + layer * 32;
    LAS int* tab = (LAS int*)(lds + LDS_MISC);
    moe_tables(cnt, tab, 8, bid, nb);
    MoeOrder<true> S; S.init(tab, p.ws + ws::HB, (const bf16_t*)(p.ws + ws::WT_UP) + (size_t)layer * 32 * 2048 * 1024, (const int*)(p.ws + ws::LIST));
    EpiMoeUp E; E.ACT = (bf16_t*)(p.ws + ws::ACTB); E.b_up = p.in[26] + (size_t)layer * 32 * 2048; E.sp = &p; E.side_layer = -1;
    pg8::gemm_phase<EpiMoeUp, MoeOrder<true>, true, true, true>(lds, 1024, S, E);
    if (nb == 256 && layer < 3) moe_up_tail(p, layer, bid);
}
__device__ __forceinline__ void moe_down_phase(const Params& p, int layer, LAS unsigned char* lds, int bid, int nb) {
    const int* cnt = (const int*)(p.ws + ws::CTL) + ws::CW_CNT + layer * 32;
    LAS int* tab = (LAS int*)(lds + LDS_MISC);
    moe_tables(cnt, tab, 4, bid, nb);
    MoeOrder<false> S; S.init(tab, p.ws + ws::ACTB, (const bf16_t*)(p.ws + ws::WT_DN) + (size_t)layer * 32 * 1024 * 1024);
    EpiMoeDown E; E.YS = (bf16_t*)(p.ws + ws::YSB); E.b_down = p.in[28] + (size_t)layer * 32 * 1024; E.sp = &p; E.side_layer = -1;
    pg8::gemm_phase<EpiMoeDown, MoeOrder<false>, true, true>(lds, 1024, S, E);
    if (nb == 256 && layer < 3) moe_down_tail(p, layer, bid);
}

extern __shared__ __attribute__((aligned(16))) unsigned char dyn_lds[];

constexpr float QSCALE = 0.125f * 1.4426950408889634f;
__device__ __forceinline__ int qkvmap(int n0) { const int p = n0 & 255; return (n0 >> 8) * 256 + ((p & 127) >> 5) * 64 + (p >> 7) * 32; }

__device__ __forceinline__ void prologue_dense_weights(const Params& p, LAS unsigned char* lds, int bid, int nb) {
    const int lane = otid() & 63, wave = otid() >> 6;
    LAS float* scr = (LAS float*)(lds + wave * 16384);
    const int gw = bid * 8 + wave, NGW = nb * 8;
    bf16_t* WQ = (bf16_t*)(p.ws + ws::WT_QKV); bf16_t* WO = (bf16_t*)(p.ws + ws::WT_O); bf16_t* WG = (bf16_t*)(p.ws + ws::WT_GIN);
    constexpr int IQ = 16 * 48, IO = 16 * 32, IG = 16 * 128;
    for (int it = gw; it < 3 * IQ + 4 * IO + IG; it += NGW) {
        int r = it;
        if (r < 3 * IQ) { const int mi = r / IQ, q = r % IQ, kb = q / 48, n0 = (q % 48) * 32;
            const float* W = mi == 1 ? p.in[13] : p.in[8] + (size_t)(mi == 2 ? 1 : 0) * 1024 * 1536;
            transpose_item(W, 1536, WQ + ((size_t)mi * 1536 + n0) * 1024, kb * 64, qkvmap(n0), scr, lane); continue; }
        r -= 3 * IQ;
        if (r < 4 * IO) { const int mi = r / IO, q = r % IO, kb = q / 32, n0 = (q % 32) * 32;
            const float* W = mi == 0 ? p.in[11] : mi == 1 ? p.in[16] : mi == 2 ? p.in[22] : p.in[11] + (size_t)1024 * 1024;
            transpose_item(W, 1024, WO + ((size_t)mi * 1024 + n0) * 1024, kb * 64, n0, scr, lane); continue; }
        r -= 4 * IO;
        { const int kb = r / 128, n0 = (r % 128) * 32; transpose_item(p.in[17], 4128, WG + (size_t)n0 * 1024, kb * 64, n0, scr, lane); }
    }
}

struct DenseOrder {
    const char* A; const char* Bt; int nN, c, G, total; bool latent_only;
    __device__ __forceinline__ void init(const void* A_, const void* Bt_, int nM, int nN_, int c_, int G_, bool latent_only_ = false) { A = (const char*)A_; Bt = (const char*)Bt_; nN = nN_; c = c_; G = G_; latent_only = latent_only_; total = (latent_only_ ? 64 : nM) * nN_; }
    __device__ __forceinline__ bool next(int i, pg8::Unit& u) const {
        const int Lx = i * G + c; if (Lx >= total) return false;
        const int grp = Lx / (8 * nN), r = Lx % (8 * nN);
        const int j = grp * 8 + (r & 7); u.pm = latent_only ? (j >> 3) * 9 + 1 + (j & 7) : j; u.pn = r >> 3; u.e = 0; u.mt = 0; u.cnt = 0; u.lx = Lx;
        u.a = A + (size_t)u.pm * 256 * 2048; u.b = Bt + (size_t)u.pn * 256 * 2048;
        return true;
    }
    __device__ __forceinline__ const char* abase() const { return A; }
    __device__ __forceinline__ int row_index(const pg8::Unit&, int) const { return 0; }
    __device__ __forceinline__ void a_ready(const pg8::Unit&) const {}
    __device__ __forceinline__ void done(const pg8::Unit&) const {}
};

struct EpiQKV {
    static constexpr bool PERM = true, AFTER_DRAIN = false;
    bf16_t* Q; bf16_t* Kb; bf16_t* Vb; const float* bias; const float* gq; const float* gk; const LAS float* rtab;
    __device__ __forceinline__ void operator()(const pg8::f32x4 (&acc)[2][2][4][2], const pg8::Unit& u, int wr, int wc, int fr, int fq) const {
        const int kind = u.pn < 4 ? 0 : (u.pn == 4 ? 1 : 2);
        const bool latent = (u.pm % 9) != 0;
        const int lcol = u.pn * 256 + wc * 64 + 8 * fq;
        f32x4 bv[2][2], gv[2][2];
#pragma unroll
        for (int bj = 0; bj < 2; ++bj)
#pragma unroll
            for (int n = 0; n < 2; ++n) {
                bv[bj][n] = bias ? *(const f32x4*)(bias + lcol + bj * 32 + 4 * n) : (f32x4){0.f, 0.f, 0.f, 0.f};
                const float* g = kind == 0 ? gq : gk;
                gv[bj][n] = (g && kind < 2) ? *(const f32x4*)(g + 8 * fq + bj * 32 + 4 * n) : (f32x4){1.f, 1.f, 1.f, 1.f};
            }
        const bool donorm = (gq != nullptr) && kind < 2;
        const bool dorope = latent && kind < 2;
        const int second = fq >> 1, fbase = 8 * (fq & 1);
        bf16_t* base = kind == 0 ? Q : (kind == 1 ? Kb : Vb);
        const int opitch = kind == 0 ? 1024 : 256;
        const int ocol = (kind == 0 ? u.pn * 256 : 0) + wc * 64 + 8 * fq;
#pragma unroll
        for (int ai = 0; ai < 2; ++ai)
#pragma unroll
            for (int m = 0; m < 4; ++m) {
                const int row = u.pm * 256 + ai * 128 + wr * 64 + m * 16 + fr;
                f32x4 x[2][2];
#pragma unroll
                for (int bj = 0; bj < 2; ++bj)
#pragma unroll
                    for (int n = 0; n < 2; ++n) x[bj][n] = acc[ai][bj][m][n] + bv[bj][n];
                if (donorm) {
                    float ss = 0.f;
#pragma unroll
                    for (int bj = 0; bj < 2; ++bj)
#pragma unroll
                        for (int n = 0; n < 2; ++n) ss += (x[bj][n][0] * x[bj][n][0] + x[bj][n][1] * x[bj][n][1]) + (x[bj][n][2] * x[bj][n][2] + x[bj][n][3] * x[bj][n][3]);
                    ss += __shfl_xor(ss, 16); ss += __shfl_xor(ss, 32);
                    const float rs = rsqrtf(ss * (1.f / 64.f) + EPS);
#pragma unroll
                    for (int bj = 0; bj < 2; ++bj)
#pragma unroll
                        for (int n = 0; n < 2; ++n) x[bj][n] = x[bj][n] * rs * gv[bj][n];
                }
                if (dorope) {
                    const int l = row % T - C;
                    const LAS float* tp[2] = {rtab + (l >> 6) * 32 + fbase, rtab + 32 * 32 + (l & 63) * 32 + fbase};
#pragma unroll
                    for (int bj = 0; bj < 2; ++bj)
#pragma unroll
                        for (int n = 0; n < 2; ++n) {
                            const f32x4 cs = *(const LAS f32x4*)(tp[bj] + 4 * n), sn = *(const LAS f32x4*)(tp[bj] + 16 + 4 * n);
                            f32x4 o;
#pragma unroll
                            for (int j = 0; j < 4; ++j) { const float other = __shfl_xor(x[bj][n][j], 32); o[j] = second ? (x[bj][n][j] * cs[j] + other * sn[j]) : (x[bj][n][j] * cs[j] - other * sn[j]); }
                            x[bj][n] = o;
                        }
                }
                const float sc = kind == 0 ? QSCALE : 1.f;
                bf16_t* rowp = base + (size_t)row * opitch + ocol;
#pragma unroll
                for (int bj = 0; bj < 2; ++bj) {
                    const f32x4 v0 = x[bj][0] * sc, v1 = x[bj][1] * sc;
                    pg8::u32x4 w; w.x = pg8::cvt_pk_bf16(v0[0], v0[1]); w.y = pg8::cvt_pk_bf16(v0[2], v0[3]); w.z = pg8::cvt_pk_bf16(v1[0], v1[1]); w.w = pg8::cvt_pk_bf16(v1[2], v1[3]);
                    *(pg8::u32x4*)(rowp + bj * 32) = w;
                }
            }
    }
};
struct EpiPlainBf16 {
    static constexpr bool PERM = true, AFTER_DRAIN = false;
    bf16_t* O; int ldc;
    __device__ __forceinline__ void operator()(const pg8::f32x4 (&acc)[2][2][4][2], const pg8::Unit& u, int wr, int wc, int fr, int fq) const {
        const int col0 = u.pn * 256 + wc * 32 + 8 * fq;
#pragma unroll
        for (int ai = 0; ai < 2; ++ai)
#pragma unroll
            for (int m = 0; m < 4; ++m) { bf16_t* rowp = O + (size_t)(u.pm * 256 + ai * 128 + wr * 64 + m * 16 + fr) * ldc + col0;
#pragma unroll
                for (int bj = 0; bj < 2; ++bj) { const f32x4 v0 = acc[ai][bj][m][0], v1 = acc[ai][bj][m][1];
                    pg8::u32x4 w; w.x = pg8::cvt_pk_bf16(v0[0], v0[1]); w.y = pg8::cvt_pk_bf16(v0[2], v0[3]); w.z = pg8::cvt_pk_bf16(v1[0], v1[1]); w.w = pg8::cvt_pk_bf16(v1[2], v1[3]);
                    *(pg8::u32x4*)(rowp + bj * 128) = w; } }
    }
};
struct EpiResid {
    static constexpr bool PERM = true, AFTER_DRAIN = false;
    bf16_t* X; const float* bias; const float* gate;
    float* ssq;
    int rowoff = 0, nai = 2;
    __device__ __forceinline__ void operator()(const pg8::f32x4 (&acc)[2][2][4][2], const pg8::Unit& u, int wr, int wc, int fr, int fq) const {
        const int col0 = u.pn * 256 + wc * 32 + 8 * fq;
        const int cr = (u.pm % 9) == 0 ? 8 : u.pm / 9;
        f32x4 bv[2][2], gv[2][2];
#pragma unroll
        for (int bj = 0; bj < 2; ++bj)
#pragma unroll
            for (int n = 0; n < 2; ++n) { const int c = col0 + bj * 128 + 4 * n;
                bv[bj][n] = bias ? *(const f32x4*)(bias + c) : (f32x4){0.f, 0.f, 0.f, 0.f}; gv[bj][n] = *(const f32x4*)(gate + (size_t)cr * 6144 + c); }
#pragma unroll
        for (int ai = 0; ai < 2; ++ai) if (ai < nai)
#pragma unroll
            for (int m = 0; m < 4; ++m) { const size_t row = (size_t)(u.pm * 256 + rowoff + ai * 128 + wr * 64 + m * 16 + fr); bf16_t* rowp = X + row * 1024 + col0; float sq = 0.f;
#pragma unroll
                for (int bj = 0; bj < 2; ++bj) { pg8::u32x4* ptr = (pg8::u32x4*)(rowp + bj * 128); const pg8::u32x4 xo = *ptr;
                    const f32x4 v0 = gv[bj][0] * (acc[ai][bj][m][0] + bv[bj][0]), v1 = gv[bj][1] * (acc[ai][bj][m][1] + bv[bj][1]);
                    pg8::u32x4 w;
                    w.x = pg8::cvt_pk_bf16(bf2f(xo.x & 0xffffu) + v0[0], bf2f(xo.x >> 16) + v0[1]); w.y = pg8::cvt_pk_bf16(bf2f(xo.y & 0xffffu) + v0[2], bf2f(xo.y >> 16) + v0[3]);
                    w.z = pg8::cvt_pk_bf16(bf2f(xo.z & 0xffffu) + v1[0], bf2f(xo.z >> 16) + v1[1]); w.w = pg8::cvt_pk_bf16(bf2f(xo.w & 0xffffu) + v1[2], bf2f(xo.w >> 16) + v1[3]);
                    *ptr = w;
                    { const float r0 = bf2f(w.x & 0xffffu), r1 = bf2f(w.x >> 16), r2 = bf2f(w.y & 0xffffu), r3 = bf2f(w.y >> 16), r4 = bf2f(w.z & 0xffffu), r5 = bf2f(w.z >> 16), r6 = bf2f(w.w & 0xffffu), r7 = bf2f(w.w >> 16);
                      sq += (r0 * r0 + r1 * r1) + (r2 * r2 + r3 * r3) + (r4 * r4 + r5 * r5) + (r6 * r6 + r7 * r7); } }
                sq += __shfl_xor(sq, 16); sq += __shfl_xor(sq, 32);
                if (fq == 0) ssq[row * 16 + u.pn * 4 + wc] = sq; }
    }
};
__device__ __forceinline__ int qkv_slot(int layer) { return layer == 0 ? 0 : (layer == 1 ? 1 : 2); }
constexpr int LDS_ROPE = LDS_MISC + 4096;
__device__ __forceinline__ void qkv_phase(const Params& p, int layer, LAS unsigned char* lds, int bid, int nb) {
    LAS float* rtab = (LAS float*)(lds + LDS_ROPE);
    __syncthreads();
    for (int i = otid(); i < 96 * 32; i += NTHR) {
        const int rr = i >> 5, j = i & 31, f = j & 15, l = rr < 32 ? rr * 64 : rr - 32, axis = rr < 32 ? 0 : 1;
        const float* rope = (const float*)(p.ws + ws::ROPE);
        rtab[i] = rope[(j < 16 ? 0 : L * 32) + l * 32 + axis * 16 + f];
    }
    __syncthreads();
    DenseOrder S; S.init(p.ws + ws::HB, (const bf16_t*)(p.ws + ws::WT_QKV) + (size_t)qkv_slot(layer) * 1536 * 1024, 72, 6, bid, nb);
    EpiQKV E; E.Q = (bf16_t*)(p.ws + ws::QB); E.Kb = (bf16_t*)(p.ws + ws::KB); E.Vb = (bf16_t*)(p.ws + ws::VB); E.rtab = rtab;
    if (layer == 1) { E.bias = nullptr; E.gq = p.in[14]; E.gk = p.in[15]; } else { E.bias = p.in[9] + (layer == 3 ? 1536 : 0); E.gq = nullptr; E.gk = nullptr; }
    pg8::gemm_phase<EpiQKV, DenseOrder, true, true>(lds, 1024, S, E);
    if (nb == 256 && bid >= 176) side_tail(p, layer == 0 ? 1 : (layer == 1 ? 2 : 3), layer == 0 ? TAIL_Q0 : (layer == 1 ? TAIL_Q1 : TAIL_Q3), bid - 176, 80, layer < 2 ? SIDE_JQ : SIDE_JQ3);
}
__device__ __forceinline__ void gin_phase(const Params& p, LAS unsigned char* lds, int bid, int nb) {
    DenseOrder S; S.init(p.ws + ws::HB, p.ws + ws::WT_GIN, 72, 16, bid, nb);
    EpiPlainBf16 E; E.O = (bf16_t*)(p.ws + ws::PB); E.ldc = 4096;
    pg8::gemm_phase<EpiPlainBf16, DenseOrder, true, true>(lds, 1024, S, E);
    if (nb == 256 && bid >= 128) side_tail(p, 2, POOL2_END, bid - 128, 128, SIDE_JG);
}
struct OneUnit {
    const char* A; const char* Bt; int pm, pn, rowoff;
    __device__ __forceinline__ bool next(int i, pg8::Unit& u) const { if (i > 0) return false; u.pm = pm; u.pn = pn; u.e = 0; u.mt = 0; u.cnt = 0; u.lx = 0; u.a = A + ((size_t)pm * 256 + rowoff) * 2048; u.b = Bt + (size_t)pn * 256 * 2048; return true; }
    __device__ __forceinline__ const char* abase() const { return A; }
    __device__ __forceinline__ int row_index(const pg8::Unit&, int) const { return 0; }
    __device__ __forceinline__ void a_ready(const pg8::Unit&) const {}
    __device__ __forceinline__ void done(const pg8::Unit&) const {}
};
__device__ __forceinline__ void oproj_ctx_unit(const Params& p, int layer, LAS unsigned char* lds, int b, int pn, int half) {
    OneUnit S; S.A = (const char*)(p.ws + ws::OBF); S.Bt = (const char*)((const bf16_t*)(p.ws + ws::WT_O) + (size_t)layer * 1024 * 1024); S.pm = 9 * b; S.pn = pn; S.rowoff = 128 * half;
    EpiResid E; E.X = (bf16_t*)(p.ws + ws::X); E.ssq = (float*)(p.ws + ws::SSQ); E.bias = layer == 0 ? p.in[12] : (layer == 3 ? p.in[12] + 1024 : nullptr);
    E.gate = (const float*)(p.ws + ws::MODS) + (size_t)layer * 9 * 6144 + 2 * 1024; E.rowoff = 128 * half; E.nai = 1;
    pg8::gemm_phase<EpiResid, OneUnit, true, true, false, true>(lds, 1024, S, E);
}
__device__ __forceinline__ void oproj_phase(const Params& p, int layer, LAS unsigned char* lds, int bid, int nb) {
    DenseOrder S; S.init(p.ws + ws::OBF, (const bf16_t*)(p.ws + ws::WT_O) + (size_t)layer * 1024 * 1024, 72, 4, bid, nb, layer == 3 || nb == 256);
    EpiResid E; E.X = (bf16_t*)(p.ws + ws::X); E.ssq = (float*)(p.ws + ws::SSQ); E.bias = layer == 0 ? p.in[12] : (layer == 3 ? p.in[12] + 1024 : nullptr);
    E.gate = (const float*)(p.ws + ws::MODS) + (size_t)layer * 9 * 6144 + 2 * 1024;
    pg8::gemm_phase<EpiResid, DenseOrder, true, true>(lds, 1024, S, E);
}

#include <hip/hip_bf16.h>
#include <cmath>
namespace attn_body {
using bf16=__hip_bfloat16;
using bf16x8=__attribute__((ext_vector_type(8)))short;
using s16x4=__attribute__((ext_vector_type(4)))short;
using f32x16=__attribute__((ext_vector_type(16)))float;
using u32x4=__attribute__((ext_vector_type(4)))unsigned;
constexpr int D=64,DM=1024,KVP=256;
constexpr int NW=8,QBLK=32,KVBLK=64;
__device__ __forceinline__ int crow(int r,int hi){return (r&3)+8*(r>>2)+4*hi;}
#define SBAR() __builtin_amdgcn_sched_barrier(0)
__device__ __forceinline__ void wmask(f32x16&p0,f32x16&p1,int kv0,int qi,int hi){
  const float NEG=-INFINITY; const int dlt=kv0+4*hi-qi;
  #pragma unroll
  for(int r=0;r<16;++r){const int d0=dlt+(r&3)+8*(r>>2); if(d0>128||d0<-128)p0[r]=NEG; if(d0+32>128||d0+32<-128)p1[r]=NEG;}
}

constexpr int NSLOT=3, SLOTB=8192;
constexpr int LDS_K=0, LDS_V=NSLOT*SLOTB, LDS_WS=2*NSLOT*SLOTB, LDS_OST=LDS_WS+NW*64*4, LDS_BYTES=LDS_OST+NW*4096;
constexpr float C2=0.125f*1.4426950408889634f;
__device__ __forceinline__ void glds16(const void*gsrc,unsigned lds_dst){unsigned keep;
  asm volatile("s_mov_b32 %0, m0\n\ts_mov_b32 m0, %2\n\ts_nop 0\n\tglobal_load_lds_dwordx4 %1, off\n\ts_mov_b32 m0, %0":"=&s"(keep):"v"(gsrc),"s"(lds_dst):"memory");}
__device__ __forceinline__ float max3f(float a,float b,float c){float r;asm("v_max3_f32 %0, %1, %2, %3":"=v"(r):"v"(a),"v"(b),"v"(c));return r;}
__device__ __forceinline__ float max2f(float a,float b){float r;asm("v_max_f32_e32 %0, %1, %2":"=v"(r):"v"(a),"v"(b));return r;}
__device__ __forceinline__ float fadd_s(float a,float b){float r;asm("v_add_f32_e32 %0, %1, %2":"=v"(r):"v"(a),"v"(b));return r;}
__device__ __forceinline__ float fsub_s(float a,float b){float r;asm("v_sub_f32_e32 %0, %1, %2":"=v"(r):"v"(a),"v"(b));return r;}
typedef float f32x2_t __attribute__((ext_vector_type(2))); typedef __bf16 bf16x2_t __attribute__((ext_vector_type(2)));
__device__ __forceinline__ unsigned cvtpk_s(float lo,float hi){f32x2_t v={lo,hi};bf16x2_t b=__builtin_convertvector(v,bf16x2_t);return __builtin_bit_cast(unsigned,b);}
#define WAIT_BAR(N) asm volatile("s_waitcnt vmcnt(" #N ") lgkmcnt(0)\n\ts_barrier":::"memory")

__device__ __forceinline__ void qkt(f32x16&p0,f32x16&p1,const char*Kslot,const bf16x8*qr,const f32x16&negm,int r32,int hi){
  const char*kb=Kslot+hi*1024+r32*16;
  #pragma unroll
  for(int d0=0;d0<4;++d0){
    const bf16x8 b0=*reinterpret_cast<const bf16x8*>(kb+d0*2048);
    const bf16x8 b1=*reinterpret_cast<const bf16x8*>(kb+d0*2048+512);
    if(d0==0){p0=__builtin_amdgcn_mfma_f32_32x32x16_bf16(b0,qr[0],negm,0,0,0);p1=__builtin_amdgcn_mfma_f32_32x32x16_bf16(b1,qr[0],negm,0,0,0);}
    else{p0=__builtin_amdgcn_mfma_f32_32x32x16_bf16(b0,qr[d0],p0,0,0,0);p1=__builtin_amdgcn_mfma_f32_32x32x16_bf16(b1,qr[d0],p1,0,0,0);}}
}
typedef __attribute__((address_space(3))) const char* lds_cptr;
typedef short v4i16_t __attribute__((ext_vector_type(4)));
__device__ __forceinline__ void kload8(bf16x8*kf,lds_cptr kp){
  kf[0]=*(const __attribute__((address_space(3))) bf16x8*)(kp);      kf[1]=*(const __attribute__((address_space(3))) bf16x8*)(kp+512);
  kf[2]=*(const __attribute__((address_space(3))) bf16x8*)(kp+2048); kf[3]=*(const __attribute__((address_space(3))) bf16x8*)(kp+2560);
  kf[4]=*(const __attribute__((address_space(3))) bf16x8*)(kp+4096); kf[5]=*(const __attribute__((address_space(3))) bf16x8*)(kp+4608);
  kf[6]=*(const __attribute__((address_space(3))) bf16x8*)(kp+6144); kf[7]=*(const __attribute__((address_space(3))) bf16x8*)(kp+6656);
}
__device__ __forceinline__ void kload2(bf16x8*kf,lds_cptr kp,int j){ kf[2*j]=*(const __attribute__((address_space(3))) bf16x8*)(kp+j*2048); kf[2*j+1]=*(const __attribute__((address_space(3))) bf16x8*)(kp+j*2048+512); }
__device__ __forceinline__ s16x4 vtr(lds_cptr p){ return __builtin_bit_cast(s16x4,__builtin_amdgcn_ds_read_tr16_b64_v4i16((__attribute__((address_space(3))) v4i16_t*)p)); }
__device__ __forceinline__ float rowmax(const f32x16&p0,const f32x16&p1){
  float a=max3f(p0[0],p0[1],p1[0]),b=max3f(p0[2],p0[3],p1[1]);a=max3f(a,p1[2],p1[3]);
  #pragma unroll
  for(int r=4;r<16;r+=4){a=max3f(a,p0[r],p0[r+1]);b=max3f(b,p0[r+2],p0[r+3]);a=max3f(a,p1[r],p1[r+1]);b=max3f(b,p1[r+2],p1[r+3]);}
  const float m=max2f(a,b);
  auto rr=__builtin_amdgcn_permlane32_swap(__float_as_uint(m),__float_as_uint(m),false,false);
  return max2f(__uint_as_float(rr[0]),__uint_as_float(rr[1]));
}
__device__ __forceinline__ void pv(f32x16*o,int vb,bf16x8 pa0,bf16x8 pa1,bf16x8 pa2,bf16x8 pa3){
  #pragma unroll
  for(int d0=0;d0<2;++d0){s16x4 lo[4],hi[4];
    #pragma unroll
    for(int ks=0;ks<4;++ks){
      asm volatile("ds_read_b64_tr_b16 %0,%1 offset:%c2":"=&v"(lo[ks]):"v"(vb),"i"(d0*4096+ks*1024):"memory");
      asm volatile("ds_read_b64_tr_b16 %0,%1 offset:%c2":"=&v"(hi[ks]):"v"(vb),"i"(d0*4096+ks*1024+512):"memory");}
    asm volatile("s_waitcnt lgkmcnt(0)":::"memory");SBAR();
    #define PK(k) (bf16x8){lo[k][0],lo[k][1],lo[k][2],lo[k][3],hi[k][0],hi[k][1],hi[k][2],hi[k][3]}
    o[d0]=__builtin_amdgcn_mfma_f32_32x32x16_bf16(pa0,PK(0),o[d0],0,0,0);
    o[d0]=__builtin_amdgcn_mfma_f32_32x32x16_bf16(pa1,PK(1),o[d0],0,0,0);
    o[d0]=__builtin_amdgcn_mfma_f32_32x32x16_bf16(pa2,PK(2),o[d0],0,0,0);
    o[d0]=__builtin_amdgcn_mfma_f32_32x32x16_bf16(pa3,PK(3),o[d0],0,0,0);
    #undef PK
  }
}

#ifndef ATTN_STORE16
#define ATTN_STORE16(p,v) (*(u32x4*)(p)=(v))
#endif
template<int THRL> __device__ __forceinline__ void attn_unit(long qrow,int h0,int kvh,long krow,int j0,int NT,bool win,int i0,const float*sink,const bf16*Q,const bf16*__restrict__ K,const bf16*__restrict__ V,bf16*O,char*shm){
  int tid=otid();
  const int lane=tid&63,r32=lane&31,hi=lane>>5; const int wid=__builtin_amdgcn_readfirstlane(tid>>6);
  const int hh=h0+(wid>>2);
  const bf16*Qw=Q+(qrow+(wid&3)*QBLK)*DM+hh*D;
  const bf16*Kh=K+krow*KVP+kvh*D,*Vh=V+krow*KVP+kvh*D;
  const unsigned lds0=(unsigned)(uintptr_t)shm;
  float*wsf=(float*)(shm+LDS_WS)+wid*64;
  const bf16*ksrc=Kh+(long)lane*KVP+wid*8;
  const bf16*vsrc=Vh+(long)(16*(wid&3)+(lane>>2))*KVP+(wid>>2)*32+(lane&3)*8;
  const unsigned kdst=lds0+LDS_K+wid*1024, vdst=lds0+LDS_V+wid*1024;
  #define TROW(t) ((t)<4?64*(t):256+64*(j0+(t)-4))
  #define DMA_K(t,slot) glds16(ksrc+(long)TROW(t)*KVP,(unsigned)__builtin_amdgcn_readfirstlane(kdst+(slot)))
  #define DMA_V(t,slot) glds16(vsrc+(long)TROW(t)*KVP,(unsigned)__builtin_amdgcn_readfirstlane(vdst+(slot)))
  const int vb0=(int)(lds0+LDS_V)+((lane>>4)&1)*32+(lane&3)*8+(4*hi+((lane&15)>>2))*64;
  const char*Kbase=shm+LDS_K; bf16x8 kf[8];
  const lds_cptr shm3=(lds_cptr)shm; const lds_cptr kp0=shm3+LDS_K+hi*1024+r32*16; const lds_cptr vp0=shm3+LDS_V+((lane>>4)&1)*32+(lane&3)*8+(4*hi+((lane&15)>>2))*64;
  DMA_K(0,0);DMA_V(0,0);DMA_K(1,SLOTB);
  bf16x8 qr[4];
  #pragma unroll
  for(int d0=0;d0<4;++d0)qr[d0]=*reinterpret_cast<const bf16x8*>(&Qw[(long)r32*DM+d0*16+hi*8]);
  float mhat=0.f,l_reg=0.f;f32x16 o[2];o[0]=f32x16{};o[1]=f32x16{};f32x16 negm=f32x16{};asm volatile("":"+v"(negm));
  const int qi=i0+(wid&3)*QBLK+r32;
  #define CMASK(P0,P1,t) do{ if(win&&(t)>=4)wmask(P0,P1,64*(j0+(t)-4),qi,hi); }while(0)
  bool resc=false;
  #define START(P0,P1) do{ const float rm=rowmax(P0,P1); resc=false; \
    { const float dl=rm; mhat=fadd_s(mhat,dl); \
      _Pragma("unroll") for(int r=0;r<16;++r){P0[r]=fsub_s(P0[r],dl);P1[r]=fsub_s(P1[r],dl);} \
      _Pragma("unroll") for(int r=0;r<16;++r)negm[r]=-mhat; asm volatile("":"+v"(negm)); } \
    _Pragma("unroll") for(int r=0;r<16;++r)P0[r]=__builtin_amdgcn_exp2f(P0[r]); }while(0)
  #define RESC() do{ if(resc){ asm volatile("s_waitcnt lgkmcnt(0)":::"memory"); \
      _Pragma("unroll") for(int d_=0;d_<2;++d_) _Pragma("unroll") for(int r=0;r<16;++r)o[d_][r]*=wsf[crow(r,hi)]; } }while(0)
  f32x16 pA0,pA1,pB0,pB1;
  int sl_prev=0,sl_cur=0,sl_next=SLOTB;
  #define ROT() do{sl_prev=sl_cur;sl_cur=sl_next;sl_next=(sl_next==(NSLOT-1)*SLOTB)?0:sl_next+SLOTB;}while(0)
  DMA_K(2,2*SLOTB);
  WAIT_BAR(3);
  qkt(pA0,pA1,Kbase,qr,negm,r32,hi);asm volatile("s_nop 15\n\ts_nop 7":"+v"(pA0),"+v"(pA1));CMASK(pA0,pA1,0);
  START(pA0,pA1);
  _Pragma("unroll") for(int r=0;r<16;++r)pA1[r]=__builtin_amdgcn_exp2f(pA1[r]);
  WAIT_BAR(0);
  DMA_K(3,0);DMA_V(1,SLOTB);
  ROT();
  kload8(kf,kp0+sl_cur);
  WAIT_BAR(2);
  s16x4 vlo[8],vhi[8]; u32x4 pw0,pw1,pw2,pw3;
  #define PKW(P,B) cvtpk_s(P[B],P[B+1])
  #define PAF(k) __builtin_bit_cast(bf16x8,pw##k)
  #define VFR(i) (bf16x8){vlo[i][0],vlo[i][1],vlo[i][2],vlo[i][3],vhi[i][0],vhi[i][1],vhi[i][2],vhi[i][3]}
  #define PIN(x) asm volatile("":"+v"(x))
  #define MX3(a,b,c) __builtin_fmaxf(__builtin_fmaxf((a),(b)),(c))
  #define GAPA(MF,A0,A1,A2,A3,W0,W1,PW) do{ MF; sacc+=A0; sacc+=A1; sacc+=A2; sacc+=A3; PIN(sacc); W0; W1; PIN(PW); SBAR(); }while(0)
  #define EX(v) __builtin_amdgcn_exp2f(v)
  #define GAPB(MF,X,B) do{ MF; X[B]=EX(X[B]); X[B+1]=EX(X[B+1]); X[B+2]=EX(X[B+2]); X[B+3]=EX(X[B+3]); PIN(X); SBAR(); }while(0)
  #define VRD(i) do{ vlo[i]=vtr(vp_+(((i)>>2)*4096+((i)&3)*1024)); vhi[i]=vtr(vp_+(((i)>>2)*4096+((i)&3)*1024+512)); }while(0)
  #define KRD(G,j) do{ if(G){ kload2(kf,kp0+sl_next,j); SBAR(); } }while(0)
  #define STEP(C0,C1,P0,P1,t,GK,GV,GL) do{ SBAR(); \
    const lds_cptr vp_=vp0+sl_prev; \
    VRD(0); SBAR(); float sacc=(P0[0]+P0[1]); \
    GAPA(C0=__builtin_amdgcn_mfma_f32_32x32x16_bf16(kf[0],qr[0],negm,0,0,0), P0[2],P0[3],P0[4],P0[5],     pw0[0]=PKW(P0,0), pw0[1]=PKW(P0,2), pw0); \
    VRD(4); SBAR(); GAPA(C1=__builtin_amdgcn_mfma_f32_32x32x16_bf16(kf[1],qr[0],negm,0,0,0), P0[6],P0[7],P0[8],P0[9],     pw0[2]=PKW(P0,4), pw0[3]=PKW(P0,6), pw0); \
    VRD(1); SBAR(); GAPA(C0=__builtin_amdgcn_mfma_f32_32x32x16_bf16(kf[2],qr[1],C0,0,0,0),   P0[10],P0[11],P0[12],P0[13], pw1[0]=PKW(P0,8), pw1[1]=PKW(P0,10), pw1); \
    VRD(5); SBAR(); GAPA(C1=__builtin_amdgcn_mfma_f32_32x32x16_bf16(kf[3],qr[1],C1,0,0,0),   P0[14],P0[15],P1[0],P1[1],   pw1[2]=PKW(P0,12),pw1[3]=PKW(P0,14), pw1); \
    VRD(2); SBAR(); GAPA(C0=__builtin_amdgcn_mfma_f32_32x32x16_bf16(kf[4],qr[2],C0,0,0,0),   P1[2],P1[3],P1[4],P1[5],     pw2[0]=PKW(P1,0), pw2[1]=PKW(P1,2), pw2); \
    VRD(6); SBAR(); GAPA(C1=__builtin_amdgcn_mfma_f32_32x32x16_bf16(kf[5],qr[2],C1,0,0,0),   P1[6],P1[7],P1[8],P1[9],     pw2[2]=PKW(P1,4), pw2[3]=PKW(P1,6), pw2); \
    VRD(3); SBAR(); GAPA(C0=__builtin_amdgcn_mfma_f32_32x32x16_bf16(kf[6],qr[3],C0,0,0,0),   P1[10],P1[11],P1[12],P1[13], pw3[0]=PKW(P1,8), pw3[1]=PKW(P1,10), pw3); \
    VRD(7); SBAR(); GAPA(C1=__builtin_amdgcn_mfma_f32_32x32x16_bf16(kf[7],qr[3],C1,0,0,0),   P1[14],P1[15],0.f,0.f,       pw3[2]=PKW(P1,12),pw3[3]=PKW(P1,14), pw3); \
    l_reg+=sacc; \
    if(GK){DMA_K((t)+3,sl_cur);} if(GV){DMA_V((t)+1,sl_next);} \
    CMASK(C0,C1,t); \
    { float a=MX3(C0[0],C0[1],C1[0]),b=MX3(C0[2],C0[3],C1[1]); a=MX3(a,C1[2],C1[3]); \
      _Pragma("unroll") for(int r=4;r<16;r+=4){a=MX3(a,C0[r],C0[r+1]);b=MX3(b,C0[r+2],C0[r+3]);a=MX3(a,C1[r],C1[r+1]);b=MX3(b,C1[r+2],C1[r+3]);} \
      float rm=__builtin_fmaxf(a,b); { auto rr=__builtin_amdgcn_permlane32_swap(__float_as_uint(rm),__float_as_uint(rm),false,false); rm=__builtin_fmaxf(__uint_as_float(rr[0]),__uint_as_float(rr[1])); } \
      resc=false; \
      if(__builtin_expect(__any(rm>(float)THRL),0)){ const float dl=__builtin_fmaxf(rm,0.f); mhat+=dl; \
        _Pragma("unroll") for(int r=0;r<16;++r){C0[r]-=dl;C1[r]-=dl;} \
        _Pragma("unroll") for(int r=0;r<16;++r)negm[r]=-mhat; asm volatile("":"+v"(negm)); \
        const float f=__builtin_amdgcn_exp2f(-dl); l_reg*=f; if(hi==0)wsf[r32]=f; resc=true; } } \
    SBAR(); \
    GAPB(o[0]=__builtin_amdgcn_mfma_f32_32x32x16_bf16(PAF(0),VFR(0),o[0],0,0,0), C0,0); \
    GAPB(o[1]=__builtin_amdgcn_mfma_f32_32x32x16_bf16(PAF(0),VFR(4),o[1],0,0,0), C0,4); \
    KRD(GL,0); GAPB(o[0]=__builtin_amdgcn_mfma_f32_32x32x16_bf16(PAF(1),VFR(1),o[0],0,0,0), C0,8); \
    KRD(GL,1); GAPB(o[1]=__builtin_amdgcn_mfma_f32_32x32x16_bf16(PAF(1),VFR(5),o[1],0,0,0), C0,12); \
    KRD(GL,2); GAPB(o[0]=__builtin_amdgcn_mfma_f32_32x32x16_bf16(PAF(2),VFR(2),o[0],0,0,0), C1,0); \
    KRD(GL,3); GAPB(o[1]=__builtin_amdgcn_mfma_f32_32x32x16_bf16(PAF(2),VFR(6),o[1],0,0,0), C1,4); \
    GAPB(o[0]=__builtin_amdgcn_mfma_f32_32x32x16_bf16(PAF(3),VFR(3),o[0],0,0,0), C1,8); \
    GAPB(o[1]=__builtin_amdgcn_mfma_f32_32x32x16_bf16(PAF(3),VFR(7),o[1],0,0,0), C1,12); \
    }while(0)
  int t=1;
  for(;t+5<NT;t+=2){
    STEP(pB0,pB1,pA0,pA1,t,true,true,true);     WAIT_BAR(2); RESC(); ROT();
    STEP(pA0,pA1,pB0,pB1,t+1,true,true,true);   WAIT_BAR(2); RESC(); ROT();
  }
  #define ENDW(tt) do{ if((tt)+3<NT){WAIT_BAR(2);} else if((tt)+2<NT){WAIT_BAR(1);} else {WAIT_BAR(0);} }while(0)
  for(;t+1<NT;t+=2){
    STEP(pB0,pB1,pA0,pA1,t,(t+3<NT),(t+1<NT),(t+1<NT));       ENDW(t);   RESC(); ROT();
    STEP(pA0,pA1,pB0,pB1,t+1,(t+4<NT),(t+2<NT),(t+2<NT));     ENDW(t+1); RESC(); ROT();
  }
  STEP(pB0,pB1,pA0,pA1,NT-1,false,false,false); RESC();
  { float sacc=pB0[0]+pB0[1]; _Pragma("unroll") for(int r=2;r<16;++r)sacc+=pB0[r]; _Pragma("unroll") for(int r=0;r<16;++r)sacc+=pB1[r]; l_reg+=sacc;
    pw0=(u32x4){PKW(pB0,0),PKW(pB0,2),PKW(pB0,4),PKW(pB0,6)};pw1=(u32x4){PKW(pB0,8),PKW(pB0,10),PKW(pB0,12),PKW(pB0,14)};pw2=(u32x4){PKW(pB1,0),PKW(pB1,2),PKW(pB1,4),PKW(pB1,6)};pw3=(u32x4){PKW(pB1,8),PKW(pB1,10),PKW(pB1,12),PKW(pB1,14)};
    SBAR(); pv(o,vb0+sl_cur,PAF(0),PAF(1),PAF(2),PAF(3)); }
  #undef PKW
  #undef PAF
  #undef VFR
  #undef PIN
  #undef MX3
  #undef GAPA
  #undef GAPB
  #undef EX
  #undef VRD
  #undef KRD
  #undef STEP
  #undef ENDW
  {auto rr=__builtin_amdgcn_permlane32_swap(__float_as_uint(l_reg),__float_as_uint(l_reg),false,false);l_reg=__uint_as_float(rr[0])+__uint_as_float(rr[1]);}
  if(sink)l_reg+=__builtin_amdgcn_exp2f(sink[hh]*1.4426950408889634f-mhat);
  if(hi==0)wsf[32+r32]=l_reg;asm volatile("s_waitcnt lgkmcnt(0)":::"memory");
  float rli[16];
  #pragma unroll
  for(int r=0;r<16;++r)rli[r]=__builtin_amdgcn_rcpf(wsf[32+crow(r,hi)]);
  bf16*Ow=O+(qrow+(wid&3)*QBLK)*DM+hh*D;
  { bf16*stg=(bf16*)(shm+LDS_OST)+wid*2048;
    #pragma unroll
    for(int r=0;r<16;++r){const int orow=crow(r,hi);
      #pragma unroll
      for(int d0=0;d0<2;++d0)stg[orow*64+d0*32+r32]=__float2bfloat16(o[d0][r]*rli[r]);}
    asm volatile("s_waitcnt lgkmcnt(0)":::"memory");
    #pragma unroll
    for(int i=0;i<4;++i){const int row=i*8+(lane>>3),ch=lane&7; const u32x4 v=*(const u32x4*)(stg+row*64+ch*8); ATTN_STORE16(Ow+(long)row*DM+ch*8,v);} }
  asm volatile("s_waitcnt lgkmcnt(0)\n\ts_barrier":::"memory");
  #undef DMA_K
  #undef TROW
  #undef DMA_V
  #undef CMASK
  #undef START
  #undef RESC
  #undef ROT
}
constexpr int ATTN_LDS_BYTES=LDS_BYTES;
#undef SBAR
#undef WAIT_BAR
}
__device__ __forceinline__ void attn_phase_fn(const Params& p, int layer, LAS unsigned char* lds, int bid, int nb) {
    using attn_body::bf16;
    const bf16* Q = (const bf16*)(p.ws + ws::QB); const bf16* K = (const bf16*)(p.ws + ws::KB); const bf16* V = (const bf16*)(p.ws + ws::VB); bf16* O = (bf16*)(p.ws + ws::OBF);
    const bool win = layer != 1; const bool need_ctx = layer < 3;
    const float* sink = win ? p.in[10] + (layer == 3 ? 16 : 0) : nullptr;
    char* shm = (char*)lds;
    for (int u = bid; u < 1024; u += nb) {
        const int b = u & 7, idx = u >> 3, hp = idx >> 4, qblk = idx & 15;
        const int i0 = qblk * 128;
        int j0 = 0, NT = 36;
        if (win) { const int jlo = max(0, i0 / 64 - 2), jhi = min(31, i0 / 64 + 3); j0 = jlo; NT = 4 + jhi - jlo + 1; }
        attn_body::attn_unit<8>((long)b * T + C + i0, hp * 2, hp >> 1, (long)b * T, j0, NT, win, i0, sink, Q, K, V, O, shm);
    }
    if (need_ctx) for (int u = bid; u < 128; u += nb) {
        const int b = u & 7, idx = u >> 3, hp = idx >> 1, qblk = idx & 1;
        attn_body::attn_unit<8>((long)b * T + qblk * 128, hp * 2, hp >> 1, (long)b * T, 0, 4, false, 0, sink, Q, K, V, O, shm);
    }
}

namespace gdn {
typedef short bf16x8 __attribute__((ext_vector_type(8)));
typedef short bf16x4 __attribute__((ext_vector_type(4)));
typedef float f32x4 __attribute__((ext_vector_type(4)));
typedef float f32x2_t __attribute__((ext_vector_type(2))); typedef __bf16 bf16x2_t __attribute__((ext_vector_type(2)));
__device__ __forceinline__ unsigned cvtpk(float lo, float hi) { f32x2_t v = {lo, hi}; bf16x2_t b = __builtin_convertvector(v, bf16x2_t); return __builtin_bit_cast(unsigned, b); }
__device__ __forceinline__ float bfl(unsigned u) { return __builtin_bit_cast(float, u << 16); }
__device__ __forceinline__ float bfh(unsigned u) { return __builtin_bit_cast(float, u & 0xffff0000u); }
#define MFMA16(a, b, c) __builtin_amdgcn_mfma_f32_16x16x32_bf16((a), (b), (c), 0, 0, 0)
constexpr size_t SZ_W = 16384, SZ_Q = 16384, SZ_KT = 16384, SZ_I = 8192, SZ_U = 16384, SZ_O = 16384;
constexpr size_t NSLOT = (size_t)NB * 36 * 8 * 2;
constexpr size_t OFF_W = 0, OFF_Q = OFF_W + NSLOT * SZ_W, OFF_KT = OFF_Q + NSLOT * SZ_Q, OFF_I = OFF_KT + NSLOT * SZ_KT, OFF_U = OFF_I + NSLOT * SZ_I, OFF_O = OFF_U + NSLOT * SZ_U, OFF_EG = OFF_O + NSLOT * SZ_O, OFF_END = OFF_EG + NSLOT * 4;
static_assert(OFF_END <= (size_t)NB * 36 * 8 * 2 * 90120, "GDN scratch size");
constexpr int QLS = 136, KTST = 72, FS = 65;
constexpr int O_QL = 0, O_KL = 17408, O_AT0 = 0, O_AT1 = 16640, O_KT = 34816, O_VT = 53248, O_KTS = 71680, O_KK = 90112, O_TT1 = 90112, O_QKB = 106752, O_TT0 = 106752, O_TB = 0, O_TG = 9216, O_GV = 125184;
constexpr int GV_BETA = 0, GV_GC = 128, GV_GL = 256;

__device__ __forceinline__ bf16x8 pack8(const f32x4& a, const f32x4& b) { typedef unsigned u4 __attribute__((ext_vector_type(4))); u4 p; p.x = cvtpk(a[0], a[1]); p.y = cvtpk(a[2], a[3]); p.z = cvtpk(b[0], b[1]); p.w = cvtpk(b[2], b[3]); return __builtin_bit_cast(bf16x8, p); }
__device__ __forceinline__ unsigned long long pack4(const f32x4& a) { return (unsigned long long)cvtpk(a[0], a[1]) | ((unsigned long long)cvtpk(a[2], a[3]) << 32); }
__device__ __forceinline__ bf16x8 ldperm_lds(const LAS bf16_t* p) { const bf16x4 a = *(const LAS bf16x4*)p, b = *(const LAS bf16x4*)(p + 16); return (bf16x8){a[0], a[1], a[2], a[3], b[0], b[1], b[2], b[3]}; }
__device__ __forceinline__ bf16x8 ldperm_g(const bf16_t* p) { const bf16x4 a = *(const bf16x4*)p, b = *(const bf16x4*)(p + 16); return (bf16x8){a[0], a[1], a[2], a[3], b[0], b[1], b[2], b[3]}; }

__device__ __forceinline__ void mm16f(f32x4& acc, const LAS float* pa, const LAS float* pb, int lane) {
    const int m = lane & 15, q = lane >> 4;
#pragma unroll
    for (int s = 0; s < 4; ++s) acc = __builtin_amdgcn_mfma_f32_16x16x4f32(pa[m * FS + 4 * s + q], pb[(4 * s + q) * FS + m], acc, 0, 0, 0);
}
__device__ __forceinline__ void st16f(LAS float* pd, const f32x4& v, int lane, float sgn) { const int m = lane & 15, q = lane >> 4;
#pragma unroll
    for (int r = 0; r < 4; ++r) pd[(4 * q + r) * FS + m] = sgn * v[r]; }

__device__ __forceinline__ void g3_item(const Params& p, int b, int c, int h, LAS unsigned char* lds, int side_it) {
    const int tid = otid(), lane = tid & 63, wave = __builtin_amdgcn_readfirstlane(tid >> 6);
    const bf16_t* PBp = (const bf16_t*)(p.ws + ws::PB); const float* SPp = (const float*)(p.ws + ws::SP);
    unsigned char* G = p.ws + ws::GDNS;
    const float* conv_w = p.in[18]; const float* a_log = p.in[19]; const float* dt_bias = p.in[20];
    LAS bf16_t* QL = (LAS bf16_t*)(lds + O_QL); LAS bf16_t* KL = (LAS bf16_t*)(lds + O_KL); LAS bf16_t* KT = (LAS bf16_t*)(lds + O_KT); LAS bf16_t* VT = (LAS bf16_t*)(lds + O_VT);
    LAS bf16_t* KTS = (LAS bf16_t*)(lds + O_KTS); LAS float* KK = (LAS float*)(lds + O_KK); LAS bf16_t* QKB = (LAS bf16_t*)(lds + O_QKB);
    LAS bf16_t* TB = (LAS bf16_t*)(lds + O_TB); LAS bf16_t* TG = (LAS bf16_t*)(lds + O_TG);
    LAS float* GV = (LAS float*)(lds + O_GV);
    const size_t n0 = (size_t)b * T + 64 * c;
    const int seg_lo = c < 4 ? 0 : C, seg_hi = c < 4 ? C : T;
    const size_t sl0 = (((size_t)b * 36 + c) * 8 + h) * 2;
    LDS_BARRIER();
    { PSEC_BEGIN();
    {
        const int task = tid < 256 ? tid : 256 + ((tid - 256) & 127);
        const int hb = tid < 256 ? 0 : (wave >> 1) - 2, he = tid < 256 ? 2 : hb + 1;
        const int rg = task / 48, kind = (task % 48) >> 4, cg = task & 15;
        const int ch = kind * 1024 + h * 128 + 8 * cg;
        v4u raw[12]; f32x4 w0[5], w1[5];
#pragma unroll
        for (int rr = 0; rr < 12; ++rr) { const int pp = 64 * c + 8 * rg + rr - 2;
            raw[rr] = (pp >= seg_lo && pp < seg_hi && rr >= 4 * hb && rr < 4 * he + 4) ? *(const v4u*)(PBp + ((size_t)b * T + pp) * 4096 + ch) : (v4u){0u, 0u, 0u, 0u}; }
#pragma unroll
        for (int j = 0; j < 5; ++j) { w0[j] = *(const f32x4*)(conv_w + j * 3072 + ch); w1[j] = *(const f32x4*)(conv_w + j * 3072 + ch + 4); }
#pragma unroll
        for (int half = 0; half < 2; ++half) if (half >= hb && half < he) {
            float o[4][8];
#pragma unroll
            for (int r = 0; r < 4; ++r) {
#pragma unroll
                for (int e = 0; e < 8; ++e) o[r][e] = 0.f;
#pragma unroll
                for (int j = 0; j < 5; ++j) { const v4u x = raw[4 * half + r + j]; const unsigned xs[4] = {x.x, x.y, x.z, x.w};
#pragma unroll
                    for (int e2 = 0; e2 < 4; ++e2) { const float wa = e2 < 2 ? w0[j][2 * e2] : w1[j][2 * e2 - 4], wb = e2 < 2 ? w0[j][2 * e2 + 1] : w1[j][2 * e2 - 3];
                        o[r][2 * e2] += bfl(xs[e2]) * wa; o[r][2 * e2 + 1] += bfh(xs[e2]) * wb; } }
                float ss = 0.f;
#pragma unroll
                for (int e = 0; e < 8; ++e) { const float v = o[r][e]; o[r][e] = v * __builtin_amdgcn_rcpf(1.f + __expf(-v)); ss += o[r][e] * o[r][e]; }
                ss += __shfl_xor(ss, 1); ss += __shfl_xor(ss, 2); ss += __shfl_xor(ss, 4); ss += __shfl_xor(ss, 8);
                if (kind < 2) { const float rs = rsqrtf(ss + EPS) * (kind == 0 ? 0.08838834764831845f : 1.f);
#pragma unroll
                    for (int e = 0; e < 8; ++e) o[r][e] *= rs; }
            }
            if (kind < 2) { LAS bf16_t* dst = kind == 0 ? QL : KL;
#pragma unroll
                for (int r = 0; r < 4; ++r) { v4u w; w.x = cvtpk(o[r][0], o[r][1]); w.y = cvtpk(o[r][2], o[r][3]); w.z = cvtpk(o[r][4], o[r][5]); w.w = cvtpk(o[r][6], o[r][7]);
                    *(LAS v4u*)(dst + (8 * rg + 4 * half + r) * QLS + 8 * cg) = w; } }
            if (kind >= 1) { LAS bf16_t* dst = kind == 1 ? KT : VT;
#pragma unroll
                for (int e = 0; e < 8; ++e) { const unsigned long long w = (unsigned long long)cvtpk(o[0][e], o[1][e]) | ((unsigned long long)cvtpk(o[2][e], o[3][e]) << 32);
                    *(LAS unsigned long long*)(dst + (8 * cg + e) * KTST + 8 * rg + 4 * half) = w; } }
        }
    }
    if (tid >= 384) {
        const int i = lane;
        { const int d = wave & 1;
            const float bl = SPp[(n0 + i) * 32 + d * 8 + h];
            const float a = SPp[(n0 + i) * 32 + 16 + d * 8 + h] + dt_bias[d * 8 + h];
            const float sp = a > 15.f ? a : __logf(1.f + __expf(a));
            float g = -__expf(a_log[d * 8 + h]) * sp;
#pragma unroll
            for (int o = 1; o < 64; o <<= 1) { const float t = d == 0 ? __shfl_up(g, o) : __shfl_down(g, o); if (d == 0 ? (i >= o) : (i + o < 64)) g += t; }
            GV[GV_BETA + d * 64 + i] = 1.f / (1.f + __expf(-bl)); GV[GV_GC + d * 64 + i] = g;
            if (d == 0 ? (i == 63) : (i == 0)) GV[GV_GL + d] = g;
        }
    }
    LDS_BARRIER();
    PSEC_END(1, lds, tid); }
    f32x4 sv[8];
    if (side_it >= 0) moe_item_load(p, 2, side_it * 8 + wave, lane, sv);
    { PSEC_BEGIN();
    {
        const int which = wave >> 2, rb = wave & 3, m = lane & 15, q = lane >> 4;
        const LAS bf16_t* Ab = (which ? QL : KL) + (16 * rb + m) * QLS + 8 * q;
        bf16x8 af[4];
#pragma unroll
        for (int s = 0; s < 4; ++s) af[s] = *(const LAS bf16x8*)(Ab + 32 * s);
#pragma unroll
        for (int cb = 0; cb < 4; ++cb) {
            f32x4 acc = {0.f, 0.f, 0.f, 0.f};
#pragma unroll
            for (int s = 0; s < 4; ++s) acc = MFMA16(af[s], *(const LAS bf16x8*)(KL + (16 * cb + m) * QLS + 8 * q + 32 * s), acc);
#pragma unroll
            for (int r = 0; r < 4; ++r) { const int i = 16 * rb + 4 * q + r, j = 16 * cb + m;
                if (which == 0) KK[i * FS + j] = acc[r]; else QKB[i * KTST + j] = (bf16_t)(cvtpk(acc[r], 0.f) & 0xffffu); }
        }
    }
    LDS_BARRIER();
    PSEC_END(2, lds, tid); }
    { PSEC_BEGIN();
#pragma unroll
    for (int it = 0; it < 4; ++it) { const int idx = tid + 512 * it, d = idx >> 10, i = (idx >> 4) & 63, ck = idx & 15;
        const float sc = __expf(GV[GV_GC + d * 64 + i]);
        const v4u x = *(const LAS v4u*)(QL + i * QLS + 8 * ck); v4u w;
        w.x = cvtpk(bfl(x.x) * sc, bfh(x.x) * sc); w.y = cvtpk(bfl(x.y) * sc, bfh(x.y) * sc); w.z = cvtpk(bfl(x.z) * sc, bfh(x.z) * sc); w.w = cvtpk(bfl(x.w) * sc, bfh(x.w) * sc);
        *(v4u*)(G + OFF_Q + (sl0 + d) * SZ_Q + ((size_t)i * 128 + 8 * ck) * 2) = w; }
#pragma unroll
    for (int it = 0; it < 2; ++it) { const int idx = tid + 512 * it, d = idx >> 9, i = (idx >> 3) & 63, ck = idx & 7;
        const float gi = GV[GV_GC + d * 64 + i];
        const v4u x = *(const LAS v4u*)(QKB + i * KTST + 8 * ck); const unsigned xs[4] = {x.x, x.y, x.z, x.w}; unsigned ws_[4];
#pragma unroll
        for (int e2 = 0; e2 < 4; ++e2) { const int j0 = 8 * ck + 2 * e2, j1 = j0 + 1;
            const bool k0 = d == 0 ? (j0 <= i) : (j0 >= i), k1 = d == 0 ? (j1 <= i) : (j1 >= i);
            const float v0 = k0 ? bfl(xs[e2]) * __expf(gi - GV[GV_GC + d * 64 + j0]) : 0.f, v1 = k1 ? bfh(xs[e2]) * __expf(gi - GV[GV_GC + d * 64 + j1]) : 0.f;
            ws_[e2] = cvtpk(v0, v1); }
        *(v4u*)(G + OFF_I + (sl0 + d) * SZ_I + ((size_t)i * 64 + 8 * ck) * 2) = (v4u){ws_[0], ws_[1], ws_[2], ws_[3]}; }
    LDS_BARRIER();
    PSEC_END(3, lds, tid); }
    { PSEC_BEGIN();
#pragma unroll
    for (int d = 0; d < 2; ++d) { LAS float* AT = (LAS float*)(lds + (d ? O_AT1 : O_AT0));
#pragma unroll
        for (int e = 0; e < 8; ++e) { const int idx = tid * 8 + e, it = idx >> 6, jt = idx & 63, ip = d ? 63 - it : it, jp = d ? 63 - jt : jt;
            float v = 0.f;
            if (jt < it) v = GV[GV_BETA + d * 64 + ip] * KK[ip * FS + jp] * __expf(GV[GV_GC + d * 64 + ip] - GV[GV_GC + d * 64 + jp]);
            AT[it * FS + jt] = v; } }
    LDS_BARRIER();
    PSEC_END(4, lds, tid); }
    { PSEC_BEGIN();
    {
        const int sd = wave < 4 ? (wave & 1) : 1 - (wave & 1), sw = wave < 4 ? (wave >> 1) : 3 - ((wave - 4) >> 1);
        LAS float* AT = (LAS float*)(lds + (sd ? O_AT1 : O_AT0)); LAS float* TT = (LAS float*)(lds + (sd ? O_TT1 : O_TT0));
        if (sw == 0) { const int g = lane >> 4, cc = lane & 15; const LAS float* ab = AT + (16 * g) * FS + 16 * g;
            float t[16];
#pragma unroll
            for (int r = 0; r < 16; ++r) { float acc = (r == cc) ? 1.f : 0.f;
#pragma unroll
                for (int j = 0; j < 16; ++j) if (j < r) acc -= ab[r * FS + j] * t[j];
                t[r] = acc; }
#pragma unroll
            for (int r = 0; r < 16; ++r) TT[(16 * g + r) * FS + 16 * g + cc] = t[r]; }
        LDS_BARRIER();
        if (sw < 3) { const int bi = sw + 1, bj = sw; f32x4 x = {0.f, 0.f, 0.f, 0.f};
            mm16f(x, AT + (16 * bi) * FS + 16 * bj, TT + (16 * bj) * FS + 16 * bj, lane);
            st16f(TT + (16 * bi) * FS + 16 * bj, x, lane, 1.f); LDS_WAIT();
            f32x4 y = {0.f, 0.f, 0.f, 0.f}; mm16f(y, TT + (16 * bi) * FS + 16 * bi, TT + (16 * bi) * FS + 16 * bj, lane);
            st16f(TT + (16 * bi) * FS + 16 * bj, y, lane, -1.f); }
        LDS_BARRIER();
        if (sw < 2) { const int bi = sw + 2, bj = sw; f32x4 x = {0.f, 0.f, 0.f, 0.f};
            mm16f(x, AT + (16 * bi) * FS + 16 * bj, TT + (16 * bj) * FS + 16 * bj, lane);
            mm16f(x, AT + (16 * bi) * FS + 16 * (bj + 1), TT + (16 * (bj + 1)) * FS + 16 * bj, lane);
            st16f(TT + (16 * bi) * FS + 16 * bj, x, lane, 1.f); LDS_WAIT();
            f32x4 y = {0.f, 0.f, 0.f, 0.f}; mm16f(y, TT + (16 * bi) * FS + 16 * bi, TT + (16 * bi) * FS + 16 * bj, lane);
            st16f(TT + (16 * bi) * FS + 16 * bj, y, lane, -1.f); }
        LDS_BARRIER();
        if (sw == 0) { f32x4 x = {0.f, 0.f, 0.f, 0.f};
            mm16f(x, AT + 48 * FS + 0, TT + 0, lane); mm16f(x, AT + 48 * FS + 16, TT + 16 * FS, lane); mm16f(x, AT + 48 * FS + 32, TT + 32 * FS, lane);
            st16f(TT + 48 * FS, x, lane, 1.f); LDS_WAIT();
            f32x4 y = {0.f, 0.f, 0.f, 0.f}; mm16f(y, TT + 48 * FS + 48, TT + 48 * FS, lane);
            st16f(TT + 48 * FS, y, lane, -1.f); }
        LDS_BARRIER();
    }
    PSEC_END(5, lds, tid); }
    for (int d = 0; d < 2; ++d) {
        const float gl = GV[GV_GL + d];
        const LAS float* TT = (const LAS float*)(lds + (d ? O_TT1 : O_TT0));
        { PSEC_BEGIN();
#pragma unroll
        for (int e = 0; e < 8; e += 2) { const int idx = tid * 8 + e, i = idx >> 6, j = idx & 63;
            const int ti = d ? 63 - i : i, tj0 = d ? 63 - j : j, tj1 = d ? 62 - j : j + 1;
            const float t0 = tj0 <= ti ? TT[ti * FS + tj0] : 0.f, t1 = tj1 <= ti ? TT[ti * FS + tj1] : 0.f;
            const float b0 = GV[GV_BETA + d * 64 + j], b1 = GV[GV_BETA + d * 64 + j + 1];
            const float e0 = __expf(GV[GV_GC + d * 64 + j]), e1 = __expf(GV[GV_GC + d * 64 + j + 1]);
            *(LAS unsigned*)(TB + i * KTST + j) = cvtpk(t0 * b0, t1 * b1); *(LAS unsigned*)(TG + i * KTST + j) = cvtpk(t0 * b0 * e0, t1 * b1 * e1); }
#pragma unroll
        for (int it = 0; it < 2; ++it) { const int idx = tid + 512 * it, a = idx >> 3, ck = idx & 7;
            const v4u x = *(const LAS v4u*)(KT + a * KTST + 8 * ck); const unsigned xs[4] = {x.x, x.y, x.z, x.w}; unsigned w4[4];
#pragma unroll
            for (int e2 = 0; e2 < 4; ++e2) { const int i0 = 8 * ck + 2 * e2; w4[e2] = cvtpk(bfl(xs[e2]) * __expf(gl - GV[GV_GC + d * 64 + i0]), bfh(xs[e2]) * __expf(gl - GV[GV_GC + d * 64 + i0 + 1])); }
            *(LAS v4u*)(KTS + a * KTST + 8 * ck) = (v4u){w4[0], w4[1], w4[2], w4[3]}; }
        LDS_BARRIER();
        PSEC_END(6, lds, tid); }
        { PSEC_BEGIN();
        {
            const int w = wave, m = lane & 15, q = lane >> 4;
            const size_t sl = sl0 + d;
            bf16x8 bv[2], bk[2];
#pragma unroll
            for (int s = 0; s < 2; ++s) { bv[s] = *(const LAS bf16x8*)(VT + (16 * w + m) * KTST + 32 * s + 8 * q); bk[s] = *(const LAS bf16x8*)(KT + (16 * w + m) * KTST + 32 * s + 8 * q); }
#pragma unroll
            for (int rb = 0; rb < 4; ++rb) { f32x4 U = {0.f, 0.f, 0.f, 0.f}, wt = {0.f, 0.f, 0.f, 0.f};
#pragma unroll
                for (int s = 0; s < 2; ++s) { U = MFMA16(*(const LAS bf16x8*)(TB + (16 * rb + m) * KTST + 32 * s + 8 * q), bv[s], U);
                    wt = MFMA16(bk[s], *(const LAS bf16x8*)(TG + (16 * rb + m) * KTST + 32 * s + 8 * q), wt); }
                *(unsigned long long*)(G + OFF_U + sl * SZ_U + ((size_t)(16 * w + m) * 64 + 16 * rb + 4 * q) * 2) = pack4(U);
                *(unsigned long long*)(G + OFF_W + sl * SZ_W + ((size_t)(16 * rb + m) * 128 + 16 * w + 4 * q) * 2) = pack4(wt);
            }
#pragma unroll
            for (int it = 0; it < 2; ++it) { const int idx = tid + 512 * it, a_ = idx >> 3, ck = idx & 7;
                *(v4u*)(G + OFF_KT + sl * SZ_KT + ((size_t)a_ * 64 + 8 * ck) * 2) = *(const LAS v4u*)(KTS + a_ * KTST + 8 * ck); }
            if (tid == 0) *(float*)(G + OFF_EG + sl * 4) = __expf(gl);
        }
        LDS_BARRIER();
        PSEC_END(7, lds, tid); }
    }
    if (side_it >= 0) moe_item_store(p, 2, side_it * 8 + wave, lane, sv);
}

constexpr int G4_SLOT = 57344;
__device__ __forceinline__ bf16x8 ldperm_sw256(const LAS unsigned char* base, int row, int s, int q) {
    const int c0 = 4 * s + (q >> 1), half = (q & 1) * 8;
    const bf16x4 a = *(const LAS bf16x4*)(base + row * 256 + ((c0 ^ (row & 15)) << 4) + half), b = *(const LAS bf16x4*)(base + row * 256 + (((c0 + 2) ^ (row & 15)) << 4) + half);
    return (bf16x8){a[0], a[1], a[2], a[3], b[0], b[1], b[2], b[3]};
}
__device__ __forceinline__ bf16x8 ldperm_sw128(const LAS unsigned char* base, int row, int s, int q) {
    const int c0 = 4 * s + (q >> 1), half = (q & 1) * 8, f = (row >> 1) & 7;
    const bf16x4 a = *(const LAS bf16x4*)(base + row * 128 + ((c0 ^ f) << 4) + half), b = *(const LAS bf16x4*)(base + row * 128 + (((c0 + 2) ^ f) << 4) + half);
    return (bf16x8){a[0], a[1], a[2], a[3], b[0], b[1], b[2], b[3]};
}
__device__ __forceinline__ void g4_block(const Params& p, int ch, int half_, LAS unsigned char* lds, int tid, int unit, bool side) {
    unsigned char* G = p.ws + ws::GDNS;
    const int lane = tid & 63, wave = __builtin_amdgcn_readfirstlane(tid >> 6);
    const int b = ch >> 4, h = (ch >> 1) & 7, d = ch & 1, m = lane & 15, q = lane >> 4;
    const bool loader = wave >= 4;
    const int cb = half_ * 4 + (wave & 3);
    f32x4 S[8];
#pragma unroll
    for (int ab = 0; ab < 8; ++ab) S[ab] = (f32x4){0.f, 0.f, 0.f, 0.f};
    auto slot_of = [&](int step) -> size_t { const int c = d == 0 ? step : (step < 4 ? 3 - step : 39 - step); return (((size_t)b * 36 + c) * 8 + h) * 2 + d; };
    auto issue = [&](int step, int slot, bool warm) {
        const size_t sl = slot_of(step); const int lw = wave - 4;
        int ln = lane; asm volatile("" : "+v"(ln));
#pragma unroll
        for (int r = 0; r < 16; ++r) {
            const int t = (r & 3) * 256 + lw * 64 + ln;
            const unsigned char* src;
            if (r < 8) { const int row = t >> 4, cc = (t & 15) ^ (row & 15); src = G + (r < 4 ? OFF_W + sl * SZ_W : OFF_Q + sl * SZ_Q) + (size_t)row * 256 + cc * 16; }
            else if (r < 14) { const int row = t >> 3, cc = (t & 7) ^ ((row >> 1) & 7); src = G + (r < 12 ? OFF_KT + sl * SZ_KT : OFF_I + sl * SZ_I) + (size_t)row * 128 + cc * 16; }
            else { const int t2 = (r - 14) * 256 + lw * 64 + ln, row = t2 >> 3, cc = (t2 & 7) ^ ((row >> 1) & 7); src = G + OFF_U + sl * SZ_U + (size_t)(64 * half_ + row) * 128 + cc * 16; }
            const int ldsoff = r < 14 ? slot * G4_SLOT + (r < 4 ? 0 : r < 8 ? 16384 : r < 12 ? 32768 : 49152) + ((r & 3) * 256 + lw * 64) * 16 : 2 * G4_SLOT + slot * 8192 + ((r - 14) * 256 + lw * 64) * 16;
            __builtin_amdgcn_global_load_lds((const unsigned*)src, (LAS unsigned*)(lds + ldsoff), 16, 0, 0);
        }
    };
    int oA[4], oB[4], pA[2], pB[2], uo[4];
    { const int m_ = lane & 15, q_ = lane >> 4, qh = q_ >> 1, hf = (q_ & 1) * 8, f_ = (m_ >> 1) & 7;
#pragma unroll
      for (int rb = 0; rb < 4; ++rb) uo[rb] = (16 * (wave & 3) + m_) * 128 + hf + (((2 * rb + qh) ^ f_) << 4);
#pragma unroll
      for (int s = 0; s < 4; ++s) { oA[s] = m_ * 256 + hf + (((4 * s + qh) ^ m_) << 4); oB[s] = m_ * 256 + hf + (((4 * s + qh + 2) ^ m_) << 4); }
#pragma unroll
      for (int s = 0; s < 2; ++s) { pA[s] = m_ * 128 + hf + (((4 * s + qh) ^ f_) << 4); pB[s] = m_ * 128 + hf + (((4 * s + qh + 2) ^ f_) << 4); } }
    auto ld2 = [&](const LAS unsigned char* base, int offa, int offb) -> bf16x8 { const bf16x4 a = *(const LAS bf16x4*)(base + offa), b = *(const LAS bf16x4*)(base + offb); return (bf16x8){a[0], a[1], a[2], a[3], b[0], b[1], b[2], b[3]}; };
    f32x4 sva[8];
#pragma unroll
    for (int j = 0; j < 8; ++j) sva[j] = (f32x4){0.f, 0.f, 0.f, 0.f};
    LAS float* eglds = (LAS float*)(lds + LDS_MISC + 1664);
    auto fetch_egl = [&](int step, int slot) { if (wave == 4 && lane == 0) eglds[slot] = *(const float*)(G + OFF_EG + slot_of(step) * 4); };
    __syncthreads();
    if (loader) { issue(0, 0, false); fetch_egl(0, 0); if (side) moe_item_load(p, 3, unit * 4 + (wave - 4), lane, sva); asm volatile("s_waitcnt vmcnt(0)" ::: "memory"); }
    __syncthreads();
    for (int step = 0; step < 36; ++step) {
        const int slot = step & 1;
        if (loader) {
            PSEC_BEGIN();
            const int glw = unit * 4 + (wave - 4);
            float egl_n = 0.f;
            if (step + 1 < 36) { issue(step + 1, slot ^ 1, false); if (wave == 4 && lane == 0) egl_n = *(const float*)(G + OFF_EG + slot_of(step + 1) * 4); }
            asm volatile("s_waitcnt vmcnt(0)" ::: "memory");
            PSEC_END(9, lds, tid - 256);
            if (step + 1 < 36 && wave == 4 && lane == 0) eglds[slot ^ 1] = egl_n;
            if (side) { moe_item_store(p, 3, glw + 1024 * step, lane, sva); if (step + 1 < 36) moe_item_load(p, 3, glw + 1024 * (step + 1), lane, sva); }
            asm volatile("s_waitcnt lgkmcnt(0)" ::: "memory");
            PSEC_END(10, lds, tid - 256);
        }
        else {
            PSEC_BEGIN();
            const int m = lane & 15, q = lane >> 4;
            const size_t sl = slot_of(step);
            const LAS unsigned char* LW = lds + slot * G4_SLOT; const LAS unsigned char* LQ = LW + 16384; const LAS unsigned char* LK = LW + 32768; const LAS unsigned char* LI = LW + 49152;
            const LAS unsigned char* LU = lds + 2 * G4_SLOT + slot * 8192;
            uint2 uv[4];
#pragma unroll
            for (int rb = 0; rb < 4; ++rb) { const unsigned long long t_ = *(const LAS unsigned long long*)(LU + uo[rb]); uv[rb].x = (unsigned)t_; uv[rb].y = (unsigned)(t_ >> 32); }
            const float egl = eglds[slot];
#define G4_SCHED() __builtin_amdgcn_sched_barrier(0)
            bf16x8 fw[2][4], fq[2][4], fi[8], fk[2][8];
#pragma unroll
            for (int s = 0; s < 4; ++s) { fw[0][s] = ld2(LW, oA[s], oB[s]); fq[0][s] = ld2(LQ, oA[s], oB[s]); }
            bf16x8 PS[4];
#pragma unroll
            for (int s = 0; s < 4; ++s) PS[s] = pack8(S[2 * s], S[2 * s + 1]);
            f32x4 o[4], vn[4];
#pragma unroll
            for (int rb = 0; rb < 4; ++rb) { const int cur = rb & 1, nxt = cur ^ 1;
                if (rb < 3) {
#pragma unroll
                    for (int s = 0; s < 4; ++s) { fw[nxt][s] = ld2(LW + (rb + 1) * 4096, oA[s], oB[s]); fq[nxt][s] = ld2(LQ + (rb + 1) * 4096, oA[s], oB[s]); } }
                else {
#pragma unroll
                    for (int r2 = 0; r2 < 4; ++r2)
#pragma unroll
                        for (int s = 0; s < 2; ++s) fi[2 * r2 + s] = ld2(LI + r2 * 2048, pA[s], pB[s]); }
                G4_SCHED();
                f32x4 t1 = {0.f, 0.f, 0.f, 0.f}; o[rb] = (f32x4){0.f, 0.f, 0.f, 0.f};
#pragma unroll
                for (int s = 0; s < 4; ++s) { t1 = MFMA16(fw[cur][s], PS[s], t1); o[rb] = MFMA16(fq[cur][s], PS[s], o[rb]); }
                vn[rb] = (f32x4){bfl(uv[rb].x) - t1[0], bfh(uv[rb].x) - t1[1], bfl(uv[rb].y) - t1[2], bfh(uv[rb].y) - t1[3]};
                G4_SCHED(); }
#pragma unroll
            for (int ab = 0; ab < 4; ++ab)
#pragma unroll
                for (int s = 0; s < 2; ++s) fk[0][2 * ab + s] = ld2(LK + ab * 2048, pA[s], pB[s]);
            bf16x8 PV[2];
#pragma unroll
            for (int s = 0; s < 2; ++s) PV[s] = pack8(vn[2 * s], vn[2 * s + 1]);
            G4_SCHED();
#pragma unroll
            for (int rb = 0; rb < 4; ++rb) {
#pragma unroll
                for (int s = 0; s < 2; ++s) o[rb] = MFMA16(fi[2 * rb + s], PV[s], o[rb]);
                *(unsigned long long*)(G + OFF_O + sl * SZ_O + ((size_t)(16 * cb + m) * 64 + 16 * rb + 4 * q) * 2) = pack4(o[rb]); }
#pragma unroll
            for (int ab = 0; ab < 4; ++ab)
#pragma unroll
                for (int s = 0; s < 2; ++s) fk[1][2 * ab + s] = ld2(LK + (4 + ab) * 2048, pA[s], pB[s]);
            G4_SCHED();
#pragma unroll
            for (int ab = 0; ab < 4; ++ab) { S[ab] = S[ab] * egl;
#pragma unroll
                for (int s = 0; s < 2; ++s) S[ab] = MFMA16(fk[0][2 * ab + s], PV[s], S[ab]); }
            G4_SCHED();
#pragma unroll
            for (int ab = 0; ab < 4; ++ab) { S[4 + ab] = S[4 + ab] * egl;
#pragma unroll
                for (int s = 0; s < 2; ++s) S[4 + ab] = MFMA16(fk[1][2 * ab + s], PV[s], S[4 + ab]); }
#undef G4_SCHED
            asm volatile("s_waitcnt lgkmcnt(0)" ::: "memory");
            PSEC_END(8, lds, tid);
        }
        asm volatile("" ::: "memory"); __builtin_amdgcn_s_barrier(); asm volatile("" ::: "memory");
    }
    asm volatile("s_waitcnt vmcnt(0)" ::: "memory");
    __syncthreads();
}

__device__ __forceinline__ void g5_item(const Params& p, int b, int c, int h, LAS unsigned char* lds, int tid) {
    unsigned char* G = p.ws + ws::GDNS;
    const bf16_t* PBp = (const bf16_t*)(p.ws + ws::PB); bf16_t* Op = (bf16_t*)(p.ws + ws::OBF);
    const float* g_out = p.in[21];
    LAS float* Tt = (LAS float*)lds;
    const size_t n0 = (size_t)b * T + 64 * c;
    const size_t sl0 = (((size_t)b * 36 + c) * 8 + h) * 2;
    LDS_BARRIER();
#pragma unroll
    for (int it = 0; it < 2; ++it) { const int idx = tid + 512 * it, dv = idx >> 3, ck = idx & 7;
        const v4u a = *(const v4u*)(G + OFF_O + sl0 * SZ_O + ((size_t)dv * 64 + 8 * ck) * 2), bb = *(const v4u*)(G + OFF_O + (sl0 + 1) * SZ_O + ((size_t)dv * 64 + 8 * ck) * 2);
        const unsigned as[4] = {a.x, a.y, a.z, a.w}, bs[4] = {bb.x, bb.y, bb.z, bb.w};
#pragma unroll
        for (int e2 = 0; e2 < 4; ++e2) { Tt[dv * 65 + 8 * ck + 2 * e2] = bfl(as[e2]) + bfl(bs[e2]); Tt[dv * 65 + 8 * ck + 2 * e2 + 1] = bfh(as[e2]) + bfh(bs[e2]); } }
    LDS_BARRIER();
    { const int i = tid >> 3, dc = tid & 7;
        float o[16]; float ss = 0.f;
#pragma unroll
        for (int e = 0; e < 16; ++e) { o[e] = Tt[(16 * dc + e) * 65 + i]; ss += o[e] * o[e]; }
        ss += __shfl_xor(ss, 1); ss += __shfl_xor(ss, 2); ss += __shfl_xor(ss, 4);
        const float rs = rsqrtf(ss * (1.f / 128.f) + EPS);
        const bf16_t* zp = PBp + (n0 + i) * 4096 + 3072 + h * 128 + 16 * dc;
        const v4u z0 = *(const v4u*)zp, z1 = *(const v4u*)(zp + 8); const unsigned zs[8] = {z0.x, z0.y, z0.z, z0.w, z1.x, z1.y, z1.z, z1.w};
        unsigned w8[8];
#pragma unroll
        for (int e2 = 0; e2 < 8; ++e2) { const float za = bfl(zs[e2]), zb = bfh(zs[e2]);
            const float va = o[2 * e2] * rs * g_out[16 * dc + 2 * e2] * (za * __builtin_amdgcn_rcpf(1.f + __expf(-za)));
            const float vb = o[2 * e2 + 1] * rs * g_out[16 * dc + 2 * e2 + 1] * (zb * __builtin_amdgcn_rcpf(1.f + __expf(-zb)));
            w8[e2] = cvtpk(va, vb); }
        bf16_t* op = Op + (n0 + i) * 1024 + h * 128 + 16 * dc;
        *(v4u*)op = (v4u){w8[0], w8[1], w8[2], w8[3]}; *(v4u*)(op + 8) = (v4u){w8[4], w8[5], w8[6], w8[7]}; }
}
}

__device__ __forceinline__ void gdn_g3_phase(const Params& p, LAS unsigned char* lds, int bid, int nb) {
    for (int it = bid; it < NB * 36 * 8; it += nb) { const int h = it & 7, bc = it >> 3; gdn::g3_item(p, bc / 36, bc % 36, h, lds, it); }
}
__device__ __forceinline__ void gdn_g4_phase(const Params& p, LAS unsigned char* lds, int bid, int nb) {
    const int tid = otid();
    for (int u = bid; u < 256; u += nb) gdn::g4_block(p, (u >> 4) * 8 + (u & 7), (u >> 3) & 1, lds, tid, u, true);
}
__device__ __forceinline__ void gdn_g5_phase(const Params& p, LAS unsigned char* lds, int bid, int nb) {
    for (int it = bid; it < NB * 36 * 8; it += nb) { const int h = it & 7, bc = it >> 3; gdn::g5_item(p, bc / 36, bc % 36, h, lds, otid()); }
}

__device__ __forceinline__ float wave_sum(float v) {
#pragma unroll
    for (int o = 1; o < 64; o <<= 1) v += __shfl_xor(v, o);
    return v;
}
__device__ __forceinline__ void ld16f(const float* src, int lane, float (&x)[16]) {
#pragma unroll
    for (int hf = 0; hf < 2; ++hf) { const f32x4 a = *(const f32x4*)(src + 512 * hf + 8 * lane), b = *(const f32x4*)(src + 512 * hf + 8 * lane + 4);
        x[8 * hf + 0] = a[0]; x[8 * hf + 1] = a[1]; x[8 * hf + 2] = a[2]; x[8 * hf + 3] = a[3]; x[8 * hf + 4] = b[0]; x[8 * hf + 5] = b[1]; x[8 * hf + 6] = b[2]; x[8 * hf + 7] = b[3]; }
}
__device__ __forceinline__ void ld16b(const bf16_t* src, int lane, float (&x)[16]) {
#pragma unroll
    for (int hf = 0; hf < 2; ++hf) { const v4u y = *(const v4u*)(src + 512 * hf + 8 * lane);
        x[8 * hf + 0] = bf2f(y.x & 0xffffu); x[8 * hf + 1] = bf2f(y.x >> 16); x[8 * hf + 2] = bf2f(y.y & 0xffffu); x[8 * hf + 3] = bf2f(y.y >> 16);
        x[8 * hf + 4] = bf2f(y.z & 0xffffu); x[8 * hf + 5] = bf2f(y.z >> 16); x[8 * hf + 6] = bf2f(y.w & 0xffffu); x[8 * hf + 7] = bf2f(y.w >> 16); }
}
__device__ __forceinline__ void st16f(float* dst, int lane, const float (&x)[16]) {
#pragma unroll
    for (int hf = 0; hf < 2; ++hf) { *(f32x4*)(dst + 512 * hf + 8 * lane) = (f32x4){x[8 * hf], x[8 * hf + 1], x[8 * hf + 2], x[8 * hf + 3]}; *(f32x4*)(dst + 512 * hf + 8 * lane + 4) = (f32x4){x[8 * hf + 4], x[8 * hf + 5], x[8 * hf + 6], x[8 * hf + 7]}; }
}
__device__ __forceinline__ void st16b(bf16_t* dst, int lane, const float (&x)[16]) {
#pragma unroll
    for (int hf = 0; hf < 2; ++hf) { v4u w; w.x = pk2(x[8 * hf], x[8 * hf + 1]); w.y = pk2(x[8 * hf + 2], x[8 * hf + 3]); w.z = pk2(x[8 * hf + 4], x[8 * hf + 5]); w.w = pk2(x[8 * hf + 6], x[8 * hf + 7]); *(v4u*)(dst + 512 * hf + 8 * lane) = w; }
}
__device__ __forceinline__ int swz32(int k, int c) { return ((k ^ ((k >> 6) & 1)) << 5) + ((c ^ ((k >> 3) & 7)) << 2); }
__device__ __forceinline__ void stage_w32(const float* W, int ldw, LAS float* sw) {
    for (int i = otid(); i < 1024 * 8; i += NTHR) { const int k = i >> 3, c = i & 7; const f32x4 v = *(const f32x4*)(W + (size_t)k * ldw + 4 * c); *(LAS f32x4*)(sw + swz32(k, c)) = v; }
}
__device__ __forceinline__ void dot32x2(const float (&h0)[16], const float (&h1)[16], const LAS float* sw, int lane, float (&p0)[32], float (&p1)[32]) {
#pragma unroll
    for (int e = 0; e < 32; ++e) { p0[e] = 0.f; p1[e] = 0.f; }
#pragma unroll
    for (int j = 0; j < 16; ++j) { const int k = (j >> 3) * 512 + 8 * lane + (j & 7);
#pragma unroll
        for (int c = 0; c < 8; ++c) { const f32x4 w = *(const LAS f32x4*)(sw + swz32(k, c));
#pragma unroll
            for (int e = 0; e < 4; ++e) { p0[4 * c + e] += h0[j] * w[e]; p1[4 * c + e] += h1[j] * w[e]; } } }
}
__device__ __forceinline__ float reduce32(float (&p)[32], int lane) {
#pragma unroll
    for (int e = 0; e < 16; ++e) { const bool up = (lane & 32) != 0; const float send = up ? p[e] : p[e + 16]; const float keep = up ? p[e + 16] : p[e]; p[e] = keep + __shfl_xor(send, 32); }
#pragma unroll
    for (int e = 0; e < 8; ++e) { const bool up = (lane & 16) != 0; const float send = up ? p[e] : p[e + 8]; const float keep = up ? p[e + 8] : p[e]; p[e] = keep + __shfl_xor(send, 16); }
#pragma unroll
    for (int e = 0; e < 4; ++e) { const bool up = (lane & 8) != 0; const float send = up ? p[e] : p[e + 4]; const float keep = up ? p[e + 4] : p[e]; p[e] = keep + __shfl_xor(send, 8); }
#pragma unroll
    for (int e = 0; e < 2; ++e) { const bool up = (lane & 4) != 0; const float send = up ? p[e] : p[e + 2]; const float keep = up ? p[e + 2] : p[e]; p[e] = keep + __shfl_xor(send, 4); }
    { const bool up = (lane & 2) != 0; const float send = up ? p[0] : p[1]; const float keep = up ? p[1] : p[0]; p[0] = keep + __shfl_xor(send, 2); }
    return p[0] + __shfl_xor(p[0], 1);
}
__device__ __forceinline__ void load_row(const Params& p, int layer, int n, int lane, bool combine, float (&x)[16], const LAS int* tab = nullptr) {
    const int b = n / T, pp = n % T;
    if (layer == 0) ld16f(pp < C ? p.in[2] + ((size_t)b * C + pp) * D : p.in[0] + ((size_t)b * L + (pp - C)) * D, lane, x);
    else ld16b((const bf16_t*)(p.ws + ws::X) + (size_t)n * D, lane, x);
    if (combine) {
        const bf16_t* Y = (const bf16_t*)(p.ws + ws::YSB);
        const int* posi = (const int*)(p.ws + ws::POSI) + (size_t)n * 4; const float* gate = (const float*)(p.ws + ws::GATE) + (size_t)n * 4;
        float gt[16]; ld16f((const float*)(p.ws + ws::MODS) + ((size_t)(layer - 1) * 9 + (pp < C ? 8 : b)) * 6144 + 5 * 1024, lane, gt);
        float s[16];
#pragma unroll
        for (int j = 0; j < 16; ++j) s[j] = 0.f;
#pragma unroll
        for (int k = 0; k < 4; ++k) { const int inf = posi[k]; const float gk = gate[k];
            const bf16_t* ys = Y + (size_t)(tab[TAB_OFFP + (inf >> 20)] + (inf & 0xfffff)) * D;
#pragma unroll
            for (int hf = 0; hf < 2; ++hf) { const v4u y = *(const v4u*)(ys + 512 * hf + 8 * lane);
                s[8 * hf + 0] += gk * bf2f(y.x & 0xffffu); s[8 * hf + 1] += gk * bf2f(y.x >> 16); s[8 * hf + 2] += gk * bf2f(y.y & 0xffffu); s[8 * hf + 3] += gk * bf2f(y.y >> 16);
                s[8 * hf + 4] += gk * bf2f(y.z & 0xffffu); s[8 * hf + 5] += gk * bf2f(y.z >> 16); s[8 * hf + 6] += gk * bf2f(y.w & 0xffffu); s[8 * hf + 7] += gk * bf2f(y.w >> 16); } }
#pragma unroll
        for (int j = 0; j < 16; ++j) x[j] += gt[j] * s[j];
    }
}
__device__ __forceinline__ void normmod_row(const Params& p, int layer, int n, int lane, const float* g, int sh_chunk, const float (&x)[16], float (&h)[16]) {
    float ss = 0.f;
#pragma unroll
    for (int j = 0; j < 16; ++j) ss += x[j] * x[j];
    const float rs = rsqrtf(wave_sum(ss) * (1.f / D) + EPS);
    const int b = n / T, pp = n % T;
    const float* md = (const float*)(p.ws + ws::MODS) + ((size_t)layer * 9 + (pp < C ? 8 : b)) * 6144 + sh_chunk * 1024;
    float gg[16], sh[16], sc[16]; ld16f(g, lane, gg); ld16f(md, lane, sh); ld16f(md + 1024, lane, sc);
#pragma unroll
    for (int j = 0; j < 16; ++j) h[j] = x[j] * rs * gg[j] * (1.f + sc[j]) + sh[j];
}
__device__ __forceinline__ void phaseA(const Params& p, int layer, LAS unsigned char* lds, int bid, int nb) {
    const int tid = otid(), lane = tid & 63, wave = __builtin_amdgcn_readfirstlane(tid >> 6);
    LAS float* sw = (LAS float*)lds;
    LAS int* tab = (LAS int*)(lds + LDS_MISC);
    const bool gdnl = layer == 2;
    if (layer > 0) moe_tables((const int*)(p.ws + ws::CTL) + ws::CW_CNT + (layer - 1) * 32, tab); else __syncthreads();
    if (gdnl) { stage_w32(p.in[17] + 4096, GIN, sw); __syncthreads(); }
    bf16_t* X = (bf16_t*)(p.ws + ws::X); bf16_t* HB = (bf16_t*)(p.ws + ws::HB); float* SPp = (float*)(p.ws + ws::SP);
    const float* g = p.in[6] + layer * D;
    if (bid < 9) {
        const float* md2 = (const float*)(p.ws + ws::MODS) + ((size_t)layer * 9 + bid) * 6144 + 3 * 1024; float* ab = (float*)(p.ws + ws::MODAB) + ((size_t)layer * 9 + bid) * 2048;
        for (int k = tid; k < 1024; k += NTHR) { ab[k] = p.in[7][layer * D + k] * (1.f + md2[1024 + k]); ab[1024 + k] = md2[k]; } }
    for (int pr = bid * 8 + wave; pr < NTOK / 2; pr += nb * 8) {
        const int n0 = 2 * pr, n1 = n0 + 1;
        float x0[16], x1[16], h0[16], h1[16];
        load_row(p, layer, n0, lane, layer > 0, x0, tab); load_row(p, layer, n1, lane, layer > 0, x1, tab);
        st16b(X + (size_t)n0 * D, lane, x0); st16b(X + (size_t)n1 * D, lane, x1);
        normmod_row(p, layer, n0, lane, g, 0, x0, h0); normmod_row(p, layer, n1, lane, g, 0, x1, h1);
        st16b(HB + (size_t)n0 * D, lane, h0); st16b(HB + (size_t)n1 * D, lane, h1);
        if (gdnl) { float p0[32], p1[32]; dot32x2(h0, h1, sw, lane, p0, p1); const float r0 = reduce32(p0, lane), r1 = reduce32(p1, lane);
            if ((lane & 1) == 0) { SPp[(size_t)n0 * 32 + (lane >> 1)] = r0; SPp[(size_t)n1 * 32 + (lane >> 1)] = r1; } }
    }
}
__device__ __forceinline__ void top4(float v, int lane, int (&idx)[4], float (&val)[4]) {
    const int e = lane >> 1;
#pragma unroll
    for (int k = 0; k < 4; ++k) {
        float bv = v; int bi = e;
#pragma unroll
        for (int o = 2; o < 64; o <<= 1) { const float ov = __shfl_xor(bv, o); const int oi = __shfl_xor(bi, o); if (ov > bv || (ov == bv && oi < bi)) { bv = ov; bi = oi; } }
        idx[k] = bi; val[k] = bv;
        if (e == bi) v = -INFINITY;
    }
}
constexpr int E_BCNT = LDS_MISC + 2048, E_BASE = LDS_MISC + 2176, E_INFO = LDS_MISC + 2304, E_MAXTOK = 512, E_TOKN = E_INFO + E_MAXTOK * 16;
constexpr int CW_CTXC = 8192;
typedef short e_bf16x8 __attribute__((ext_vector_type(8)));
__device__ __forceinline__ unsigned e_cvtpk(float lo, float hi) { typedef float f2 __attribute__((ext_vector_type(2))); typedef __bf16 b2 __attribute__((ext_vector_type(2))); f2 v = {lo, hi}; b2 b = __builtin_convertvector(v, b2); return __builtin_bit_cast(unsigned, b); }
__device__ __forceinline__ void phaseE(const Params& p, int layer, LAS unsigned char* lds, int bid, int nb) {
    const int tid = otid(), lane = tid & 63, wave = __builtin_amdgcn_readfirstlane(tid >> 6), m = lane & 15, q = lane >> 4;
    LAS int* bcnt = (LAS int*)(lds + E_BCNT); LAS int* base = (LAS int*)(lds + E_BASE); LAS int* info = (LAS int*)(lds + E_INFO);
    const bool ctxmode = layer < 3 && nb == 256;
    const bool special = ctxmode && bid < 64;
    if (special) {
        oproj_ctx_unit(p, layer, lds, bid >> 3, bid & 3, (bid >> 2) & 1);
        unsigned* ctr = (unsigned*)(p.ws + ws::CTL) + CW_CTXC + (layer * 8 + (bid >> 3)) * 64;
        asm volatile("s_waitcnt vmcnt(0)" ::: "memory");
        __syncthreads();
        if (tid == 0) {
            __builtin_amdgcn_fence(__ATOMIC_RELEASE, "agent"); asm volatile("s_waitcnt vmcnt(0)" ::: "memory");
            __hip_atomic_fetch_add(ctr, 1u, __ATOMIC_RELAXED, __HIP_MEMORY_SCOPE_AGENT);
        }
    }
    __syncthreads();
    {
        const v4u* src = (const v4u*)(p.ws + ws::WT_RT + (size_t)layer * 2 * 32 * 1024 * 2);
        for (int i = tid; i < 8192; i += NTHR) { const int row = i >> 7, ck = i & 127; *(LAS v4u*)(lds + row * 2048 + ((ck ^ (row & 15)) << 4)) = src[i]; }
    }
    if (tid < 32) bcnt[tid] = 0;
    for (int i = tid; i < E_MAXTOK * 4; i += NTHR) info[i] = -1;
    LAS int* tokn = (LAS int*)(lds + E_TOKN);
    __syncthreads();
    const float* g = p.in[7] + layer * D; const float* br = p.in[24] + layer * NE;
    int* cnt = (int*)(p.ws + ws::CTL) + ws::CW_CNT + layer * 32; int* posi = (int*)(p.ws + ws::POSI); float* gate = (float*)(p.ws + ws::GATE); int* list = (int*)(p.ws + ws::LIST);
    const bf16_t* X = (const bf16_t*)(p.ws + ws::X); bf16_t* HB = (bf16_t*)(p.ws + ws::HB);
    const bool skip_ctx = layer == 3;
    const float bias0 = br[m], bias1 = br[16 + m];
    int it = 0;
    int li0 = 0, lstep = 1, lend = 0;
    if (!ctxmode) { li0 = bid + wave * nb; lstep = 8 * nb; lend = NTOK / 16; }
    else if (!special && wave < 6) { li0 = (bid - 64) + wave * 192; lstep = 1 << 20; lend = 1024; }
    else if (special) { li0 = 1024 + 16 * (bid >> 3) + 2 * (bid & 7) + (wave >> 2); lstep = 1 << 20; lend = 1152; }
    const bool ksplit = special; const int kq = wave & 3;
    LAS float* ssp = (LAS float*)(lds + LDS_MISC);
    for (int li = li0; li < lend; li += lstep, ++it) {
        int gi = li;
        if (ctxmode) {
            if (li >= 1024) { const int cg = li - 1024, cb = cg >> 4; gi = 144 * cb + (cg & 15);
                unsigned* ctr = (unsigned*)(p.ws + ws::CTL) + CW_CTXC + (layer * 8 + cb) * 64;
                unsigned sp = 0; while ((unsigned)__builtin_amdgcn_readfirstlane(__hip_atomic_load(ctr, __ATOMIC_RELAXED, __HIP_MEMORY_SCOPE_AGENT)) < 8u) { __builtin_amdgcn_s_sleep(2); if (++sp > (1u << 22)) break; }
                __builtin_amdgcn_fence(__ATOMIC_ACQUIRE, "agent"); asm volatile("s_waitcnt vmcnt(0)" ::: "memory"); }
            else gi = (li >> 7) * 144 + 16 + (li & 127);
        }
        const int nbase = 16 * gi, pp0 = nbase % T, bb = nbase / T;
        if (skip_ctx && pp0 < C) continue;
        const int n = nbase + m;
        const bf16_t* xr = X + (size_t)n * D + 8 * q;
        const float* ab = (const float*)(p.ws + ws::MODAB) + ((size_t)layer * 9 + (pp0 < C ? 8 : bb)) * 2048 + 8 * q;
        float ss;
        { const f32x4 pq = *(const f32x4*)((const float*)(p.ws + ws::SSQ) + (size_t)n * 16 + 4 * q); ss = (pq[0] + pq[1]) + (pq[2] + pq[3]); }
        ss += __shfl_xor(ss, 16); ss += __shfl_xor(ss, 32);
        const float rs = rsqrtf(ss * (1.f / D) + EPS);
        f32x4 acc0 = {0.f, 0.f, 0.f, 0.f}, acc1 = {0.f, 0.f, 0.f, 0.f};
        bf16_t* hbr = HB + (size_t)n * D + 8 * q;
#define E_KSTEP(s) E_KCOMP(s, (*(const v4u*)(xr + 32 * (s))), (*(const f32x4*)(ab + 32 * (s))), (*(const f32x4*)(ab + 32 * (s) + 4)), (*(const f32x4*)(ab + 1024 + 32 * (s))), (*(const f32x4*)(ab + 1024 + 32 * (s) + 4)))
#define E_KCOMP(s, XY, AA, ABV, BA, BBV) { \
            const v4u xy = XY; \
            const f32x4 xa = {bf2f(xy.x & 0xffffu), bf2f(xy.x >> 16), bf2f(xy.y & 0xffffu), bf2f(xy.y >> 16)}, xb = {bf2f(xy.z & 0xffffu), bf2f(xy.z >> 16), bf2f(xy.w & 0xffffu), bf2f(xy.w >> 16)}; \
            const f32x4 aa = AA, abv = ABV; \
            const f32x4 ba = BA, bbv = BBV; \
            float h[8]; \
            _Pragma("unroll") \
            for (int j = 0; j < 4; ++j) { h[j] = xa[j] * rs * aa[j] + ba[j]; h[4 + j] = xb[j] * rs * abv[j] + bbv[j]; } \
            v4u hi, lo; \
            hi.x = e_cvtpk(h[0], h[1]); hi.y = e_cvtpk(h[2], h[3]); hi.z = e_cvtpk(h[4], h[5]); hi.w = e_cvtpk(h[6], h[7]); \
            lo.x = e_cvtpk(h[0] - bf2f(hi.x & 0xffffu), h[1] - bf2f(hi.x >> 16)); lo.y = e_cvtpk(h[2] - bf2f(hi.y & 0xffffu), h[3] - bf2f(hi.y >> 16)); \
            lo.z = e_cvtpk(h[4] - bf2f(hi.z & 0xffffu), h[5] - bf2f(hi.z >> 16)); lo.w = e_cvtpk(h[6] - bf2f(hi.w & 0xffffu), h[7] - bf2f(hi.w >> 16)); \
            *(v4u*)(hbr + 32 * (s)) = hi; \
            const e_bf16x8 ahi = __builtin_bit_cast(e_bf16x8, hi), alo = __builtin_bit_cast(e_bf16x8, lo); \
            const int ck = 4 * (s) + q; \
            const e_bf16x8 b0h = *(const LAS e_bf16x8*)(lds + m * 2048 + ((ck ^ m) << 4)), b1h = *(const LAS e_bf16x8*)(lds + (16 + m) * 2048 + ((ck ^ m) << 4)); \
            const e_bf16x8 b0l = *(const LAS e_bf16x8*)(lds + (32 + m) * 2048 + ((ck ^ m) << 4)), b1l = *(const LAS e_bf16x8*)(lds + (48 + m) * 2048 + ((ck ^ m) << 4)); \
            acc0 = __builtin_amdgcn_mfma_f32_16x16x32_bf16(ahi, b0h, acc0, 0, 0, 0); acc1 = __builtin_amdgcn_mfma_f32_16x16x32_bf16(ahi, b1h, acc1, 0, 0, 0); \
            acc0 = __builtin_amdgcn_mfma_f32_16x16x32_bf16(alo, b0h, acc0, 0, 0, 0); acc1 = __builtin_amdgcn_mfma_f32_16x16x32_bf16(alo, b1h, acc1, 0, 0, 0); \
            acc0 = __builtin_amdgcn_mfma_f32_16x16x32_bf16(ahi, b0l, acc0, 0, 0, 0); acc1 = __builtin_amdgcn_mfma_f32_16x16x32_bf16(ahi, b1l, acc1, 0, 0, 0); \
        }
        if (ksplit) {
#pragma unroll
            for (int s8 = 0; s8 < 8; ++s8) E_KSTEP(8 * kq + s8)
            __syncthreads();
            { LAS f32x4* ap = (LAS f32x4*)(lds + wave * 2048 + lane * 32); ap[0] = acc0; ap[1] = acc1; }
            __syncthreads();
            { const int w0 = wave & 4; const LAS f32x4* a0p = (const LAS f32x4*)(lds + w0 * 2048 + lane * 32);
              acc0 = (a0p[0] + a0p[128]) + (a0p[256] + a0p[384]); acc1 = (a0p[1] + a0p[129]) + (a0p[257] + a0p[385]); }
        } else {
            v4u xq[3][4];
#pragma unroll
            for (int j = 0; j < 4; ++j) { xq[0][j] = *(const v4u*)(xr + 32 * j); xq[1][j] = *(const v4u*)(xr + 32 * (4 + j)); }
#pragma unroll
            for (int bt = 0; bt < 8; ++bt) {
                f32x4 A0[4], A1[4], B0[4], B1[4];
#pragma unroll
                for (int j = 0; j < 4; ++j) { const int s = 4 * bt + j; A0[j] = *(const f32x4*)(ab + 32 * s); A1[j] = *(const f32x4*)(ab + 32 * s + 4); B0[j] = *(const f32x4*)(ab + 1024 + 32 * s); B1[j] = *(const f32x4*)(ab + 1024 + 32 * s + 4); }
                asm volatile("" ::: "memory");
                if (bt + 2 < 8) {
#pragma unroll
                    for (int j = 0; j < 4; ++j) xq[(bt + 2) % 3][j] = *(const v4u*)(xr + 32 * (4 * (bt + 2) + j)); }
                asm volatile("" ::: "memory");
#pragma unroll
                for (int j = 0; j < 4; ++j) E_KCOMP(4 * bt + j, xq[bt % 3][j], A0[j], A1[j], B0[j], B1[j])
            }
        }
#undef E_KSTEP
#undef E_KCOMP
#pragma unroll
        for (int r = 0; r < 4; ++r) if (!ksplit || r == kq) {
            float v0 = acc0[r] + bias0, v1 = acc1[r] + bias1;
            int idx[4]; float val[4];
#pragma unroll
            for (int k = 0; k < 4; ++k) {
                float bv = v0; int bi = m; if (v1 > v0) { bv = v1; bi = 16 + m; }
#pragma unroll
                for (int o = 1; o < 16; o <<= 1) { const float ov = __shfl_xor(bv, o); const int oi = __shfl_xor(bi, o); if (ov > bv || (ov == bv && oi < bi)) { bv = ov; bi = oi; } }
                idx[k] = bi; val[k] = bv;
                if (bi == m) v0 = -INFINITY; if (bi == 16 + m) v1 = -INFINITY;
            }
            float ex[4], sum = 0.f;
#pragma unroll
            for (int k = 0; k < 4; ++k) { ex[k] = __expf(val[k] - val[0]); sum += ex[k]; }
            const float inv = 1.f / sum;
            if (m == 0) { const int tok = 4 * q + r, tl = (wave + 8 * it) * 16 + tok, nt = nbase + tok;
                if (tl < E_MAXTOK) { tokn[tl] = nt;
#pragma unroll
                    for (int k = 0; k < 4; ++k) { const int lpos = atomicAdd((int*)&bcnt[idx[k]], 1); info[tl * 4 + k] = (idx[k] << 16) | lpos; gate[nt * 4 + k] = ex[k] * inv; } } }
        }
    }
    __syncthreads();
    if (tid < 32) base[tid] = atomicAdd(&cnt[tid], bcnt[tid]);
    __syncthreads();
    for (int i = tid; i < E_MAXTOK * 4; i += NTHR) { const int inf = info[i];
        if (inf >= 0) { const int tl = i >> 2, k = i & 3, n = tokn[tl];
            const int e_ = inf >> 16, pos = base[e_] + (inf & 0xffff);
            list[e_ * CAP + pos] = n; posi[n * 4 + k] = (e_ << 20) | pos; } }
}
__device__ __forceinline__ void prologue_router(const Params& p, int bid, int nb) {
    bf16_t* wt = (bf16_t*)(p.ws + ws::WT_RT);
    for (int gidx = bid * NTHR + otid(); gidx < DEPTH * 32 * 1024; gidx += nb * NTHR) {
        const int layer = gidx >> 15, e = (gidx >> 10) & 31, k = gidx & 1023;
        const float w = p.in[23][((size_t)layer * 1024 + k) * 32 + e];
        const unsigned hi = f2bf(w); const unsigned lo = f2bf(w - bf2f(hi));
        wt[((size_t)(layer * 2 + 0) * 32 + e) * 1024 + k] = (bf16_t)hi; wt[((size_t)(layer * 2 + 1) * 32 + e) * 1024 + k] = (bf16_t)lo;
    }
}
__device__ __forceinline__ void phaseFinal(const Params& p, LAS unsigned char* lds, int bid, int nb) {
    const int tid = otid(), lane = tid & 63, wave = __builtin_amdgcn_readfirstlane(tid >> 6);
    LAS int* tab = (LAS int*)(lds + LDS_MISC);
    moe_tables((const int*)(p.ws + ws::CTL) + ws::CW_CNT + 3 * 32, tab);
    float gg[16]; ld16f(p.in[29], lane, gg);
    for (int i = 2 * (bid * 8 + wave); i < NB * L; i += nb * 16) {
        const int b = i / L, l = i % L, n = b * T + C + l;
        float x[16], y[16]; load_row(p, 4, n, lane, true, x, tab); load_row(p, 4, n + 1, lane, true, y, tab);
        float ss = 0.f, st = 0.f;
#pragma unroll
        for (int j = 0; j < 16; ++j) { ss += x[j] * x[j]; st += y[j] * y[j]; }
        const float rs = rsqrtf(wave_sum(ss) * (1.f / D) + EPS), rt = rsqrtf(wave_sum(st) * (1.f / D) + EPS);
#pragma unroll
        for (int j = 0; j < 16; ++j) { x[j] = x[j] * rs * gg[j]; y[j] = y[j] * rt * gg[j]; }
        st16f(p.out + (size_t)i * D, lane, x); st16f(p.out + (size_t)(i + 1) * D, lane, y);
    }
}
__device__ __forceinline__ void prologue_mods(const Params& p, LAS unsigned char* lds, int bid, int nb) {
    const int tid = otid(), lane = tid & 63, wave = tid >> 6;
    LAS float* sc = (LAS float*)lds;
    LAS float* part = (LAS float*)(lds + 36864);
    float* mods = (float*)(p.ws + ws::MODS);
    __syncthreads();
    for (int i = tid; i < 9 * 1024; i += NTHR) { const int r = i >> 10, k = i & 1023; const float v = r < 8 ? p.in[1][r * 1024 + k] : p.in[3][k]; sc[i] = v / (1.f + expf(-v)); }
    __syncthreads();
    for (int task = bid; task < DEPTH * 96; task += nb) {
        const int layer = task / 96, col = (task % 96) * 64 + lane;
        const float* w = p.in[4] + (size_t)layer * 1024 * 6144 + col;
        float acc[9];
#pragma unroll
        for (int r = 0; r < 9; ++r) acc[r] = 0.f;
#pragma unroll 32
        for (int kk = 0; kk < 128; ++kk) { const int k = wave * 128 + kk; const float wv = w[(size_t)k * 6144];
#pragma unroll
            for (int r = 0; r < 9; ++r) acc[r] += sc[r * 1024 + k] * wv; }
#pragma unroll
        for (int r = 0; r < 9; ++r) part[(wave * 9 + r) * 64 + lane] = acc[r];
        __syncthreads();
        for (int i = tid; i < 9 * 64; i += NTHR) { const int r = i >> 6, cc = i & 63; float s = 0.f;
#pragma unroll
            for (int ww = 0; ww < 8; ++ww) s += part[(ww * 9 + r) * 64 + cc];
            const int c2 = (task % 96) * 64 + cc; mods[((size_t)layer * 9 + r) * 6144 + c2] = s + p.in[5][layer * 6144 + c2]; }
        __syncthreads();
    }
    float* rope = (float*)(p.ws + ws::ROPE);
    for (int gid = bid * NTHR + tid; gid < L * 32; gid += nb * NTHR) {
        const int l = gid >> 5, j = gid & 31, axis = j >> 4, f = j & 15;
        const float pos = (float)(axis == 0 ? (l / 64) : (l % 64));
        const float inv = (float)pow(10000.0, -(double)(2 * f) / 32.0);
        const float ang = pos * inv;
        rope[gid] = (float)cos((double)ang); rope[L * 32 + gid] = (float)sin((double)ang);
    }
}

#define XB_TMO      128
#define XB_XCNT(j)  (256  + 64 * (j))
#define XB_XSUB(j)  (1280 + 64 * (j))
#define XB_XGEN(j)  (2304 + 64 * (j))
#define XB_TOP      3328
#define XB_TOPGEN   3392
#define XCD_BAR_WORDS 3456
#define XB_SPIN_CAP (1u << 18)

__device__ __forceinline__ unsigned xb_ld(unsigned* p)              { return __hip_atomic_load(p, __ATOMIC_RELAXED, __HIP_MEMORY_SCOPE_AGENT); }
__device__ __forceinline__ unsigned xb_add(unsigned* p, unsigned v) { return __hip_atomic_fetch_add(p, v, __ATOMIC_RELAXED, __HIP_MEMORY_SCOPE_AGENT); }
__device__ __forceinline__ unsigned xb_xcc_id() { return (unsigned)__builtin_amdgcn_s_getreg((3 << 11) | 20) & 0xFu; }
#define XB_SPIN(cond, bar) do { unsigned _sp = 0; while (cond) { __builtin_amdgcn_s_sleep(1); \
    if ((++_sp & 255u) == 0u) { if (xb_ld(&(bar)[XB_TMO])) break; if (_sp > XB_SPIN_CAP) { atomicAdd(&(bar)[XB_TMO], 1u); break; } } } } while (0)

struct XcdBarrier {
    unsigned* bar; unsigned x;
    volatile LAS unsigned* st;
};

__device__ __forceinline__ XcdBarrier xcd_barrier_post(unsigned* bar, volatile LAS unsigned* st) {
    XcdBarrier b; b.bar = bar; b.x = xb_xcc_id(); b.st = st;
    if (threadIdx.x == 0) (void)xb_add(&bar[XB_XCNT(b.x)], 1u);
    return b;
}
__device__ __forceinline__ void xcd_barrier_complete(unsigned* bar, unsigned x, unsigned& nloc, unsigned& nx) {
    const unsigned G = gridDim.x * gridDim.y * gridDim.z;
    unsigned sum, cnt, mine, sp = 0u;
    for (;;) {
        sum = 0u; cnt = 0u; mine = 0u;
#pragma unroll
        for (unsigned j = 0; j < 16; ++j) { const unsigned c = xb_ld(&bar[XB_XCNT(j)]); sum += c; cnt += (c > 0u) ? 1u : 0u; mine = (j == x) ? c : mine; }
        if (sum == G) break;
        __builtin_amdgcn_s_sleep(1);
        if ((++sp & 255u) == 0u) { if (xb_ld(&bar[XB_TMO])) break; if (sp > XB_SPIN_CAP) { atomicAdd(&bar[XB_TMO], 1u); break; } }
    }
    nloc = mine > 0u ? mine : 1u; nx = cnt > 0u ? cnt : 1u;
}

__device__ __forceinline__ void xcd_barrier(const XcdBarrier& b) {
    asm volatile("s_waitcnt vmcnt(0)" ::: "memory");
    __syncthreads();
    if (threadIdx.x == 0) {
        unsigned* bar = b.bar;
        __builtin_amdgcn_s_waitcnt(0);
        unsigned nloc = b.st[0], nx = b.st[1];
        if (nloc == 0u) { xcd_barrier_complete(bar, b.x, nloc, nx); b.st[0] = nloc; b.st[1] = nx; }
        const unsigned old = xb_add(&bar[XB_XSUB(b.x)], 1u);
        const unsigned gen = old / nloc;
        if (old + 1u == (gen + 1u) * nloc) {
            __builtin_amdgcn_fence(__ATOMIC_RELEASE, "agent");
            asm volatile("s_waitcnt vmcnt(0)" ::: "memory");
            const unsigned og = xb_add(&bar[XB_TOP], 1u);
            const unsigned tg = og / nx;
            if (og + 1u == (tg + 1u) * nx) xb_add(&bar[XB_TOPGEN], 1u);
            else XB_SPIN(xb_ld(&bar[XB_TOPGEN]) == tg, bar);
            __builtin_amdgcn_fence(__ATOMIC_ACQUIRE, "agent");
            xb_add(&bar[XB_XGEN(b.x)], 1u);
            asm volatile("s_waitcnt vmcnt(0)" ::: "memory");
        } else {
            XB_SPIN(xb_ld(&bar[XB_XGEN(b.x)]) == gen, bar);
            __builtin_amdgcn_fence(__ATOMIC_ACQUIRE, "agent");
            asm volatile("s_waitcnt vmcnt(0)" ::: "memory");
        }
    }
    __syncthreads();
}


#ifndef MK_MULTI
#define MK_MULTI 0
#endif
constexpr int CW_BAR = 4096;
constexpr int N_PHASES = 38;
__global__ void __launch_bounds__(NTHR, 2) mega(Params p) {
    LAS unsigned char* lds = (LAS unsigned char*)dyn_lds;
    volatile LAS unsigned* st = (volatile LAS unsigned*)(lds + LDS_MISC + 1024);
    if (threadIdx.x == 0) { st[0] = 0u; st[1] = 0u; st[2] = 0u; st[3] = 0u; }
    __syncthreads();
#if defined(PROBE_SECTION)
    if (threadIdx.x == 0) *PSEC_ACC(lds) = 0ull;
#endif
    const int bid = blockIdx.x, nb = gridDim.x;
    const int lo = p.ph_lo, hi = p.ph_hi;
    const bool one = (hi - lo) == N_PHASES;
    XcdBarrier xb; xb.bar = (unsigned*)(p.ws + ws::CTL) + CW_BAR; xb.x = 0; xb.st = st;
    if (one) xb = xcd_barrier_post((unsigned*)(p.ws + ws::CTL) + CW_BAR, st);
#define PH(idx) ((idx) >= lo && (idx) < hi)
#if defined(PROBE_MASK)
    unsigned long long t_acc = 0ull, t_prev = __builtin_amdgcn_s_memrealtime(); int ph_cur = 0;
#define SEAM() do { if (one) xcd_barrier(xb); { const unsigned long long now_ = __builtin_amdgcn_s_memrealtime(); if ((PROBE_MASK >> ph_cur) & 1ull) t_acc += now_ - t_prev; t_prev = now_; ++ph_cur; } } while (0)
#define SKIPPH(n) do { ph_cur += (n); } while (0)
#else
#define SEAM() do { if (one) xcd_barrier(xb); } while (0)
#define SKIPPH(n) do { } while (0)
#endif
    if (PH(0)) { prologue_router(p, bid, nb); prologue_mods(p, lds, bid, nb); prologue_dense_weights(p, lds, bid, nb); prologue_moe_weights(p, lds, bid, nb); }
    SEAM();
    for (int layer = 0; layer < DEPTH; ++layer) {
        const int pb = 1 + 9 * layer;
        if (PH(pb + 0)) { if (layer == 1 && nb == 256) moe_pool_finish(p, 0, bid, nb); if (layer == 3 && nb == 256) moe_pool_finish(p, 2, bid, nb); phaseA(p, layer, lds, bid, nb); }
        SEAM();
        if (layer == 2) {
            if (PH(pb + 1)) gin_phase(p, lds, bid, nb);
            SEAM();
            if (PH(pb + 2)) gdn_g3_phase(p, lds, bid, nb);
            SEAM();
            if (PH(pb + 3)) gdn_g4_phase(p, lds, bid, nb);
            SEAM();
            if (PH(pb + 4)) { gdn_g5_phase(p, lds, bid, nb); if (nb == 256) moe_pool_finish(p, 1, bid, nb); }
        } else {
            if (PH(pb + 1)) qkv_phase(p, layer, lds, bid, nb);
            SEAM();
            if (PH(pb + 2)) attn_phase_fn(p, layer, lds, bid, nb);
            SKIPPH(2);
        }
        SEAM();
        if (PH(pb + 5)) oproj_phase(p, layer, lds, bid, nb);
        SEAM();
        if (PH(pb + 6)) phaseE(p, layer, lds, bid, nb);
        SEAM();
        if (PH(pb + 7)) moe_up_phase(p, layer, lds, bid, nb);
        SEAM();
        if (PH(pb + 8)) moe_down_phase(p, layer, lds, bid, nb);
        SEAM();
    }
    if (PH(37)) phaseFinal(p, lds, bid, nb);
#if defined(PROBE_SECTION)
    __syncthreads();
    if (bid == 0 && otid() == 0) { const unsigned long long acc_ = *PSEC_ACC(lds), t0_ = __builtin_amdgcn_s_memrealtime(); while (__builtin_amdgcn_s_memrealtime() - t0_ < 9ull * acc_) __builtin_amdgcn_s_sleep(8); }
#endif
#if defined(PROBE_MASK)
    { const unsigned long long now_ = __builtin_amdgcn_s_memrealtime(); if ((PROBE_MASK >> 37) & 1ull) t_acc += now_ - t_prev;
      if (bid == 0 && otid() == 0) { const unsigned long long t0_ = __builtin_amdgcn_s_memrealtime(); while (__builtin_amdgcn_s_memrealtime() - t0_ < 9ull * t_acc) __builtin_amdgcn_s_sleep(8); } }
#endif
#undef PH
#undef SEAM
#undef SKIPPH
}

extern "C" void kernel_launch(void* const* d_in, const int* in_sizes, int n_in, void* d_out, int out_size, void* d_ws, size_t ws_size, hipStream_t stream) {
    static int grid = 0;
    if (grid == 0) {
        int dev = 0, cus = 0, per_cu = 0;
        if (ws_size < ws::END) { fprintf(stderr, "kernel_launch: workspace too small: %zu < %zu\n", ws_size, (size_t)ws::END); grid = -1; return; }
        if (hipGetDevice(&dev) != hipSuccess || hipDeviceGetAttribute(&cus, hipDeviceAttributeMultiprocessorCount, dev) != hipSuccess) { grid = -1; return; }
        if (hipFuncSetAttribute((const void*)mega, hipFuncAttributeMaxDynamicSharedMemorySize, LDS_BYTES) != hipSuccess) { fprintf(stderr, "kernel_launch: hipFuncSetAttribute failed\n"); grid = -1; return; }
        if (hipOccupancyMaxActiveBlocksPerMultiprocessor(&per_cu, (const void*)mega, NTHR, LDS_BYTES) != hipSuccess || per_cu < 1) { fprintf(stderr, "kernel_launch: occupancy query says %d\n", per_cu); per_cu = 1; }
        (void)hipGetLastError();
        grid = cus;
    }
    if (grid < 0) return;
    (void)hipMemsetAsync((char*)d_ws + ws::CTL, 0, 65536, stream);
    Params prm{};
    for (int q = 0; q < 30; ++q) prm.in[q] = (const float*)d_in[q];
    prm.out = (float*)d_out; prm.ws = (unsigned char*)d_ws;
#if MK_MULTI
    for (int ph = 0; ph < N_PHASES; ++ph) { prm.ph_lo = ph; prm.ph_hi = ph + 1; hipLaunchKernelGGL(mega, dim3(grid), dim3(NTHR), LDS_BYTES, stream, prm); }
#else
    prm.ph_lo = 0; prm.ph_hi = N_PHASES;
    hipLaunchKernelGGL(mega, dim3(grid), dim3(NTHR), LDS_BYTES, stream, prm);
#endif
}
```
